# Optimizing an MI355X kernel written in HIP

```python
import jax, jax.numpy as jnp
from jax import lax
import numpy as np

D_MODEL = 2048
BATCH = 16
SEQ = 2048
DEPTH = 1
DEC_BATCH = 128
DEC_SEQ = 4
PAST_LEN = 16384
PAGE_SIZE = 128

HEAD_DIM = 64
ATTN_W = D_MODEL // 2
N_HEADS = ATTN_W // HEAD_DIM
N_KV_HEADS = N_HEADS // 4
GROUP = N_HEADS // N_KV_HEADS
KV_W = N_KV_HEADS * HEAD_DIM
CONV_CH = D_MODEL - ATTN_W
MIX_W = ATTN_W + CONV_CH
IN_W = ATTN_W + 2 * KV_W + 2 * CONV_CH
WINDOW = 128
BLOCK = 128
CACHE_WIN = min(WINDOW, PAST_LEN)
CONV_W = 31
CONV_BUF = min(CONV_W - 1, PAST_LEN)
D_FF = 4 * D_MODEL
EPS = 1e-6
ATTN_SCALE = HEAD_DIM ** -0.5
NEG = -1e30

kernel_name = "hymba_swa_sink_conformer_conv_sqrelu"


def _rmsnorm(x, g):
    xf = x.astype(jnp.float32)
    y = xf * lax.rsqrt(jnp.mean(xf * xf, axis=-1, keepdims=True) + EPS)
    return (y * g.astype(jnp.float32)).astype(x.dtype)


def _layernorm(x, g, b):
    xf = x.astype(jnp.float32)
    mu = jnp.mean(xf, axis=-1, keepdims=True)
    xc = xf - mu
    y = xc * lax.rsqrt(jnp.mean(xc * xc, axis=-1, keepdims=True) + EPS)
    return (y * g.astype(jnp.float32) + b.astype(jnp.float32)).astype(x.dtype)


def _project(h, w_in, q_norm, k_norm):
    z = h @ w_in
    q, k, v, a, gate = jnp.split(
        z, [ATTN_W, ATTN_W + KV_W, ATTN_W + 2 * KV_W, ATTN_W + 2 * KV_W + CONV_CH], axis=-1)
    lead = h.shape[:-1]
    q = _rmsnorm(q.reshape(*lead, N_KV_HEADS, GROUP, HEAD_DIM), q_norm)
    k = _rmsnorm(k.reshape(*lead, N_KV_HEADS, HEAD_DIM), k_norm)
    v = v.reshape(*lead, N_KV_HEADS, HEAD_DIM)
    u = a * jax.nn.sigmoid(gate)
    return q, k, v, u


def _sink_attn(q, k, v, q_pos, k_pos, sinks):
    s = jnp.einsum('...qhgd,...khd->...hgqk', q, k,
                   preferred_element_type=jnp.float32) * ATTN_SCALE
    kp = k_pos[..., None, :]
    qp = q_pos[..., :, None]
    mask = (kp <= qp) & (kp > qp - WINDOW) & (kp >= 0)
    s = jnp.where(mask[..., None, None, :, :], s, NEG)
    sink = sinks.astype(jnp.float32).reshape(N_KV_HEADS, GROUP, 1, 1)
    sink = jnp.broadcast_to(sink, s.shape[:-1] + (1,))
    p = jax.nn.softmax(jnp.concatenate([s, sink], axis=-1), axis=-1)[..., :-1]
    return jnp.einsum('...hgqk,...khd->...qhgd', p.astype(v.dtype), v)


def _conv_tail(u_ext, w_dw, b_dw, g_ln, b_ln):
    y = lax.conv_general_dilated(
        u_ext, w_dw[:, None, :].astype(u_ext.dtype), window_strides=(1,), padding='VALID',
        dimension_numbers=('NWC', 'WIO', 'NWC'), feature_group_count=CONV_CH)
    y = _layernorm(y + b_dw, g_ln, b_ln)
    return jax.nn.silu(y)


def _merge_and_mlp(x, attn_o, conv_o, w_out, g_mlp, w_up, w_down):
    x1 = x + jnp.concatenate([attn_o, conv_o], axis=-1) @ w_out
    h = _rmsnorm(x1, g_mlp)
    return x1 + jnp.square(jax.nn.relu(h @ w_up)) @ w_down


def setup_inputs(seed: int = 0) -> dict:
    key = jax.random.key(seed)
    ks = jax.random.split(key, 20)
    f = jnp.float32
    n = lambda k, shp, sc: (jax.random.normal(k, shp, f) * sc)
    return {
        "x_prompt": n(ks[0], (BATCH, SEQ, D_MODEL), 1.0),
        "x_sample": n(ks[1], (DEC_BATCH, DEC_SEQ, D_MODEL), 1.0),
        "cache_k": n(ks[2], (DEPTH, DEC_BATCH, CACHE_WIN, N_KV_HEADS, HEAD_DIM), 1.0),
        "cache_v": n(ks[3], (DEPTH, DEC_BATCH, CACHE_WIN, N_KV_HEADS, HEAD_DIM), 1.0),
        "state_conv": n(ks[4], (DEPTH, DEC_BATCH, CONV_BUF, CONV_CH), 0.5),
        "g_mix_norm": 1.0 + n(ks[5], (DEPTH, D_MODEL), 0.02),
        "w_in": n(ks[6], (DEPTH, D_MODEL, IN_W), D_MODEL ** -0.5),
        "q_norm": 1.0 + n(ks[7], (DEPTH, HEAD_DIM), 0.02),
        "k_norm": 1.0 + n(ks[8], (DEPTH, HEAD_DIM), 0.02),
        "sinks": n(ks[9], (DEPTH, N_HEADS), 0.5),
        "w_dw": n(ks[10], (DEPTH, CONV_W, CONV_CH), CONV_W ** -0.5),
        "b_dw": n(ks[11], (DEPTH, CONV_CH), 0.02),
        "g_conv_ln": 1.0 + n(ks[12], (DEPTH, CONV_CH), 0.02),
        "b_conv_ln": n(ks[13], (DEPTH, CONV_CH), 0.02),
        "w_out": n(ks[14], (DEPTH, MIX_W, D_MODEL), MIX_W ** -0.5),
        "g_mlp_norm": 1.0 + n(ks[15], (DEPTH, D_MODEL), 0.02),
        "w_up": n(ks[16], (DEPTH, D_MODEL, D_FF), D_MODEL ** -0.5),
        "w_down": n(ks[17], (DEPTH, D_FF, D_MODEL), D_FF ** -0.5),
    }


def reference(x_prompt, x_sample, cache_k, cache_v, state_conv,
              g_mix_norm, w_in, q_norm, k_norm, sinks, w_dw, b_dw, g_conv_ln, b_conv_ln,
              w_out, g_mlp_norm, w_up, w_down):
    B, S, _ = x_prompt.shape
    Bd, Sd, _ = x_sample.shape
    n_blk = S // BLOCK
    q_pos_p = jnp.arange(S, dtype=jnp.int32).reshape(n_blk, BLOCK)
    k_pos_p = q_pos_p[:, :1] - BLOCK + jnp.arange(2 * BLOCK, dtype=jnp.int32)
    q_pos_s = PAST_LEN + jnp.arange(Sd, dtype=jnp.int32)
    k_pos_s = PAST_LEN - CACHE_WIN + jnp.arange(CACHE_WIN + Sd, dtype=jnp.int32)

    xp, xs = x_prompt, x_sample
    nk_p, nv_p, nc_p, nk_s, nv_s, nc_s = [], [], [], [], [], []
    for l in range(DEPTH):
        h = _rmsnorm(xp, g_mix_norm[l])
        q, k, v, u = _project(h, w_in[l], q_norm[l], k_norm[l])
        qb = q.reshape(B, n_blk, BLOCK, N_KV_HEADS, GROUP, HEAD_DIM)
        kb = k.reshape(B, n_blk, BLOCK, N_KV_HEADS, HEAD_DIM)
        vb = v.reshape(B, n_blk, BLOCK, N_KV_HEADS, HEAD_DIM)
        pad = jnp.zeros_like(kb[:, :1])
        kk = jnp.concatenate([jnp.concatenate([pad, kb[:, :-1]], axis=1), kb], axis=2)
        vv = jnp.concatenate([jnp.concatenate([pad, vb[:, :-1]], axis=1), vb], axis=2)
        attn_p = _sink_attn(qb, kk, vv, q_pos_p, k_pos_p, sinks[l]).reshape(B, S, ATTN_W)
        u_ext = jnp.concatenate([jnp.zeros((B, CONV_W - 1, CONV_CH), u.dtype), u], axis=1)
        conv_p = _conv_tail(u_ext, w_dw[l], b_dw[l], g_conv_ln[l], b_conv_ln[l])
        xp = _merge_and_mlp(xp, attn_p, conv_p, w_out[l], g_mlp_norm[l], w_up[l], w_down[l])
        nk_p.append(k[:, S - CACHE_WIN:])
        nv_p.append(v[:, S - CACHE_WIN:])
        nc_p.append(u[:, S - CONV_BUF:])

        h = _rmsnorm(xs, g_mix_norm[l])
        q, k, v, u = _project(h, w_in[l], q_norm[l], k_norm[l])
        kk = jnp.concatenate([cache_k[l].astype(k.dtype), k], axis=1)
        vv = jnp.concatenate([cache_v[l].astype(v.dtype), v], axis=1)
        attn_s = _sink_attn(q, kk, vv, q_pos_s, k_pos_s, sinks[l]).reshape(Bd, Sd, ATTN_W)
        u_ext = jnp.concatenate([state_conv[l].astype(u.dtype), u], axis=1)
        conv_s = _conv_tail(u_ext[:, CONV_BUF - (CONV_W - 1):], w_dw[l], b_dw[l],
                            g_conv_ln[l], b_conv_ln[l])
        xs = _merge_and_mlp(xs, attn_s, conv_s, w_out[l], g_mlp_norm[l], w_up[l], w_down[l])
        nk_s.append(kk[:, Sd:])
        nv_s.append(vv[:, Sd:])
        nc_s.append(u_ext[:, Sd:])

    return (xp, xs, jnp.stack(nk_p), jnp.stack(nv_p), jnp.stack(nc_p),
            jnp.stack(nk_s), jnp.stack(nv_s), jnp.stack(nc_s))
```

```cpp
#include <hip/hip_runtime.h>
#include <cstdio>
#include <cstdint>
namespace pg8 {
#define PG8_LAS __attribute__((address_space(3)))
typedef unsigned short bf16_t;
typedef short bf16x8 __attribute__((ext_vector_type(8)));
typedef float f32x4 __attribute__((ext_vector_type(4)));
typedef unsigned u32x4 __attribute__((ext_vector_type(4)));
constexpr int BM = 256, BK = 64, HALF = 128, HTB = HALF * BK * 2  , STAGE_BYTES = 8 * HTB, NXCD = 8, WGM = 8;

__host__ __device__ __forceinline__ int lds_byte(int r, int c) { const int st = (r >> 4) * 2 + (c >> 5), rr = r & 15, cc = c & 31, ob = rr * 64 + cc * 2; return st * 1024 + (ob ^ (((ob >> 9) & 1) << 5)); }
__host__ __device__ __forceinline__ void stage_rc(int b, int& R, int& C) { const int st = b / 1024, sb = b % 1024, swz = sb ^ (((sb >> 9) & 1) << 5); R = (st >> 1) * 16 + swz / 64; C = (st & 1) * 32 + (swz % 64) / 2; }
__host__ __device__ __forceinline__ int perm32(int rho) { const int n = rho >> 4, i = rho & 15; return 8 * (i >> 2) + 4 * n + (i & 3); }

struct Unit { int pm, pn; };
struct Gemm { const bf16_t* A; const bf16_t* Bt; int M, N, K; };

struct StaticOrder {
    int nM, nN, nwg, G, c;
    __host__ __device__ void init(int M, int N, int G_, int c_) { nM = M / BM; nN = N / BM; nwg = nM * nN; G = G_; c = c_; }
    __host__ __device__ bool next(int i, Unit& u) const {
        const long L = (long)i * G + c; if (L >= nwg) return false;
        int wgid = (int)L; { const int q = nwg / NXCD, r = nwg % NXCD, xcd = wgid % NXCD, off = wgid / NXCD; wgid = (xcd < r ? xcd * (q + 1) : r * (q + 1) + (xcd - r) * q) + off; }
        const int nig = WGM * nN, gid = wgid / nig, fm = gid * WGM, gsz = (nM - fm) < WGM ? (nM - fm) : WGM;
        u.pm = fm + ((wgid % nig) % gsz); u.pn = (wgid % nig) / gsz; return true;
    }
    __device__ __forceinline__ void a_ready(const Unit&) const {}
    __device__ __forceinline__ void done(const Unit&) const {}
};

__device__ __forceinline__ unsigned cvt_pk_bf16(float lo, float hi) { unsigned r; asm volatile("v_cvt_pk_bf16_f32 %0, %1, %2" : "=v"(r) : "v"(lo), "v"(hi)); return r; }
typedef float f32x2 __attribute__((ext_vector_type(2)));
struct EpiIn {
    static constexpr bool PERM = true, AFTER_DRAIN = false;
    bf16_t* Z; bf16_t* U; const float* rstd;
    __device__ __forceinline__ void operator()(const f32x4 (&acc)[2][2][4][2], const Unit& u, int wr, int wc, int fr, int fq) const {
        const int row0 = u.pm * BM + wr * 64 + fr;
        if (u.pn < 6) {
            const int col0 = u.pn * BM + wc * 32 + 8 * fq;
#pragma unroll
            for (int ai = 0; ai < 2; ++ai)
#pragma unroll
                for (int m = 0; m < 4; ++m) { const int row = row0 + ai * HALF + m * 16; const float rs = rstd[row]; bf16_t* rowp = Z + (size_t)row * 1536 + col0;
#pragma unroll
                    for (int bj = 0; bj < 2; ++bj) { const f32x4 v0 = acc[ai][bj][m][0] * rs, v1 = acc[ai][bj][m][1] * rs;
                        u32x4 w; w.x = cvt_pk_bf16(v0[0], v0[1]); w.y = cvt_pk_bf16(v0[2], v0[3]); w.z = cvt_pk_bf16(v1[0], v1[1]); w.w = cvt_pk_bf16(v1[2], v1[3]);
                        *(u32x4*)(rowp + bj * HALF) = w; } }
        } else {
            const int c0 = (u.pn - 6) * HALF + wc * 32 + 8 * fq;
#pragma unroll
            for (int ai = 0; ai < 2; ++ai)
#pragma unroll
                for (int m = 0; m < 4; ++m) { const int row = row0 + ai * HALF + m * 16; const float rs = rstd[row];
                    float o[8];
#pragma unroll
                    for (int n = 0; n < 2; ++n)
#pragma unroll
                        for (int e = 0; e < 4; ++e) { const float a = acc[ai][0][m][n][e] * rs, g = acc[ai][1][m][n][e] * rs; o[n * 4 + e] = a * __builtin_amdgcn_rcpf(1.0f + __expf(-g)); }
                    u32x4 w; w.x = cvt_pk_bf16(o[0], o[1]); w.y = cvt_pk_bf16(o[2], o[3]); w.z = cvt_pk_bf16(o[4], o[5]); w.w = cvt_pk_bf16(o[6], o[7]);
                    *(u32x4*)(U + (size_t)row * 1024 + c0) = w; }
        }
    }
};
struct EpiOut {
    static constexpr bool PERM = true, AFTER_DRAIN = false;
    const float* xp; const float* xs; float* out; bf16_t* XB; float* ssq;
    __device__ __forceinline__ void operator()(const f32x4 (&acc)[2][2][4][2], const Unit& u, int wr, int wc, int fr, int fq) const {
        const int row0 = u.pm * BM + wr * 64 + fr, col0 = u.pn * BM + wc * 32 + 8 * fq;
        const float* xb = (u.pm < 128) ? xp : (xs - (size_t)32768 * 2048);
#pragma unroll
        for (int ai = 0; ai < 2; ++ai)
#pragma unroll
            for (int m = 0; m < 4; ++m) { const int row = row0 + ai * HALF + m * 16; const size_t ro = (size_t)row * 2048 + col0; float q = 0.f;
#pragma unroll
                for (int bj = 0; bj < 2; ++bj) { const f32x4 x0 = *(const f32x4*)(xb + ro + bj * HALF), x1 = *(const f32x4*)(xb + ro + bj * HALF + 4);
                    const f32x4 v0 = acc[ai][bj][m][0] + x0, v1 = acc[ai][bj][m][1] + x1;
                    *(f32x4*)(out + ro + bj * HALF) = v0; *(f32x4*)(out + ro + bj * HALF + 4) = v1;
                    u32x4 w; w.x = cvt_pk_bf16(v0[0], v0[1]); w.y = cvt_pk_bf16(v0[2], v0[3]); w.z = cvt_pk_bf16(v1[0], v1[1]); w.w = cvt_pk_bf16(v1[2], v1[3]);
                    *(u32x4*)(XB + ro + bj * HALF) = w;
                    q += (v0[0] * v0[0] + v0[1] * v0[1]) + (v0[2] * v0[2] + v0[3] * v0[3]) + (v1[0] * v1[0] + v1[1] * v1[1]) + (v1[2] * v1[2] + v1[3] * v1[3]); }
                q += __shfl_xor(q, 16); q += __shfl_xor(q, 32);
                if (fq == 0) ssq[(size_t)row * 32 + u.pn * 4 + wc] = q; }
    }
};
struct EpiUp {
    static constexpr bool PERM = true, AFTER_DRAIN = false;
    bf16_t* H;
    __device__ __forceinline__ void operator()(const f32x4 (&acc)[2][2][4][2], const Unit& u, int wr, int wc, int fr, int fq) const {
        const int row0 = u.pm * BM + wr * 64 + fr, col0 = u.pn * BM + wc * 32 + 8 * fq;
#pragma unroll
        for (int ai = 0; ai < 2; ++ai)
#pragma unroll
            for (int m = 0; m < 4; ++m) { bf16_t* rowp = H + (size_t)(row0 + ai * HALF + m * 16) * 8192 + col0;
#pragma unroll
                for (int bj = 0; bj < 2; ++bj) { f32x4 v0 = acc[ai][bj][m][0], v1 = acc[ai][bj][m][1];
#pragma unroll
                    for (int e = 0; e < 4; ++e) { const float a = fmaxf(v0[e], 0.f), b = fmaxf(v1[e], 0.f); v0[e] = a * a; v1[e] = b * b; }
                    u32x4 w; w.x = cvt_pk_bf16(v0[0], v0[1]); w.y = cvt_pk_bf16(v0[2], v0[3]); w.z = cvt_pk_bf16(v1[0], v1[1]); w.w = cvt_pk_bf16(v1[2], v1[3]);
                    *(u32x4*)(rowp + bj * HALF) = w; } }
    }
};
struct EpiDown {
    static constexpr bool PERM = true, AFTER_DRAIN = false;
    float* out; const float* r2;
    __device__ __forceinline__ void operator()(const f32x4 (&acc)[2][2][4][2], const Unit& u, int wr, int wc, int fr, int fq) const {
        const int row0 = u.pm * BM + wr * 64 + fr, col0 = u.pn * BM + wc * 32 + 8 * fq;
#pragma unroll
        for (int ai = 0; ai < 2; ++ai)
#pragma unroll
            for (int m = 0; m < 4; ++m) { const int row = row0 + ai * HALF + m * 16; const float s = r2[row]; float* rowp = out + (size_t)row * 2048 + col0;
#pragma unroll
                for (int bj = 0; bj < 2; ++bj) { const f32x4 x0 = *(const f32x4*)(rowp + bj * HALF), x1 = *(const f32x4*)(rowp + bj * HALF + 4);
                    *(f32x4*)(rowp + bj * HALF) = x0 + acc[ai][bj][m][0] * s; *(f32x4*)(rowp + bj * HALF + 4) = x1 + acc[ai][bj][m][1] * s; } }
    }
};

template <class Epi, class Sched, bool ALIGN_EPI = false, bool SP2 = false>
__device__ __forceinline__ void gemm_phase(PG8_LAS unsigned char* lds, const Gemm g, const Sched& S, const Epi& E) {
    const int tid = threadIdx.x, wid = __builtin_amdgcn_readfirstlane(tid >> 6), lane = tid & 63, wr = wid >> 2, wc = wid & 3, fr = lane & 15, fq = lane >> 4;
    const int K = g.K, nt = K / BK;
    unsigned voffA[2], voffB[2];
#pragma unroll
    for (int i = 0; i < 2; ++i) { int R, C; stage_rc(tid * 16 + i * 8192, R, C); const int Rb = Epi::PERM ? ((R & ~31) + perm32(R & 31)) : R;
        voffA[i] = (unsigned)(R * K + C) * 2u; voffB[i] = (unsigned)(Rb * K + C) * 2u; }
    const size_t kstep = (size_t)(BK * 2);
    const size_t hstep = (size_t)HALF * K * 2;
    const size_t tstep = 2 * hstep;
    const unsigned ldsw = (unsigned)wid * 1024u;
    const int aoff = lds_byte(wr * 64 + fr, fq * 8), boff = lds_byte(wc * 32 + fr, fq * 8);
#define PG8_SA(b, h) (((b) * 2 + (h)) * HTB)
#define PG8_SB(b, h) ((4 + (b) * 2 + (h)) * HTB)
#define PG8_STAGE(bufoff, gbase, voff) do { _Pragma("unroll") for (int _i = 0; _i < 2; ++_i) \
        __builtin_amdgcn_global_load_lds((const unsigned*)((const char*)(gbase) + (voff)[_i]), (PG8_LAS unsigned*)(lds + (bufoff) + ldsw + _i * 8192), 16, 0, 0); } while (0)
#define PG8_LDA(dst, b, h) do { _Pragma("unroll") for (int m = 0; m < 4; ++m) _Pragma("unroll") for (int k = 0; k < 2; ++k) dst[m][k] = *(const PG8_LAS bf16x8*)(lds + PG8_SA(b, h) + aoff + m * 2048 + k * 1024); } while (0)
#define PG8_LDB(dst, b, h) do { _Pragma("unroll") for (int n = 0; n < 2; ++n) _Pragma("unroll") for (int k = 0; k < 2; ++k) dst[n][k] = *(const PG8_LAS bf16x8*)(lds + PG8_SB(b, h) + boff + n * 2048 + k * 1024); } while (0)
#define PG8_MMA(ai, bj, At, Bt) do { __builtin_amdgcn_s_setprio(1); _Pragma("unroll") for (int m = 0; m < 4; ++m) _Pragma("unroll") for (int n = 0; n < 2; ++n) _Pragma("unroll") for (int k = 0; k < 2; ++k) \
        acc[ai][bj][m][n] = __builtin_amdgcn_mfma_f32_16x16x32_bf16(Bt[n][k], At[m][k], acc[ai][bj][m][n], 0, 0, 0); __builtin_amdgcn_s_setprio(0); } while (0)
#define PG8_WAIT_V(n) asm volatile("s_waitcnt vmcnt(" #n ")" ::: "memory")
#define PG8_WAIT_L(n) asm volatile("s_waitcnt lgkmcnt(" #n ")" ::: "memory")
#define PG8_BAR __builtin_amdgcn_s_barrier()
#define PG8_SCHED __builtin_amdgcn_sched_barrier(0)
    Unit cur, nxt; int ui = 0;
    if (!S.next(0, cur)) return;
    f32x4 acc[2][2][4][2];
#pragma unroll
    for (int a = 0; a < 2; ++a)
#pragma unroll
        for (int b = 0; b < 2; ++b)
#pragma unroll
            for (int m = 0; m < 4; ++m)
#pragma unroll
                for (int n = 0; n < 2; ++n) acc[a][b][m][n] = (f32x4){0.f, 0.f, 0.f, 0.f};
    bf16x8 At[4][2], B0[2][2], B1[2][2];
    const char* cA = (const char*)g.A + (size_t)cur.pm * tstep; const char* cB = (const char*)g.Bt + (size_t)cur.pn * tstep;
    S.a_ready(cur);
    if constexpr (SP2) {
        PG8_STAGE(PG8_SB(0, 0), cB, voffB); PG8_STAGE(PG8_SB(0, 1), cB + hstep, voffB); PG8_STAGE(PG8_SA(0, 0), cA, voffA); PG8_STAGE(PG8_SA(0, 1), cA + hstep, voffA);
        if (wr == 1) PG8_BAR;
        PG8_WAIT_V(2); PG8_BAR;
        PG8_STAGE(PG8_SB(1, 0), cB + kstep, voffB); PG8_STAGE(PG8_SA(1, 0), cA + kstep, voffA); PG8_STAGE(PG8_SB(1, 1), cB + hstep + kstep, voffB);
        PG8_WAIT_V(6); PG8_BAR;
    } else {
        PG8_STAGE(PG8_SB(0, 0), cB, voffB); PG8_STAGE(PG8_SA(0, 0), cA, voffA); PG8_STAGE(PG8_SB(0, 1), cB + hstep, voffB); PG8_STAGE(PG8_SA(0, 1), cA + hstep, voffA);
        if (wr == 1) PG8_BAR;
        PG8_WAIT_V(4); PG8_BAR;
        PG8_STAGE(PG8_SB(1, 0), cB + kstep, voffB); PG8_STAGE(PG8_SA(1, 0), cA + kstep, voffA); PG8_STAGE(PG8_SB(1, 1), cB + hstep + kstep, voffB);
        PG8_WAIT_V(6); PG8_BAR;
    }
    for (;;) {
        const bool has_next = S.next(ui + 1, nxt);
        const char* nA = has_next ? (const char*)g.A + (size_t)nxt.pm * tstep : cA; const char* nB = has_next ? (const char*)g.Bt + (size_t)nxt.pn * tstep : cB;
        for (int t = 0; t < nt; t += 2) {
            const bool last = (t == nt - 2);
            const char* a1 = cA + (size_t)(t + 1) * kstep;
            const char* a2 = last ? nA : cA + (size_t)(t + 2) * kstep; const char* b2 = last ? nB : cB + (size_t)(t + 2) * kstep;
            const char* a3 = a2 + kstep; const char* b3 = b2 + kstep;
            if (last && has_next) S.a_ready(nxt);
            if constexpr (SP2) {
            PG8_LDB(B0, 0, 0); PG8_LDB(B1, 0, 1); PG8_SCHED; PG8_LDA(At, 0, 0); PG8_STAGE(PG8_SA(1, 1), a1 + hstep, voffA);
            PG8_WAIT_V(8); PG8_WAIT_L(0); PG8_BAR; PG8_MMA(0, 0, At, B0); PG8_MMA(0, 1, At, B1); PG8_BAR; PG8_SCHED;
            PG8_LDA(At, 0, 1); PG8_STAGE(PG8_SB(0, 0), b2, voffB); PG8_STAGE(PG8_SB(0, 1), b2 + hstep, voffB); PG8_STAGE(PG8_SA(0, 0), a2, voffA);
            PG8_WAIT_V(8); PG8_WAIT_L(0); PG8_BAR; PG8_MMA(1, 0, At, B0); PG8_MMA(1, 1, At, B1); PG8_BAR; PG8_SCHED;
            PG8_LDB(B0, 1, 0); PG8_LDB(B1, 1, 1); PG8_SCHED; PG8_LDA(At, 1, 0); PG8_STAGE(PG8_SA(0, 1), a2 + hstep, voffA);
            PG8_WAIT_V(8); PG8_WAIT_L(0); PG8_BAR; PG8_MMA(0, 0, At, B0); PG8_MMA(0, 1, At, B1); PG8_BAR; PG8_SCHED;
            PG8_LDA(At, 1, 1); PG8_STAGE(PG8_SB(1, 0), b3, voffB); PG8_STAGE(PG8_SB(1, 1), b3 + hstep, voffB); PG8_STAGE(PG8_SA(1, 0), a3, voffA);
            PG8_WAIT_V(8); PG8_WAIT_L(0); PG8_BAR; PG8_MMA(1, 0, At, B0); PG8_MMA(1, 1, At, B1); PG8_BAR; PG8_SCHED;
            } else {
            PG8_LDB(B0, 0, 0); PG8_SCHED; PG8_LDA(At, 0, 0); PG8_STAGE(PG8_SA(1, 1), a1 + hstep, voffA);
            PG8_WAIT_L(8); PG8_BAR; PG8_WAIT_L(0); PG8_MMA(0, 0, At, B0); PG8_BAR; PG8_SCHED;
            PG8_LDB(B1, 0, 1); PG8_STAGE(PG8_SB(0, 0), b2, voffB);
            PG8_BAR; PG8_WAIT_L(0); PG8_MMA(0, 1, At, B1); PG8_BAR;
            PG8_LDA(At, 0, 1); PG8_STAGE(PG8_SA(0, 0), a2, voffA);
            PG8_BAR; PG8_WAIT_L(0); PG8_MMA(1, 0, At, B0); PG8_BAR; PG8_SCHED;
            PG8_STAGE(PG8_SB(0, 1), b2 + hstep, voffB);
            PG8_WAIT_V(6); PG8_BAR; PG8_MMA(1, 1, At, B1); PG8_BAR;
            PG8_LDB(B0, 1, 0); PG8_SCHED; PG8_LDA(At, 1, 0); PG8_STAGE(PG8_SA(0, 1), a2 + hstep, voffA);
            PG8_WAIT_L(8); PG8_BAR; PG8_WAIT_L(0); PG8_MMA(0, 0, At, B0); PG8_BAR; PG8_SCHED;
            PG8_LDB(B1, 1, 1); PG8_STAGE(PG8_SB(1, 0), b3, voffB);
            PG8_BAR; PG8_WAIT_L(0); PG8_MMA(0, 1, At, B1); PG8_BAR;
            PG8_LDA(At, 1, 1); PG8_STAGE(PG8_SA(1, 0), a3, voffA);
            PG8_BAR; PG8_WAIT_L(0); PG8_MMA(1, 0, At, B0); PG8_BAR; PG8_SCHED;
            PG8_STAGE(PG8_SB(1, 1), b3 + hstep, voffB);
            PG8_WAIT_V(6); PG8_BAR; PG8_MMA(1, 1, At, B1); PG8_BAR;
            }
        }
        if constexpr (ALIGN_EPI) { if (wr == 0) PG8_BAR; }
        if constexpr (!Epi::AFTER_DRAIN) { E(acc, cur, wr, wc, fr, fq); S.done(cur); }
        if (!has_next) break;
#pragma unroll
        for (int a = 0; a < 2; ++a)
#pragma unroll
            for (int b = 0; b < 2; ++b)
#pragma unroll
                for (int m = 0; m < 4; ++m)
#pragma unroll
                    for (int n = 0; n < 2; ++n) acc[a][b][m][n] = (f32x4){0.f, 0.f, 0.f, 0.f};
        cur = nxt; cA = nA; cB = nB; ++ui;
        if constexpr (ALIGN_EPI) { if (wr == 1) PG8_BAR; }
    }
    PG8_WAIT_V(0);
    if constexpr (!ALIGN_EPI) { if (wr == 0) PG8_BAR; }
    PG8_BAR;
    if constexpr (Epi::AFTER_DRAIN) { E.fused(acc, cur, wr, wc, fr, fq, lds, wid, lane); S.done(cur); }
#undef PG8_SA
#undef PG8_SB
#undef PG8_STAGE
#undef PG8_LDA
#undef PG8_LDB
#undef PG8_MMA
#undef PG8_WAIT_V
#undef PG8_WAIT_L
#undef PG8_BAR
#undef PG8_SCHED
}
}

constexpr int NWAVES = 8;
constexpr int DM = 2048, NB = 16, SEQ = 2048, DB = 128, DS = 4, HD = 64, NH = 16, NKV = 4, CCH = 1024, CW = 31, FF = 8192;
constexpr int MP = NB * SEQ, MS = DB * DS, M = MP + MS;
constexpr int INW = 3584, ZW = 1536;
constexpr float EPS = 1e-6f;
constexpr float QSCALE = 0.125f * 1.4426950408889634f;
constexpr float LOG2E = 1.4426950408889634f;
constexpr size_t O_Y = 0, O_KP = (size_t)M * DM, O_VP = O_KP + (size_t)NB * 128 * 256, O_CP = O_VP + (size_t)NB * 128 * 256,
                 O_KS = O_CP + (size_t)NB * 30 * CCH, O_VS = O_KS + (size_t)DB * 128 * 256, O_CS = O_VS + (size_t)DB * 128 * 256, O_END = O_CS + (size_t)DB * 30 * CCH;
constexpr size_t MiB = 1u << 20;
constexpr size_t WS_CTL = 0, CTL_ZERO_BYTES = 64 * 1024;
constexpr size_t WS_WIN = 1 * MiB, WS_WOUT = 15 * MiB, WS_WUP = 23 * MiB, WS_WDN = 55 * MiB;
constexpr size_t WS_RSTD1 = 87 * MiB, WS_R2 = 88 * MiB, WS_SSQ = 89 * MiB;
constexpr size_t WS_XB = 94 * MiB;
constexpr size_t WS_Z = 224 * MiB, WS_U = 322 * MiB, WS_MIX = 387 * MiB;
constexpr size_t WS_H = 224 * MiB, WS_END = 744 * MiB;
static_assert(WS_Z + (size_t)M * ZW * 2 <= WS_U && WS_U + (size_t)M * CCH * 2 <= WS_MIX && WS_MIX + (size_t)M * DM * 2 <= WS_END && WS_H + (size_t)M * FF * 2 <= WS_END, "d_ws map");
static_assert(WS_XB + (size_t)M * DM * 2 <= WS_Z && WS_SSQ + (size_t)M * 32 * 4 <= WS_XB && WS_WIN + (size_t)INW * DM * 2 <= WS_WOUT, "d_ws map");
constexpr int CW_BAR = 4096;
constexpr int RING_BYTES = 131072, MISC_OFF = RING_BYTES + 320, LDS_BYTES = 147456;
#define GAS __attribute__((address_space(1)))
#define LAS __attribute__((address_space(3)))
typedef unsigned short bf16;
typedef unsigned v4u __attribute__((ext_vector_type(4)));
typedef float f32x4 __attribute__((ext_vector_type(4)));
typedef short bf16x8 __attribute__((ext_vector_type(8)));
typedef GAS unsigned gu32;
typedef GAS unsigned long long gu64;
#define RLX_AGENT __ATOMIC_RELAXED, __HIP_MEMORY_SCOPE_AGENT
#define LDS_WAIT() asm volatile("s_waitcnt lgkmcnt(0)" ::: "memory")
#define VM_WAIT() asm volatile("s_waitcnt vmcnt(0)" ::: "memory")
__device__ __forceinline__ unsigned long long rt() { return __builtin_amdgcn_s_memrealtime(); }
__device__ __forceinline__ unsigned f2bf(float f) { unsigned u = __builtin_bit_cast(unsigned, f); return (u + 0x7fffu + ((u >> 16) & 1u)) >> 16; }
__device__ __forceinline__ unsigned pk2(float lo, float hi) { return f2bf(lo) | (f2bf(hi) << 16); }

#define XB_TMO      128
#define XB_XCNT(j)  (256  + 64 * (j))
#define XB_XSUB(j)  (1280 + 64 * (j))
#define XB_XGEN(j)  (2304 + 64 * (j))
#define XB_TOP      3328
#define XB_TOPGEN   3392
#define XCD_BAR_WORDS 3456
#define XB_SPIN_CAP (1u << 18)

__device__ __forceinline__ unsigned xb_ld(unsigned* p)              { return __hip_atomic_load(p, __ATOMIC_RELAXED, __HIP_MEMORY_SCOPE_AGENT); }
__device__ __forceinline__ unsigned xb_add(unsigned* p, unsigned v) { return __hip_atomic_fetch_add(p, v, __ATOMIC_RELAXED, __HIP_MEMORY_SCOPE_AGENT); }
__device__ __forceinline__ unsigned xb_xcc_id() { return (unsigned)__builtin_amdgcn_s_getreg((3 << 11) | 20) & 0xFu; }
#define XB_SPIN(cond, bar) do { unsigned _sp = 0; while (cond) { __builtin_amdgcn_s_sleep(1); \
    if ((++_sp & 255u) == 0u) { if (xb_ld(&(bar)[XB_TMO])) break; if (_sp > XB_SPIN_CAP) { atomicAdd(&(bar)[XB_TMO], 1u); break; } } } } while (0)

struct XcdBarrier {
    unsigned* bar; unsigned x;
    volatile LAS unsigned* st;
};

__device__ __forceinline__ XcdBarrier xcd_barrier_post(unsigned* bar, volatile LAS unsigned* st) {
    XcdBarrier b; b.bar = bar; b.x = xb_xcc_id(); b.st = st;
    if (threadIdx.x == 0) (void)xb_add(&bar[XB_XCNT(b.x)], 1u);
    return b;
}
__device__ __forceinline__ void xcd_barrier_complete(unsigned* bar, unsigned x, unsigned& nloc, unsigned& nx) {
    const unsigned G = gridDim.x * gridDim.y * gridDim.z;
    unsigned sum, cnt, mine, sp = 0u;
    for (;;) {
        sum = 0u; cnt = 0u; mine = 0u;
#pragma unroll
        for (unsigned j = 0; j < 16; ++j) { const unsigned c = xb_ld(&bar[XB_XCNT(j)]); sum += c; cnt += (c > 0u) ? 1u : 0u; mine = (j == x) ? c : mine; }
        if (sum == G) break;
        __builtin_amdgcn_s_sleep(1);
        if ((++sp & 255u) == 0u) { if (xb_ld(&bar[XB_TMO])) break; if (sp > XB_SPIN_CAP) { atomicAdd(&bar[XB_TMO], 1u); break; } }
    }
    nloc = mine > 0u ? mine : 1u; nx = cnt > 0u ? cnt : 1u;
}

__device__ __forceinline__ void xcd_barrier(const XcdBarrier& b) {
    asm volatile("s_waitcnt vmcnt(0)" ::: "memory");
    __syncthreads();
    if (threadIdx.x == 0) {
        unsigned* bar = b.bar;
        __builtin_amdgcn_s_waitcnt(0);
        unsigned nloc = b.st[0], nx = b.st[1];
        if (nloc == 0u) { xcd_barrier_complete(bar, b.x, nloc, nx); b.st[0] = nloc; b.st[1] = nx; }
        const unsigned old = xb_add(&bar[XB_XSUB(b.x)], 1u);
        const unsigned gen = old / nloc;
        if (old + 1u == (gen + 1u) * nloc) {
            __builtin_amdgcn_fence(__ATOMIC_RELEASE, "agent");
            asm volatile("s_waitcnt vmcnt(0)" ::: "memory");
            const unsigned og = xb_add(&bar[XB_TOP], 1u);
            const unsigned tg = og / nx;
            if (og + 1u == (tg + 1u) * nx) xb_add(&bar[XB_TOPGEN], 1u);
            else XB_SPIN(xb_ld(&bar[XB_TOPGEN]) == tg, bar);
            __builtin_amdgcn_fence(__ATOMIC_ACQUIRE, "agent");
            xb_add(&bar[XB_XGEN(b.x)], 1u);
            asm volatile("s_waitcnt vmcnt(0)" ::: "memory");
        } else {
            XB_SPIN(xb_ld(&bar[XB_XGEN(b.x)]) == gen, bar);
            __builtin_amdgcn_fence(__ATOMIC_ACQUIRE, "agent");
            asm volatile("s_waitcnt vmcnt(0)" ::: "memory");
        }
    }
    __syncthreads();
}

typedef float f32x2 __attribute__((ext_vector_type(2)));
typedef float f32x16 __attribute__((ext_vector_type(16)));
typedef short s16x4 __attribute__((ext_vector_type(4)));
__device__ __forceinline__ unsigned cvtpk(float lo, float hi) { unsigned r; asm volatile("v_cvt_pk_bf16_f32 %0, %1, %2" : "=v"(r) : "v"(lo), "v"(hi)); return r; }
__device__ __forceinline__ float bf_lo(unsigned u) { return __builtin_bit_cast(float, u << 16); }
__device__ __forceinline__ float bf_hi(unsigned u) { return __builtin_bit_cast(float, u & 0xffff0000u); }
__device__ __forceinline__ float wave_sum(float v) {
#pragma unroll
    for (int o = 1; o < 64; o <<= 1) v += __shfl_xor(v, o);
    return v;
}

__device__ __forceinline__ void p0_transpose_item(const float* W, const float* gain, int K, int N, bf16* WT, int rowmap, LAS float* scr, int item, int lane) {
    const int nblk = N / 32, kb = item / nblk, nb = item % nblk, k0 = 64 * kb, n0 = 32 * nb;
#pragma unroll 8
    for (int i = 0; i < 32; ++i) { const int kk = 2 * i + (lane >> 5); const float g = gain ? gain[k0 + kk] : 1.0f; scr[kk * 33 + (lane & 31)] = W[(size_t)(k0 + kk) * N + n0 + (lane & 31)] * g; }
    LDS_WAIT(); asm volatile("" ::: "memory");
    int nd0 = n0;
    if (rowmap == 1 && n0 >= ZW) { int c = n0 - ZW; if (c < CCH) nd0 = ZW + 256 * (c >> 7) + (c & 127); else { c -= CCH; nd0 = ZW + 256 * (c >> 7) + 128 + (c & 127); } }
    const int c = lane & 7;
#pragma unroll
    for (int j = 0; j < 4; ++j) { const int n = (lane >> 3) + 8 * j; const LAS float* s = scr + (8 * c) * 33 + n;
        v4u o; o.x = pk2(s[0 * 33], s[1 * 33]); o.y = pk2(s[2 * 33], s[3 * 33]); o.z = pk2(s[4 * 33], s[5 * 33]); o.w = pk2(s[6 * 33], s[7 * 33]);
        *(GAS v4u*)(WT + (size_t)(nd0 + n) * K + k0 + 8 * c) = o; }
    LDS_WAIT(); asm volatile("" ::: "memory");
}
__device__ __forceinline__ void x_row_to_bf16(const float* xrow, bf16* orow, float* rstd_out, int lane) {
    const GAS f32x4* xr = (const GAS f32x4*)xrow + lane;
    f32x4 v[8]; float s = 0.f;
#pragma unroll
    for (int j = 0; j < 8; ++j) { v[j] = xr[64 * j]; s += (v[j].x * v[j].x + v[j].y * v[j].y) + (v[j].z * v[j].z + v[j].w * v[j].w); }
    s = wave_sum(s);
    if (lane == 0) *rstd_out = 1.0f / sqrtf(s * (1.0f / DM) + EPS);
    GAS unsigned long long* o8 = (GAS unsigned long long*)orow + lane;
#pragma unroll
    for (int j = 0; j < 8; ++j) o8[64 * j] = (unsigned long long)cvtpk(v[j].x, v[j].y) | ((unsigned long long)cvtpk(v[j].z, v[j].w) << 32);
}

constexpr int KV_RS = 144;
__device__ __forceinline__ int crow(int r, int hi) { return (r & 3) + 8 * (r >> 2) + 4 * hi; }
__device__ __forceinline__ s16x4 vtr(const LAS unsigned char* p) { return __builtin_bit_cast(s16x4, __builtin_amdgcn_ds_read_tr16_b64_v4i16((LAS s16x4*)p)); }

__device__ __forceinline__ void load_q(const bf16* qrow, int h, const float* gq, bf16x8 (&qf)[4]) {
    float v[4][8]; float ss = 0.f;
#pragma unroll
    for (int d0 = 0; d0 < 4; ++d0) { const v4u raw = *(const v4u*)(qrow + 16 * d0 + 8 * h);
#pragma unroll
        for (int e = 0; e < 4; ++e) { v[d0][2 * e] = bf_lo(raw[e]); v[d0][2 * e + 1] = bf_hi(raw[e]); ss += v[d0][2 * e] * v[d0][2 * e] + v[d0][2 * e + 1] * v[d0][2 * e + 1]; } }
    ss += __shfl_xor(ss, 32);
    const float rs = (1.0f / sqrtf(ss * (1.0f / HD) + EPS)) * QSCALE;
#pragma unroll
    for (int d0 = 0; d0 < 4; ++d0) { const f32x4 g0 = *(const f32x4*)(gq + 16 * d0 + 8 * h), g1 = *(const f32x4*)(gq + 16 * d0 + 8 * h + 4);
        v4u w; w.x = cvtpk(v[d0][0] * rs * g0[0], v[d0][1] * rs * g0[1]); w.y = cvtpk(v[d0][2] * rs * g0[2], v[d0][3] * rs * g0[3]);
        w.z = cvtpk(v[d0][4] * rs * g1[0], v[d0][5] * rs * g1[1]); w.w = cvtpk(v[d0][6] * rs * g1[2], v[d0][7] * rs * g1[3]);
        qf[d0] = __builtin_bit_cast(bf16x8, w); }
}
__device__ __forceinline__ void attn_core(const LAS unsigned char* Kt, const LAS unsigned char* Vt, int tt0, int qrel, int kvmin, const bf16x8 (&qf)[4], float sink2, int lane, f32x16 (&o)[2]) {
    const int r32 = lane & 31, h = lane >> 5;
    f32x16 s[5];
#pragma unroll
    for (int i = 0; i < 5; ++i) {
        const LAS unsigned char* kp = Kt + (32 * (tt0 + i) + r32) * KV_RS + h * 16;
        f32x16 a = {0.f, 0.f, 0.f, 0.f, 0.f, 0.f, 0.f, 0.f, 0.f, 0.f, 0.f, 0.f, 0.f, 0.f, 0.f, 0.f};
#pragma unroll
        for (int d0 = 0; d0 < 4; ++d0) { const bf16x8 kf = *(const LAS bf16x8*)(kp + 32 * d0); a = __builtin_amdgcn_mfma_f32_32x32x16_bf16(kf, qf[d0], a, 0, 0, 0); }
        s[i] = a;
    }
    float mx = -1e30f;
#pragma unroll
    for (int i = 0; i < 5; ++i)
#pragma unroll
        for (int r = 0; r < 16; ++r) { const int kv = 32 * (tt0 + i) + crow(r, h); const bool ok = (kv > qrel) && (kv <= qrel + 128) && (kv >= kvmin); const float x = ok ? s[i][r] : -1e30f; s[i][r] = x; mx = fmaxf(mx, x); }
    mx = fmaxf(mx, __shfl_xor(mx, 32));
    const float mref = fmaxf(mx, sink2);
    float ls = 0.f;
#pragma unroll
    for (int i = 0; i < 5; ++i)
#pragma unroll
        for (int r = 0; r < 16; ++r) { const float p = __builtin_amdgcn_exp2f(s[i][r] - mref); s[i][r] = p; ls += p; }
    ls += __shfl_xor(ls, 32);
    const float inv = 1.0f / (ls + __builtin_amdgcn_exp2f(sink2 - mref));
    o[0] = (f32x16){0.f, 0.f, 0.f, 0.f, 0.f, 0.f, 0.f, 0.f, 0.f, 0.f, 0.f, 0.f, 0.f, 0.f, 0.f, 0.f}; o[1] = o[0];
    const LAS unsigned char* vb = Vt + (4 * h + ((lane & 15) >> 2)) * KV_RS + ((lane >> 4) & 1) * 32 + (lane & 3) * 8;
#pragma unroll
    for (int i = 0; i < 5; ++i)
#pragma unroll
        for (int st = 0; st < 2; ++st) {
            v4u pw; pw.x = cvtpk(s[i][8 * st + 0], s[i][8 * st + 1]); pw.y = cvtpk(s[i][8 * st + 2], s[i][8 * st + 3]); pw.z = cvtpk(s[i][8 * st + 4], s[i][8 * st + 5]); pw.w = cvtpk(s[i][8 * st + 6], s[i][8 * st + 7]);
            const bf16x8 pf = __builtin_bit_cast(bf16x8, pw);
#pragma unroll
            for (int dt = 0; dt < 2; ++dt) {
                const LAS unsigned char* vp = vb + (32 * (tt0 + i) + 16 * st) * KV_RS + dt * 64;
                const s16x4 lo = vtr(vp), hi = vtr(vp + 8 * KV_RS);
                const bf16x8 vf = (bf16x8){lo[0], lo[1], lo[2], lo[3], hi[0], hi[1], hi[2], hi[3]};
                o[dt] = __builtin_amdgcn_mfma_f32_32x32x16_bf16(vf, pf, o[dt], 0, 0, 0);
            }
        }
#pragma unroll
    for (int dt = 0; dt < 2; ++dt)
#pragma unroll
        for (int r = 0; r < 16; ++r) o[dt][r] *= inv;
}
__device__ __forceinline__ void store_o(bf16* orow, int h, const f32x16 (&o)[2]) {
#pragma unroll
    for (int dt = 0; dt < 2; ++dt)
#pragma unroll
        for (int g = 0; g < 4; ++g) { unsigned long long w = (unsigned long long)cvtpk(o[dt][4 * g], o[dt][4 * g + 1]) | ((unsigned long long)cvtpk(o[dt][4 * g + 2], o[dt][4 * g + 3]) << 32);
            *(unsigned long long*)(orow + 32 * dt + 8 * g + 4 * h) = w; }
}
__device__ __forceinline__ void knorm32(const v4u (&raw)[4], const float* gk32, float (&kf)[32]) {
    float ss = 0.f;
#pragma unroll
    for (int i = 0; i < 4; ++i)
#pragma unroll
        for (int e = 0; e < 4; ++e) { kf[8 * i + 2 * e] = bf_lo(raw[i][e]); kf[8 * i + 2 * e + 1] = bf_hi(raw[i][e]); ss += kf[8 * i + 2 * e] * kf[8 * i + 2 * e] + kf[8 * i + 2 * e + 1] * kf[8 * i + 2 * e + 1]; }
    ss += __shfl_xor(ss, 1);
    const float rs = 1.0f / sqrtf(ss * (1.0f / HD) + EPS);
#pragma unroll
    for (int i = 0; i < 8; ++i) { const f32x4 g = *(const f32x4*)(gk32 + 4 * i);
#pragma unroll
        for (int e = 0; e < 4; ++e) kf[4 * i + e] = kf[4 * i + e] * rs * g[e]; }
}
__device__ __forceinline__ void lds_put32(LAS unsigned char* dst, const float (&f)[32]) {
#pragma unroll
    for (int i = 0; i < 4; ++i) { v4u w; w.x = cvtpk(f[8 * i], f[8 * i + 1]); w.y = cvtpk(f[8 * i + 2], f[8 * i + 3]); w.z = cvtpk(f[8 * i + 4], f[8 * i + 5]); w.w = cvtpk(f[8 * i + 6], f[8 * i + 7]); *(LAS v4u*)(dst + 16 * i) = w; }
}
__device__ __forceinline__ void glb_put32(float* dst, const float (&f)[32]) {
#pragma unroll
    for (int i = 0; i < 8; ++i) *(f32x4*)(dst + 4 * i) = (f32x4){f[4 * i], f[4 * i + 1], f[4 * i + 2], f[4 * i + 3]};
}

struct P2Args { const bf16* Z; const bf16* U; bf16* MIX; const float *ck, *cv, *sc, *gq, *gk, *sinks, *wdw, *bdw, *gln, *bln; float* out; };

__device__ __forceinline__ void attn_prompt_unit(const P2Args& A, LAS unsigned char* lds, int b, int qb, int hk, int tid, int lane, int wave) {
    LAS unsigned char* Kt = lds; LAS unsigned char* Vt = lds + 49152;
    {   const int r = tid >> 1, half = tid & 1, t = 128 * (qb - 1) + r;
        v4u kr[4], vr[4];
        if (t >= 0) { const bf16* zr = A.Z + (size_t)(b * SEQ + t) * ZW + hk * HD + half * 32;
#pragma unroll
            for (int i = 0; i < 4; ++i) { kr[i] = *(const v4u*)(zr + 1024 + 8 * i); vr[i] = *(const v4u*)(zr + 1280 + 8 * i); } }
        else {
#pragma unroll
            for (int i = 0; i < 4; ++i) { kr[i] = (v4u){0u, 0u, 0u, 0u}; vr[i] = (v4u){0u, 0u, 0u, 0u}; } }
        float kf[32]; knorm32(kr, A.gk + half * 32, kf);
        lds_put32(Kt + r * KV_RS + half * 64, kf);
#pragma unroll
        for (int i = 0; i < 4; ++i) *(LAS v4u*)(Vt + r * KV_RS + half * 64 + 16 * i) = vr[i];
        if (qb == 15 && r >= 128) {
            const size_t oo = ((size_t)(b * 128 + (r - 128)) * NKV + hk) * HD + half * 32;
            glb_put32(A.out + O_KP + oo, kf);
            float vf[32];
#pragma unroll
            for (int i = 0; i < 4; ++i)
#pragma unroll
                for (int e = 0; e < 4; ++e) { vf[8 * i + 2 * e] = bf_lo(vr[i][e]); vf[8 * i + 2 * e + 1] = bf_hi(vr[i][e]); }
            glb_put32(A.out + O_VP + oo, vf);
        }
    }
    __syncthreads();
#pragma unroll 1
    for (int w2 = 0; w2 < 2; ++w2) {
        const int wu = wave * 2 + w2, g = wu >> 2, q0 = (wu & 3) * 32, r32 = lane & 31, h = lane >> 5, head = hk * 4 + g;
        const size_t row = (size_t)b * SEQ + 128 * qb + q0 + r32;
        bf16x8 qf[4]; load_q(A.Z + row * ZW + head * HD, h, A.gq, qf);
        f32x16 o[2];
        attn_core(Kt, Vt, q0 >> 5, q0 + r32, qb == 0 ? 128 : 0, qf, A.sinks[head] * LOG2E, lane, o);
        store_o(A.MIX + row * DM + head * HD, h, o);
    }
    __syncthreads();
}
__device__ __forceinline__ void attn_sample_unit(const P2Args& A, LAS unsigned char* lds, int b, int hp, int tid, int lane, int wave) {
    LAS unsigned char* Kt = lds; LAS unsigned char* Vt = lds + 49152;
#pragma unroll 1
    for (int it = 0; it < 2; ++it) {
        const int task = tid + it * 512;
        if (task < 640) {
            const int hl = task / 320, rem = task % 320, r = rem >> 1, half = rem & 1, hk = 2 * hp + hl;
            LAS unsigned char* kd = Kt + hl * (160 * KV_RS) + r * KV_RS + half * 64; LAS unsigned char* vd = Vt + hl * (160 * KV_RS) + r * KV_RS + half * 64;
            float kf[32], vf[32];
            if (r < 128) {
                const size_t io = ((size_t)(b * 128 + r) * NKV + hk) * HD + half * 32;
#pragma unroll
                for (int i = 0; i < 8; ++i) { const f32x4 a = *(const f32x4*)(A.ck + io + 4 * i), c = *(const f32x4*)(A.cv + io + 4 * i);
                    kf[4 * i] = a[0]; kf[4 * i + 1] = a[1]; kf[4 * i + 2] = a[2]; kf[4 * i + 3] = a[3]; vf[4 * i] = c[0]; vf[4 * i + 1] = c[1]; vf[4 * i + 2] = c[2]; vf[4 * i + 3] = c[3]; }
                if (r >= 4) { const size_t oo = ((size_t)(b * 128 + r - 4) * NKV + hk) * HD + half * 32; glb_put32(A.out + O_KS + oo, kf); glb_put32(A.out + O_VS + oo, vf); }
            } else if (r < 132) {
                const bf16* zr = A.Z + (size_t)(MP + b * DS + (r - 128)) * ZW + hk * HD + half * 32;
                v4u kr[4], vr[4];
#pragma unroll
                for (int i = 0; i < 4; ++i) { kr[i] = *(const v4u*)(zr + 1024 + 8 * i); vr[i] = *(const v4u*)(zr + 1280 + 8 * i); }
                knorm32(kr, A.gk + half * 32, kf);
#pragma unroll
                for (int i = 0; i < 4; ++i)
#pragma unroll
                    for (int e = 0; e < 4; ++e) { vf[8 * i + 2 * e] = bf_lo(vr[i][e]); vf[8 * i + 2 * e + 1] = bf_hi(vr[i][e]); }
                const size_t oo = ((size_t)(b * 128 + r - 4) * NKV + hk) * HD + half * 32; glb_put32(A.out + O_KS + oo, kf); glb_put32(A.out + O_VS + oo, vf);
            } else {
#pragma unroll
                for (int i = 0; i < 32; ++i) { kf[i] = 0.f; vf[i] = 0.f; }
            }
            lds_put32(kd, kf); lds_put32(vd, vf);
        }
    }
    __syncthreads();
    if (wave < 2) {
        const int hk = 2 * hp + wave, r32 = lane & 31, h = lane >> 5, g = (r32 >> 2) & 3, i = r32 & 3, head = hk * 4 + g;
        const size_t row = (size_t)MP + b * DS + i;
        bf16x8 qf[4]; load_q(A.Z + row * ZW + head * HD, h, A.gq, qf);
        f32x16 o[2];
        attn_core(Kt + wave * (160 * KV_RS), Vt + wave * (160 * KV_RS), 0, i, 0, qf, A.sinks[head] * LOG2E, lane, o);
        if (r32 < 16) store_o(A.MIX + row * DM + head * HD, h, o);
    }
    __syncthreads();
}

template <int TT, bool SAMPLE>
__device__ __forceinline__ void conv_unit(const P2Args& A, LAS unsigned char* lds, int b, int t0, const f32x2 (&w)[CW], f32x2 bdw, f32x2 gln, f32x2 bln, int tid) {
    LAS float* red = (LAS float*)lds; LAS float* fin = (LAS float*)(lds + 65536);
    const int c = 2 * tid;
    f32x2 acc[TT];
#pragma unroll
    for (int tt = 0; tt < TT; ++tt) acc[tt] = (f32x2){0.f, 0.f};
#pragma unroll
    for (int rr = 0; rr < TT + 30; ++rr) {
        f32x2 u2;
        if (SAMPLE) {
            if (rr < 30) u2 = *(const f32x2*)(A.sc + ((size_t)b * 30 + rr) * CCH + c);
            else { const unsigned raw = *(const unsigned*)(A.U + (size_t)(MP + b * DS + rr - 30) * CCH + c); u2 = (f32x2){bf_lo(raw), bf_hi(raw)}; }
            if (rr >= DS) *(f32x2*)(A.out + O_CS + ((size_t)b * 30 + rr - DS) * CCH + c) = u2;
        } else {
            const int t = t0 - 30 + rr;
            if (t >= 0) { const unsigned raw = *(const unsigned*)(A.U + (size_t)(b * SEQ + t) * CCH + c); u2 = (f32x2){bf_lo(raw), bf_hi(raw)}; } else u2 = (f32x2){0.f, 0.f};
            if (rr >= 30 && t >= SEQ - 30) *(f32x2*)(A.out + O_CP + ((size_t)b * 30 + t - (SEQ - 30)) * CCH + c) = u2;
        }
#pragma unroll
        for (int tt = 0; tt < TT; ++tt) { const int j = rr - tt; if (j >= 0 && j < CW) acc[tt] += w[j] * u2; }
    }
#pragma unroll
    for (int tt = 0; tt < TT; ++tt) { const f32x2 y = acc[tt] + bdw; acc[tt] = y; red[(2 * tt) * 512 + tid] = y.x + y.y; red[(2 * tt + 1) * 512 + tid] = y.x * y.x + y.y * y.y; }
    __syncthreads();
    {   constexpr int NV = 2 * TT, PER = 512 / NV;
        const int v = tid / PER, p = tid % PER; float s = 0.f;
#pragma unroll
        for (int k = 0; k < NV; ++k) s += red[v * 512 + k * PER + p];
#pragma unroll
        for (int o = 1; o < PER; o <<= 1) s += __shfl_xor(s, o);
        if (p == 0) fin[v] = s; }
    __syncthreads();
#pragma unroll
    for (int tt = 0; tt < TT; ++tt) {
        const float mean = fin[2 * tt] * (1.0f / CCH), var = fin[2 * tt + 1] * (1.0f / CCH) - mean * mean, rstd = 1.0f / sqrtf(var + EPS);
        const f32x2 val = (acc[tt] - mean) * rstd * gln + bln;
        const float o0 = val.x * __builtin_amdgcn_rcpf(1.0f + __expf(-val.x)), o1 = val.y * __builtin_amdgcn_rcpf(1.0f + __expf(-val.y));
        const size_t row = SAMPLE ? (size_t)(MP + b * DS + tt) : (size_t)(b * SEQ + t0 + tt);
        *(unsigned*)(A.MIX + row * DM + 1024 + c) = cvtpk(o0, o1);
    }
}

struct Args { const float* in[18]; float* out; unsigned char* ws; };
__global__ void __launch_bounds__(NWAVES * 64, 2) fwd_kernel(Args args) {
    extern __shared__ __attribute__((aligned(16))) unsigned char lds_raw[];
    LAS unsigned char* lds = (LAS unsigned char*)lds_raw;
    volatile LAS unsigned* MISC = (volatile LAS unsigned*)(lds + MISC_OFF);
    const int tid = threadIdx.x, lane = tid & 63, wave = __builtin_amdgcn_readfirstlane(tid >> 6);
    const int G = gridDim.x, bx = blockIdx.x;
    unsigned char* ws = args.ws;
    unsigned* ctl = (unsigned*)(ws + WS_CTL);
    const float* xp = args.in[0]; const float* xs = args.in[1];
    bf16* Wi = (bf16*)(ws + WS_WIN); bf16* Wo = (bf16*)(ws + WS_WOUT); bf16* Wu = (bf16*)(ws + WS_WUP); bf16* Wd = (bf16*)(ws + WS_WDN);
    float* rstd1 = (float*)(ws + WS_RSTD1); float* r2 = (float*)(ws + WS_R2); float* ssq = (float*)(ws + WS_SSQ);
    bf16* XB = (bf16*)(ws + WS_XB); bf16* Z = (bf16*)(ws + WS_Z); bf16* U = (bf16*)(ws + WS_U); bf16* MIX = (bf16*)(ws + WS_MIX); bf16* H = (bf16*)(ws + WS_H);
    float* out = args.out;
    for (int u = tid; u < (LDS_BYTES - RING_BYTES) / 4; u += NWAVES * 64) ((LAS unsigned*)(lds + RING_BYTES))[u] = 0u;
    __syncthreads();
    XcdBarrier bar = xcd_barrier_post(ctl + CW_BAR, MISC + 8);

    {
        LAS float* scr = (LAS float*)(lds + wave * 16384);
        const int gw = bx * NWAVES + wave, NGW = G * NWAVES;
        constexpr int I_IN = (DM / 64) * (INW / 32), I_OUT = (DM / 64) * (DM / 32), I_UP = (DM / 64) * (FF / 32), I_DN = (FF / 64) * (DM / 32);
        constexpr int NITEMS = I_IN + I_OUT + I_UP + I_DN;
        for (int it = gw; it < NITEMS; it += NGW) {
            int r = it;
            if (r < I_IN) { p0_transpose_item(args.in[6], args.in[5], DM, INW, Wi, 1, scr, r, lane); continue; } r -= I_IN;
            if (r < I_OUT) { p0_transpose_item(args.in[14], nullptr, DM, DM, Wo, 0, scr, r, lane); continue; } r -= I_OUT;
            if (r < I_UP) { p0_transpose_item(args.in[16], args.in[15], DM, FF, Wu, 0, scr, r, lane); continue; } r -= I_UP;
            p0_transpose_item(args.in[17], nullptr, FF, DM, Wd, 0, scr, r, lane);
        }
        for (int m = gw; m < M; m += NGW) { const float* src = (m < MP) ? xp + (size_t)m * DM : xs + (size_t)(m - MP) * DM; x_row_to_bf16(src, XB + (size_t)m * DM, rstd1 + m, lane); }
    }
    xcd_barrier(bar);

    {
        pg8::Gemm g{XB, Wi, M, INW, DM}; pg8::StaticOrder S; S.init(M, INW, G, bx);
        pg8::EpiIn E{Z, U, rstd1};
        pg8::gemm_phase<pg8::EpiIn, pg8::StaticOrder, true, true>(lds, g, S, E);
    }
    xcd_barrier(bar);

    {
        P2Args A{Z, U, MIX, args.in[2], args.in[3], args.in[4], args.in[7], args.in[8], args.in[9], args.in[10], args.in[11], args.in[12], args.in[13], out};
        for (int au = bx; au < NB * 16 * NKV; au += G) attn_prompt_unit(A, lds, au >> 6, (au >> 2) & 15, au & 3, tid, lane, wave);
        for (int su = bx; su < DB * 2; su += G) attn_sample_unit(A, lds, su >> 1, su & 1, tid, lane, wave);
        f32x2 w[CW];
#pragma unroll
        for (int j = 0; j < CW; ++j) w[j] = *(const f32x2*)(A.wdw + j * CCH + 2 * tid);
        const f32x2 bdw = *(const f32x2*)(A.bdw + 2 * tid), gln = *(const f32x2*)(A.gln + 2 * tid), bln = *(const f32x2*)(A.bln + 2 * tid);
        for (int cu = bx; cu < MP / 16; cu += G) conv_unit<16, false>(A, lds, cu >> 7, (cu & 127) * 16, w, bdw, gln, bln, tid);
        for (int cu = bx; cu < DB; cu += G) conv_unit<DS, true>(A, lds, cu, 0, w, bdw, gln, bln, tid);
    }
    xcd_barrier(bar);

    {
        pg8::Gemm g{MIX, Wo, M, DM, DM}; pg8::StaticOrder S; S.init(M, DM, G, bx);
        pg8::EpiOut E{xp, xs, out, XB, ssq};
        pg8::gemm_phase<pg8::EpiOut, pg8::StaticOrder, true, true>(lds, g, S, E);
    }
    xcd_barrier(bar);

    {
        for (int row = bx * (NWAVES * 64) + tid; row < M; row += G * NWAVES * 64) {
            const f32x4* p = (const f32x4*)(ssq + (size_t)row * 32); float s = 0.f;
#pragma unroll
            for (int i = 0; i < 8; ++i) { const f32x4 v = p[i]; s += (v.x + v.y) + (v.z + v.w); }
            r2[row] = 1.0f / (s * (1.0f / DM) + EPS);
        }
        pg8::Gemm g{XB, Wu, M, FF, DM}; pg8::StaticOrder S; S.init(M, FF, G, bx);
        pg8::EpiUp E{H};
        pg8::gemm_phase<pg8::EpiUp, pg8::StaticOrder, true, true>(lds, g, S, E);
    }
    xcd_barrier(bar);

    {
        pg8::Gemm g{H, Wd, M, DM, FF}; pg8::StaticOrder S; S.init(M, DM, G, bx);
        pg8::EpiDown E{out, r2};
        pg8::gemm_phase<pg8::EpiDown, pg8::StaticOrder, true, true>(lds, g, S, E);
    }
}

extern "C" void kernel_launch(void* const* d_in, const int* in_sizes, int n_in, void* d_out, int out_size, void* d_ws, size_t ws_size, hipStream_t stream) {
    static int grid = 0;
    if (grid == 0) {
        if (n_in != 18 || (size_t)out_size != O_END || ws_size < WS_END) { fprintf(stderr, "kernel_launch: unexpected shapes (n_in %d, out %d, ws %zu); nothing launched\n", n_in, out_size, ws_size); grid = -1; return; }
        int dev = 0, cus = 0, per_cu = 0;
        if (hipGetDevice(&dev) != hipSuccess || hipDeviceGetAttribute(&cus, hipDeviceAttributeMultiprocessorCount, dev) != hipSuccess) { grid = -1; return; }
        if (hipFuncSetAttribute((const void*)fwd_kernel, hipFuncAttributeMaxDynamicSharedMemorySize, LDS_BYTES) != hipSuccess) { fprintf(stderr, "kernel_launch: hipFuncSetAttribute failed\n"); grid = -1; return; }
        if (hipOccupancyMaxActiveBlocksPerMultiprocessor(&per_cu, (const void*)fwd_kernel, NWAVES * 64, LDS_BYTES) != hipSuccess || per_cu < 1) { fprintf(stderr, "kernel_launch: occupancy query reports %d\n", per_cu); }
        (void)hipGetLastError();
        grid = cus;
    }
    if (grid < 0) return;
    if (hipMemsetAsync((char*)d_ws + WS_CTL, 0, CTL_ZERO_BYTES, stream) != hipSuccess) return;
    Args a{};
    for (int i = 0; i < 18; ++i) a.in[i] = (const float*)d_in[i];
    a.out = (float*)d_out; a.ws = (unsigned char*)d_ws;
    hipLaunchKernelGGL(fwd_kernel, dim3(grid), dim3(NWAVES * 64), LDS_BYTES, stream, a);
}
```

```cpp
#include <hip/hip_runtime.h>
#include <cstdio>
#include <cstdint>
#ifndef RES_BF16
#define RES_BF16 1
#endif
#ifndef PROBE
#define PROBE 0
#endif
namespace pg8 {
#define PG8_LAS __attribute__((address_space(3)))
typedef unsigned short bf16_t;
typedef short bf16x8 __attribute__((ext_vector_type(8)));
typedef float f32x4 __attribute__((ext_vector_type(4)));
typedef unsigned u32x4 __attribute__((ext_vector_type(4)));
constexpr int BM = 256, BK = 64, HALF = 128, HTB = HALF * BK * 2  , STAGE_BYTES = 8 * HTB, NXCD = 8, WGM = 8;

__host__ __device__ __forceinline__ int lds_byte(int r, int c) { const int st = (r >> 4) * 2 + (c >> 5), rr = r & 15, cc = c & 31, ob = rr * 64 + cc * 2; return st * 1024 + (ob ^ (((ob >> 9) & 1) << 5)); }
__host__ __device__ __forceinline__ void stage_rc(int b, int& R, int& C) { const int st = b / 1024, sb = b % 1024, swz = sb ^ (((sb >> 9) & 1) << 5); R = (st >> 1) * 16 + swz / 64; C = (st & 1) * 32 + (swz % 64) / 2; }
__host__ __device__ __forceinline__ int perm32(int rho) { const int n = rho >> 4, i = rho & 15; return 8 * (i >> 2) + 4 * n + (i & 3); }

struct Unit { int pm, pn; };
struct Gemm { const bf16_t* A; const bf16_t* Bt; int M, N, K; };

struct StaticOrder {
    int nM, nN, nwg, G, c, wgm, rev;
    __host__ __device__ void init(int M, int N, int G_, int c_, int wgm_ = WGM, int rev_ = 0) { nM = M / BM; nN = N / BM; nwg = nM * nN; G = G_; c = c_; wgm = wgm_; rev = rev_; }
    __host__ __device__ bool next(int i, Unit& u) const {
        if ((long)i * G + c >= nwg) return false;
        const int nr = (nwg - c + G - 1) / G; const long L = (long)(rev ? nr - 1 - i : i) * G + c;
        int wgid = (int)L; { const int q = nwg / NXCD, r = nwg % NXCD, xcd = wgid % NXCD, off = wgid / NXCD; wgid = (xcd < r ? xcd * (q + 1) : r * (q + 1) + (xcd - r) * q) + off; }
        const int nig = wgm * nN, gid = wgid / nig, fm = gid * wgm, gsz = (nM - fm) < wgm ? (nM - fm) : wgm;
        u.pm = fm + ((wgid % nig) % gsz); u.pn = (wgid % nig) / gsz; return true;
    }
    __device__ __forceinline__ void a_ready(const Unit&) const {}
    __device__ __forceinline__ void done(const Unit&) const {}
};

__device__ __forceinline__ unsigned cvt_pk_bf16(float lo, float hi) { unsigned r; asm volatile("v_cvt_pk_bf16_f32 %0, %1, %2" : "=v"(r) : "v"(lo), "v"(hi)); return r; }
typedef float f32x2 __attribute__((ext_vector_type(2)));
struct EpiIn {
    static constexpr bool PERM = true, AFTER_DRAIN = false;
    bf16_t* Z; bf16_t* U; const float* rstd;
    __device__ __forceinline__ void operator()(const f32x4 (&acc)[2][2][4][2], const Unit& u, int wr, int wc, int fr, int fq) const {
        const int row0 = u.pm * BM + wr * 64 + fr;
        if (u.pn < 6) {
            const int col0 = u.pn * BM + wc * 32 + 8 * fq;
#pragma unroll
            for (int ai = 0; ai < 2; ++ai)
#pragma unroll
                for (int m = 0; m < 4; ++m) { const int row = row0 + ai * HALF + m * 16; const float rs = rstd[row]; bf16_t* rowp = Z + (size_t)row * 1536 + col0;
#pragma unroll
                    for (int bj = 0; bj < 2; ++bj) { const f32x4 v0 = acc[ai][bj][m][0] * rs, v1 = acc[ai][bj][m][1] * rs;
                        u32x4 w; w.x = cvt_pk_bf16(v0[0], v0[1]); w.y = cvt_pk_bf16(v0[2], v0[3]); w.z = cvt_pk_bf16(v1[0], v1[1]); w.w = cvt_pk_bf16(v1[2], v1[3]);
                        *(u32x4*)(rowp + bj * HALF) = w; } }
        } else {
            const int c0 = (u.pn - 6) * HALF + wc * 32 + 8 * fq;
#pragma unroll
            for (int ai = 0; ai < 2; ++ai)
#pragma unroll
                for (int m = 0; m < 4; ++m) { const int row = row0 + ai * HALF + m * 16; const float rs = rstd[row];
                    float o[8];
#pragma unroll
                    for (int n = 0; n < 2; ++n)
#pragma unroll
                        for (int e = 0; e < 4; ++e) { const float a = acc[ai][0][m][n][e] * rs, g = acc[ai][1][m][n][e] * rs; o[n * 4 + e] = a * __builtin_amdgcn_rcpf(1.0f + __expf(-g)); }
                    u32x4 w; w.x = cvt_pk_bf16(o[0], o[1]); w.y = cvt_pk_bf16(o[2], o[3]); w.z = cvt_pk_bf16(o[4], o[5]); w.w = cvt_pk_bf16(o[6], o[7]);
                    *(u32x4*)(U + (size_t)row * 1024 + c0) = w; }
        }
    }
};
struct EpiOut {
    static constexpr bool PERM = false, AFTER_DRAIN = false;
    const float* xp; const float* xs; float* out; bf16_t* XB; float* ssq;
    __device__ __forceinline__ void operator()(const f32x4 (&acc)[2][2][4][2], const Unit& u, int wr, int wc, int fr, int fq) const {
        typedef unsigned u32x2 __attribute__((ext_vector_type(2)));
        const int row0 = u.pm * BM + wr * 64 + fr, col0 = u.pn * BM + wc * 32 + 4 * fq;
#pragma unroll
        for (int ai = 0; ai < 2; ++ai) {
#if RES_BF16
            u32x2 xr[4][2][2];
#pragma unroll
            for (int m = 0; m < 4; ++m) { const size_t ro = (size_t)(row0 + ai * HALF + m * 16) * 2048 + col0;
#pragma unroll
                for (int bj = 0; bj < 2; ++bj) { xr[m][bj][0] = *(const u32x2*)(XB + ro + bj * HALF); xr[m][bj][1] = *(const u32x2*)(XB + ro + bj * HALF + 16); } }
#else
            const float* xb = (u.pm < 128) ? xp : (xs - (size_t)32768 * 2048);
            f32x4 xr[4][2][2];
#pragma unroll
            for (int m = 0; m < 4; ++m) { const size_t ro = (size_t)(row0 + ai * HALF + m * 16) * 2048 + col0;
#pragma unroll
                for (int bj = 0; bj < 2; ++bj) { xr[m][bj][0] = *(const f32x4*)(xb + ro + bj * HALF); xr[m][bj][1] = *(const f32x4*)(xb + ro + bj * HALF + 16); } }
#endif
            __builtin_amdgcn_sched_barrier(0);
#pragma unroll
            for (int m = 0; m < 4; ++m) { const int row = row0 + ai * HALF + m * 16; const size_t ro = (size_t)row * 2048 + col0; float q = 0.f;
#pragma unroll
                for (int bj = 0; bj < 2; ++bj)
#pragma unroll
                    for (int n = 0; n < 2; ++n) {
#if RES_BF16
                        const u32x2 xw = xr[m][bj][n];
                        const f32x4 xv = (f32x4){__builtin_bit_cast(float, xw.x << 16), __builtin_bit_cast(float, xw.x & 0xffff0000u), __builtin_bit_cast(float, xw.y << 16), __builtin_bit_cast(float, xw.y & 0xffff0000u)};
                        const f32x4 v = acc[ai][bj][m][n] + xv;
#else
                        const f32x4 v = acc[ai][bj][m][n] + xr[m][bj][n];
                        *(f32x4*)(out + ro + bj * HALF + n * 16) = v;
#endif
                        u32x2 w; w.x = cvt_pk_bf16(v[0], v[1]); w.y = cvt_pk_bf16(v[2], v[3]);
                        *(u32x2*)(XB + ro + bj * HALF + n * 16) = w;
                        q += (v[0] * v[0] + v[1] * v[1]) + (v[2] * v[2] + v[3] * v[3]); }
                q += __shfl_xor(q, 16); q += __shfl_xor(q, 32);
                if (fq == 0) ssq[(size_t)row * 32 + u.pn * 4 + wc] = q; }
            __builtin_amdgcn_sched_barrier(0);
        }
    }
};
struct EpiUp {
    static constexpr bool PERM = true, AFTER_DRAIN = false;
    bf16_t* H;
    __device__ __forceinline__ void operator()(const f32x4 (&acc)[2][2][4][2], const Unit& u, int wr, int wc, int fr, int fq) const {
        const int row0 = u.pm * BM + wr * 64 + fr, col0 = u.pn * BM + wc * 32 + 8 * fq;
#pragma unroll
        for (int ai = 0; ai < 2; ++ai)
#pragma unroll
            for (int m = 0; m < 4; ++m) { bf16_t* rowp = H + (size_t)(row0 + ai * HALF + m * 16) * 8192 + col0;
#pragma unroll
                for (int bj = 0; bj < 2; ++bj) { f32x4 v0 = acc[ai][bj][m][0], v1 = acc[ai][bj][m][1];
#pragma unroll
                    for (int e = 0; e < 4; ++e) { const float a = fmaxf(v0[e], 0.f), b = fmaxf(v1[e], 0.f); v0[e] = a * a; v1[e] = b * b; }
                    u32x4 w; w.x = cvt_pk_bf16(v0[0], v0[1]); w.y = cvt_pk_bf16(v0[2], v0[3]); w.z = cvt_pk_bf16(v1[0], v1[1]); w.w = cvt_pk_bf16(v1[2], v1[3]);
                    *(u32x4*)(rowp + bj * HALF) = w; } }
    }
};
struct EpiDown {
    static constexpr bool PERM = false, AFTER_DRAIN = false;
    float* out; const float* r2; const bf16_t* XB;
    __device__ __forceinline__ void operator()(const f32x4 (&acc)[2][2][4][2], const Unit& u, int wr, int wc, int fr, int fq) const {
        typedef unsigned u32x2 __attribute__((ext_vector_type(2)));
        const int row0 = u.pm * BM + wr * 64 + fr, col0 = u.pn * BM + wc * 32 + 4 * fq;
#pragma unroll
        for (int ai = 0; ai < 2; ++ai) {
#if RES_BF16
            u32x2 xr[4][2][2]; float sc[4];
#pragma unroll
            for (int m = 0; m < 4; ++m) { const int row = row0 + ai * HALF + m * 16; const bf16_t* rowp = XB + (size_t)row * 2048 + col0; sc[m] = r2[row];
#pragma unroll
                for (int bj = 0; bj < 2; ++bj) { xr[m][bj][0] = *(const u32x2*)(rowp + bj * HALF); xr[m][bj][1] = *(const u32x2*)(rowp + bj * HALF + 16); } }
            __builtin_amdgcn_sched_barrier(0);
#pragma unroll
            for (int m = 0; m < 4; ++m) { float* rowp = out + (size_t)(row0 + ai * HALF + m * 16) * 2048 + col0;
#pragma unroll
                for (int bj = 0; bj < 2; ++bj)
#pragma unroll
                    for (int n = 0; n < 2; ++n) { const u32x2 w = xr[m][bj][n];
                        const f32x4 x = (f32x4){__builtin_bit_cast(float, w.x << 16), __builtin_bit_cast(float, w.x & 0xffff0000u), __builtin_bit_cast(float, w.y << 16), __builtin_bit_cast(float, w.y & 0xffff0000u)};
                        *(f32x4*)(rowp + bj * HALF + n * 16) = x + acc[ai][bj][m][n] * sc[m]; } }
            __builtin_amdgcn_sched_barrier(0);
#else
            f32x4 xr[4][2][2]; float sc[4];
#pragma unroll
            for (int m = 0; m < 4; ++m) { const int row = row0 + ai * HALF + m * 16; const float* rowp = out + (size_t)row * 2048 + col0; sc[m] = r2[row];
#pragma unroll
                for (int bj = 0; bj < 2; ++bj) { xr[m][bj][0] = *(const f32x4*)(rowp + bj * HALF); xr[m][bj][1] = *(const f32x4*)(rowp + bj * HALF + 16); } }
            __builtin_amdgcn_sched_barrier(0);
#pragma unroll
            for (int m = 0; m < 4; ++m) { float* rowp = out + (size_t)(row0 + ai * HALF + m * 16) * 2048 + col0;
#pragma unroll
                for (int bj = 0; bj < 2; ++bj) { *(f32x4*)(rowp + bj * HALF) = xr[m][bj][0] + acc[ai][bj][m][0] * sc[m]; *(f32x4*)(rowp + bj * HALF + 16) = xr[m][bj][1] + acc[ai][bj][m][1] * sc[m]; } }
            __builtin_amdgcn_sched_barrier(0);
#endif
        }
    }
};

template <class Epi, class Sched, bool ALIGN_EPI = false, bool SP2 = false>
__device__ __forceinline__ void gemm_phase(PG8_LAS unsigned char* lds, const Gemm g, const Sched& S, const Epi& E) {
    int tid_ = threadIdx.x; asm volatile("" : "+v"(tid_));
    const int tid = tid_, wid = __builtin_amdgcn_readfirstlane(tid >> 6), lane = tid & 63, wr = wid >> 2, wc = wid & 3, fr = lane & 15, fq = lane >> 4;
    const int K = g.K, nt = K / BK;
    unsigned voffA[2], voffB[2];
#pragma unroll
    for (int i = 0; i < 2; ++i) { int R, C; stage_rc(tid * 16 + i * 8192, R, C); const int Rb = Epi::PERM ? ((R & ~31) + perm32(R & 31)) : R;
        voffA[i] = (unsigned)(R * K + C) * 2u; voffB[i] = (unsigned)(Rb * K + C) * 2u; }
    const size_t kstep = (size_t)(BK * 2);
    const size_t hstep = (size_t)HALF * K * 2;
    const size_t tstep = 2 * hstep;
    const unsigned ldsw = (unsigned)wid * 1024u;
    const int aoff = lds_byte(wr * 64 + fr, fq * 8), boff = lds_byte(wc * 32 + fr, fq * 8);
#define PG8_SA(b, h) (((b) * 2 + (h)) * HTB)
#define PG8_SB(b, h) ((4 + (b) * 2 + (h)) * HTB)
#define PG8_STAGE(bufoff, gbase, voff) do { _Pragma("unroll") for (int _i = 0; _i < 2; ++_i) \
        __builtin_amdgcn_global_load_lds((const unsigned*)((const char*)(gbase) + (voff)[_i]), (PG8_LAS unsigned*)(lds + (bufoff) + ldsw + _i * 8192), 16, 0, 0); } while (0)
#define PG8_LDA(dst, b, h) do { _Pragma("unroll") for (int m = 0; m < 4; ++m) _Pragma("unroll") for (int k = 0; k < 2; ++k) dst[m][k] = *(const PG8_LAS bf16x8*)(lds + PG8_SA(b, h) + aoff + m * 2048 + k * 1024); } while (0)
#define PG8_LDB(dst, b, h) do { _Pragma("unroll") for (int n = 0; n < 2; ++n) _Pragma("unroll") for (int k = 0; k < 2; ++k) dst[n][k] = *(const PG8_LAS bf16x8*)(lds + PG8_SB(b, h) + boff + n * 2048 + k * 1024); } while (0)
#define PG8_MMA(ai, bj, At, Bt) do { __builtin_amdgcn_s_setprio(1); _Pragma("unroll") for (int m = 0; m < 4; ++m) _Pragma("unroll") for (int n = 0; n < 2; ++n) _Pragma("unroll") for (int k = 0; k < 2; ++k) \
        acc[ai][bj][m][n] = __builtin_amdgcn_mfma_f32_16x16x32_bf16(Bt[n][k], At[m][k], acc[ai][bj][m][n], 0, 0, 0); __builtin_amdgcn_s_setprio(0); } while (0)
#define PG8_WAIT_V(n) asm volatile("s_waitcnt vmcnt(" #n ")" ::: "memory")
#define PG8_WAIT_L(n) asm volatile("s_waitcnt lgkmcnt(" #n ")" ::: "memory")
#define PG8_BAR __builtin_amdgcn_s_barrier()
#define PG8_SCHED __builtin_amdgcn_sched_barrier(0)
    Unit cur, nxt; int ui = 0;
    if (!S.next(0, cur)) return;
    f32x4 acc[2][2][4][2];
#pragma unroll
    for (int a = 0; a < 2; ++a)
#pragma unroll
        for (int b = 0; b < 2; ++b)
#pragma unroll
            for (int m = 0; m < 4; ++m)
#pragma unroll
                for (int n = 0; n < 2; ++n) acc[a][b][m][n] = (f32x4){0.f, 0.f, 0.f, 0.f};
    bf16x8 At[4][2], B0[2][2], B1[2][2];
    const char* cA = (const char*)g.A + (size_t)cur.pm * tstep; const char* cB = (const char*)g.Bt + (size_t)cur.pn * tstep;
    S.a_ready(cur);
    if constexpr (SP2) {
        PG8_STAGE(PG8_SB(0, 0), cB, voffB); PG8_STAGE(PG8_SB(0, 1), cB + hstep, voffB); PG8_STAGE(PG8_SA(0, 0), cA, voffA); PG8_STAGE(PG8_SA(0, 1), cA + hstep, voffA);
        if (wr == 1) PG8_BAR;
        PG8_WAIT_V(2); PG8_BAR;
        PG8_STAGE(PG8_SB(1, 0), cB + kstep, voffB); PG8_STAGE(PG8_SA(1, 0), cA + kstep, voffA); PG8_STAGE(PG8_SB(1, 1), cB + hstep + kstep, voffB);
        PG8_WAIT_V(6); PG8_BAR;
    } else {
        PG8_STAGE(PG8_SB(0, 0), cB, voffB); PG8_STAGE(PG8_SA(0, 0), cA, voffA); PG8_STAGE(PG8_SB(0, 1), cB + hstep, voffB); PG8_STAGE(PG8_SA(0, 1), cA + hstep, voffA);
        if (wr == 1) PG8_BAR;
        PG8_WAIT_V(4); PG8_BAR;
        PG8_STAGE(PG8_SB(1, 0), cB + kstep, voffB); PG8_STAGE(PG8_SA(1, 0), cA + kstep, voffA); PG8_STAGE(PG8_SB(1, 1), cB + hstep + kstep, voffB);
        PG8_WAIT_V(6); PG8_BAR;
    }
    for (;;) {
        const bool has_next = S.next(ui + 1, nxt);
        const char* nA = has_next ? (const char*)g.A + (size_t)nxt.pm * tstep : cA; const char* nB = has_next ? (const char*)g.Bt + (size_t)nxt.pn * tstep : cB;
        for (int t = 0; t < nt; t += 2) {
            const bool last = (t == nt - 2);
            const char* a1 = cA + (size_t)(t + 1) * kstep;
            const char* a2 = last ? nA : cA + (size_t)(t + 2) * kstep; const char* b2 = last ? nB : cB + (size_t)(t + 2) * kstep;
            const char* a3 = a2 + kstep; const char* b3 = b2 + kstep;
            if (last && has_next) S.a_ready(nxt);
            if constexpr (SP2) {
            PG8_LDB(B0, 0, 0); PG8_LDB(B1, 0, 1); PG8_SCHED; PG8_LDA(At, 0, 0); PG8_STAGE(PG8_SA(1, 1), a1 + hstep, voffA);
            PG8_WAIT_V(8); PG8_WAIT_L(0); PG8_BAR; PG8_MMA(0, 0, At, B0); PG8_MMA(0, 1, At, B1); PG8_BAR; PG8_SCHED;
            PG8_LDA(At, 0, 1); PG8_STAGE(PG8_SB(0, 0), b2, voffB); PG8_STAGE(PG8_SB(0, 1), b2 + hstep, voffB); PG8_STAGE(PG8_SA(0, 0), a2, voffA);
            PG8_WAIT_V(8); PG8_WAIT_L(0); PG8_BAR; PG8_MMA(1, 0, At, B0); PG8_MMA(1, 1, At, B1); PG8_BAR; PG8_SCHED;
            PG8_LDB(B0, 1, 0); PG8_LDB(B1, 1, 1); PG8_SCHED; PG8_LDA(At, 1, 0); PG8_STAGE(PG8_SA(0, 1), a2 + hstep, voffA);
            PG8_WAIT_V(8); PG8_WAIT_L(0); PG8_BAR; PG8_MMA(0, 0, At, B0); PG8_MMA(0, 1, At, B1); PG8_BAR; PG8_SCHED;
            PG8_LDA(At, 1, 1); PG8_STAGE(PG8_SB(1, 0), b3, voffB); PG8_STAGE(PG8_SB(1, 1), b3 + hstep, voffB); PG8_STAGE(PG8_SA(1, 0), a3, voffA);
            PG8_WAIT_V(8); PG8_WAIT_L(0); PG8_BAR; PG8_MMA(1, 0, At, B0); PG8_MMA(1, 1, At, B1); PG8_BAR; PG8_SCHED;
            } else {
            PG8_LDB(B0, 0, 0); PG8_SCHED; PG8_LDA(At, 0, 0); PG8_STAGE(PG8_SA(1, 1), a1 + hstep, voffA);
            PG8_WAIT_L(8); PG8_BAR; PG8_WAIT_L(0); PG8_MMA(0, 0, At, B0); PG8_BAR; PG8_SCHED;
            PG8_LDB(B1, 0, 1); PG8_STAGE(PG8_SB(0, 0), b2, voffB);
            PG8_BAR; PG8_WAIT_L(0); PG8_MMA(0, 1, At, B1); PG8_BAR;
            PG8_LDA(At, 0, 1); PG8_STAGE(PG8_SA(0, 0), a2, voffA);
            PG8_BAR; PG8_WAIT_L(0); PG8_MMA(1, 0, At, B0); PG8_BAR; PG8_SCHED;
            PG8_STAGE(PG8_SB(0, 1), b2 + hstep, voffB);
            PG8_WAIT_V(6); PG8_BAR; PG8_MMA(1, 1, At, B1); PG8_BAR;
            PG8_LDB(B0, 1, 0); PG8_SCHED; PG8_LDA(At, 1, 0); PG8_STAGE(PG8_SA(0, 1), a2 + hstep, voffA);
            PG8_WAIT_L(8); PG8_BAR; PG8_WAIT_L(0); PG8_MMA(0, 0, At, B0); PG8_BAR; PG8_SCHED;
            PG8_LDB(B1, 1, 1); PG8_STAGE(PG8_SB(1, 0), b3, voffB);
            PG8_BAR; PG8_WAIT_L(0); PG8_MMA(0, 1, At, B1); PG8_BAR;
            PG8_LDA(At, 1, 1); PG8_STAGE(PG8_SA(1, 0), a3, voffA);
            PG8_BAR; PG8_WAIT_L(0); PG8_MMA(1, 0, At, B0); PG8_BAR; PG8_SCHED;
            PG8_STAGE(PG8_SB(1, 1), b3 + hstep, voffB);
            PG8_WAIT_V(6); PG8_BAR; PG8_MMA(1, 1, At, B1); PG8_BAR;
            }
        }
        if constexpr (ALIGN_EPI) { if (wr == 0) PG8_BAR; }
        if constexpr (!Epi::AFTER_DRAIN) { E(acc, cur, wr, wc, fr, fq); S.done(cur); }
        if (!has_next) break;
#pragma unroll
        for (int a = 0; a < 2; ++a)
#pragma unroll
            for (int b = 0; b < 2; ++b)
#pragma unroll
                for (int m = 0; m < 4; ++m)
#pragma unroll
                    for (int n = 0; n < 2; ++n) acc[a][b][m][n] = (f32x4){0.f, 0.f, 0.f, 0.f};
        cur = nxt; cA = nA; cB = nB; ++ui;
        if constexpr (ALIGN_EPI) { if (wr == 1) PG8_BAR; }
    }
    PG8_WAIT_V(0);
    if constexpr (!ALIGN_EPI) { if (wr == 0) PG8_BAR; }
    PG8_BAR;
    if constexpr (Epi::AFTER_DRAIN) { E.fused(acc, cur, wr, wc, fr, fq, lds, wid, lane); S.done(cur); }
#undef PG8_SA
#undef PG8_SB
#undef PG8_STAGE
#undef PG8_LDA
#undef PG8_LDB
#undef PG8_MMA
#undef PG8_WAIT_V
#undef PG8_WAIT_L
#undef PG8_BAR
#undef PG8_SCHED
}
}

constexpr int NWAVES = 8;
constexpr int DM = 2048, NB = 16, SEQ = 2048, DB = 128, DS = 4, HD = 64, NH = 16, NKV = 4, CCH = 1024, CW = 31, FF = 8192;
constexpr int MP = NB * SEQ, MS = DB * DS, M = MP + MS;
constexpr int INW = 3584, ZW = 1536;
constexpr float EPS = 1e-6f;
constexpr float QSCALE = 0.125f * 1.4426950408889634f;
constexpr float LOG2E = 1.4426950408889634f;
constexpr size_t O_Y = 0, O_KP = (size_t)M * DM, O_VP = O_KP + (size_t)NB * 128 * 256, O_CP = O_VP + (size_t)NB * 128 * 256,
                 O_KS = O_CP + (size_t)NB * 30 * CCH, O_VS = O_KS + (size_t)DB * 128 * 256, O_CS = O_VS + (size_t)DB * 128 * 256, O_END = O_CS + (size_t)DB * 30 * CCH;
constexpr size_t MiB = 1u << 20;
constexpr size_t WS_CTL = 0, CTL_ZERO_BYTES = 64 * 1024;
constexpr size_t WS_WIN = 1 * MiB, WS_WOUT = 15 * MiB, WS_WUP = 23 * MiB, WS_WDN = 55 * MiB;
constexpr size_t WS_RSTD1 = 87 * MiB, WS_R2 = 88 * MiB, WS_SSQS = 88 * MiB + 512 * 1024, WS_SSQ = 89 * MiB;
constexpr size_t WS_XB = 94 * MiB;
constexpr size_t WS_Z = 224 * MiB, WS_U = 322 * MiB, WS_MIX = 387 * MiB;
constexpr size_t WS_H = 224 * MiB, WS_END = 744 * MiB;
static_assert(WS_Z + (size_t)M * ZW * 2 <= WS_U && WS_U + (size_t)M * CCH * 2 <= WS_MIX && WS_MIX + (size_t)M * DM * 2 <= WS_END && WS_H + (size_t)M * FF * 2 <= WS_END, "d_ws map");
static_assert(WS_XB + (size_t)M * DM * 2 <= WS_Z && WS_SSQ + (size_t)M * 32 * 4 <= WS_XB && WS_WIN + (size_t)INW * DM * 2 <= WS_WOUT, "d_ws map");
constexpr int CW_BAR = 4096;
constexpr int RING_BYTES = 131072, MISC_OFF = RING_BYTES + 320, LDS_BYTES = 147456;
#define GAS __attribute__((address_space(1)))
#define LAS __attribute__((address_space(3)))
typedef unsigned short bf16;
typedef unsigned v4u __attribute__((ext_vector_type(4)));
typedef float f32x4 __attribute__((ext_vector_type(4)));
typedef short bf16x8 __attribute__((ext_vector_type(8)));
typedef GAS unsigned gu32;
typedef GAS unsigned long long gu64;
#define RLX_AGENT __ATOMIC_RELAXED, __HIP_MEMORY_SCOPE_AGENT
#define LDS_WAIT() asm volatile("s_waitcnt lgkmcnt(0)" ::: "memory")
#define VM_WAIT() asm volatile("s_waitcnt vmcnt(0)" ::: "memory")
__device__ __forceinline__ unsigned long long rt() { return __builtin_amdgcn_s_memrealtime(); }
__device__ __forceinline__ unsigned f2bf(float f) { unsigned u = __builtin_bit_cast(unsigned, f); return (u + 0x7fffu + ((u >> 16) & 1u)) >> 16; }
__device__ __forceinline__ unsigned pk2(float lo, float hi) { return f2bf(lo) | (f2bf(hi) << 16); }

#define XB_TMO      128
#define XB_XCNT(j)  (256  + 64 * (j))
#define XB_XSUB(j)  (1280 + 64 * (j))
#define XB_XGEN(j)  (2304 + 64 * (j))
#define XB_TOP      3328
#define XB_TOPGEN   3392
#define XCD_BAR_WORDS 3456
#define XB_SPIN_CAP (1u << 18)

__device__ __forceinline__ unsigned xb_ld(unsigned* p)              { return __hip_atomic_load(p, __ATOMIC_RELAXED, __HIP_MEMORY_SCOPE_AGENT); }
__device__ __forceinline__ unsigned xb_add(unsigned* p, unsigned v) { return __hip_atomic_fetch_add(p, v, __ATOMIC_RELAXED, __HIP_MEMORY_SCOPE_AGENT); }
__device__ __forceinline__ unsigned xb_xcc_id() { return (unsigned)__builtin_amdgcn_s_getreg((3 << 11) | 20) & 0xFu; }
#define XB_SPIN(cond, bar) do { unsigned _sp = 0; while (cond) { __builtin_amdgcn_s_sleep(1); \
    if ((++_sp & 255u) == 0u) { if (xb_ld(&(bar)[XB_TMO])) break; if (_sp > XB_SPIN_CAP) { atomicAdd(&(bar)[XB_TMO], 1u); break; } } } } while (0)

struct XcdBarrier {
    unsigned* bar; unsigned x;
    volatile LAS unsigned* st;
};

__device__ __forceinline__ XcdBarrier xcd_barrier_post(unsigned* bar, volatile LAS unsigned* st) {
    XcdBarrier b; b.bar = bar; b.x = xb_xcc_id(); b.st = st;
    if (threadIdx.x == 0) (void)xb_add(&bar[XB_XCNT(b.x)], 1u);
    return b;
}
__device__ __forceinline__ void xcd_barrier_complete(unsigned* bar, unsigned x, unsigned& nloc, unsigned& nx) {
    const unsigned G = gridDim.x * gridDim.y * gridDim.z;
    unsigned sum, cnt, mine, sp = 0u;
    for (;;) {
        sum = 0u; cnt = 0u; mine = 0u;
#pragma unroll
        for (unsigned j = 0; j < 16; ++j) { const unsigned c = xb_ld(&bar[XB_XCNT(j)]); sum += c; cnt += (c > 0u) ? 1u : 0u; mine = (j == x) ? c : mine; }
        if (sum == G) break;
        __builtin_amdgcn_s_sleep(1);
        if ((++sp & 255u) == 0u) { if (xb_ld(&bar[XB_TMO])) break; if (sp > XB_SPIN_CAP) { atomicAdd(&bar[XB_TMO], 1u); break; } }
    }
    nloc = mine > 0u ? mine : 1u; nx = cnt > 0u ? cnt : 1u;
}

__device__ __forceinline__ void xcd_barrier(const XcdBarrier& b) {
    asm volatile("s_waitcnt vmcnt(0)" ::: "memory");
    __syncthreads();
    if (threadIdx.x == 0) {
        unsigned* bar = b.bar;
        __builtin_amdgcn_s_waitcnt(0);
        unsigned nloc = b.st[0], nx = b.st[1];
        if (nloc == 0u) { xcd_barrier_complete(bar, b.x, nloc, nx); b.st[0] = nloc; b.st[1] = nx; }
        const unsigned old = xb_add(&bar[XB_XSUB(b.x)], 1u);
        const unsigned gen = old / nloc;
        if (old + 1u == (gen + 1u) * nloc) {
            __builtin_amdgcn_fence(__ATOMIC_RELEASE, "agent");
            asm volatile("s_waitcnt vmcnt(0)" ::: "memory");
            const unsigned og = xb_add(&bar[XB_TOP], 1u);
            const unsigned tg = og / nx;
            if (og + 1u == (tg + 1u) * nx) xb_add(&bar[XB_TOPGEN], 1u);
            else XB_SPIN(xb_ld(&bar[XB_TOPGEN]) == tg, bar);
            __builtin_amdgcn_fence(__ATOMIC_ACQUIRE, "agent");
            xb_add(&bar[XB_XGEN(b.x)], 1u);
            asm volatile("s_waitcnt vmcnt(0)" ::: "memory");
        } else {
            XB_SPIN(xb_ld(&bar[XB_XGEN(b.x)]) == gen, bar);
            __builtin_amdgcn_fence(__ATOMIC_ACQUIRE, "agent");
            asm volatile("s_waitcnt vmcnt(0)" ::: "memory");
        }
    }
    __syncthreads();
}

typedef float f32x2 __attribute__((ext_vector_type(2)));
typedef float f32x16 __attribute__((ext_vector_type(16)));
typedef short s16x4 __attribute__((ext_vector_type(4)));
__device__ __forceinline__ unsigned cvtpk(float lo, float hi) { unsigned r; asm volatile("v_cvt_pk_bf16_f32 %0, %1, %2" : "=v"(r) : "v"(lo), "v"(hi)); return r; }
__device__ __forceinline__ float bf_lo(unsigned u) { return __builtin_bit_cast(float, u << 16); }
__device__ __forceinline__ float bf_hi(unsigned u) { return __builtin_bit_cast(float, u & 0xffff0000u); }
__device__ __forceinline__ void fmac1(float& acc, float a, float b) { asm("v_fmac_f32 %0, %1, %2" : "+v"(acc) : "v"(a), "v"(b)); }
__device__ __forceinline__ float wave_sum(float v) {
#pragma unroll
    for (int o = 1; o < 64; o <<= 1) v += __shfl_xor(v, o);
    return v;
}

struct P0Item { const float* W; const float* gain; bf16* WT; int K, N, rowmap, k0, n0; };
struct P0Mats { const float *w_in, *g_in, *w_out, *w_up, *g_up, *w_dn; bf16 *Wi, *Wo, *Wu, *Wd; };
constexpr int P0_I_IN = (DM / 64) * (INW / 32), P0_I_OUT = (DM / 64) * (DM / 32), P0_I_UP = (DM / 64) * (FF / 32), P0_I_DN = (FF / 64) * (DM / 32), P0_NITEMS = P0_I_IN + P0_I_OUT + P0_I_UP + P0_I_DN;
__device__ __forceinline__ P0Item p0_item(const P0Mats& Mx, int it) {
    P0Item I; int r = it;
    if (r < P0_I_IN) { I.W = Mx.w_in; I.gain = Mx.g_in; I.WT = Mx.Wi; I.K = DM; I.N = INW; I.rowmap = 1; }
    else if ((r -= P0_I_IN) < P0_I_OUT) { I.W = Mx.w_out; I.gain = nullptr; I.WT = Mx.Wo; I.K = DM; I.N = DM; I.rowmap = 0; }
    else if ((r -= P0_I_OUT) < P0_I_UP) { I.W = Mx.w_up; I.gain = Mx.g_up; I.WT = Mx.Wu; I.K = DM; I.N = FF; I.rowmap = 0; }
    else { r -= P0_I_UP; I.W = Mx.w_dn; I.gain = nullptr; I.WT = Mx.Wd; I.K = FF; I.N = DM; I.rowmap = 0; }
    const int nblk = I.N / 32; I.k0 = 64 * (r / nblk); I.n0 = 32 * (r % nblk); return I;
}
__device__ __forceinline__ void p0_item_issue(const P0Item& I, int lane, f32x4 (&v)[8], float (&g)[8]) {
    const int kr = lane >> 3, nc = lane & 7;
#pragma unroll
    for (int j = 0; j < 8; ++j) { v[j] = *(const f32x4*)(I.W + (size_t)(I.k0 + 8 * j + kr) * I.N + I.n0 + 4 * nc); g[j] = I.gain ? I.gain[I.k0 + 8 * j + kr] : 1.0f; }
}
__device__ __forceinline__ void p0_weights(const P0Mats& Mx, LAS float* scr, int gw, int NGW, int lane) {
    f32x4 v[8]; float g[8];
    int it = gw;
    P0Item I = p0_item(Mx, it < P0_NITEMS ? it : 0);
    if (it < P0_NITEMS) p0_item_issue(I, lane, v, g);
#pragma unroll 1
    for (; it < P0_NITEMS; it += NGW) {
        {   const int kr = lane >> 3, nc = lane & 7;
#pragma unroll
            for (int j = 0; j < 8; ++j) { LAS float* d = scr + (8 * j + kr) * 33 + 4 * nc; d[0] = v[j].x * g[j]; d[1] = v[j].y * g[j]; d[2] = v[j].z * g[j]; d[3] = v[j].w * g[j]; } }
        const P0Item C = I;
        if (it + NGW < P0_NITEMS) { I = p0_item(Mx, it + NGW); p0_item_issue(I, lane, v, g); }
        __builtin_amdgcn_sched_barrier(0);
        LDS_WAIT(); asm volatile("" ::: "memory");
        int nd0 = C.n0;
        if (C.rowmap == 1 && C.n0 >= ZW) { int c = C.n0 - ZW; if (c < CCH) nd0 = ZW + 256 * (c >> 7) + (c & 127); else { c -= CCH; nd0 = ZW + 256 * (c >> 7) + 128 + (c & 127); } }
        const int c = lane & 7;
#pragma unroll
        for (int j = 0; j < 4; ++j) { const int n = (lane >> 3) + 8 * j; const LAS float* s = scr + (8 * c) * 33 + n;
            v4u o; o.x = pk2(s[0 * 33], s[1 * 33]); o.y = pk2(s[2 * 33], s[3 * 33]); o.z = pk2(s[4 * 33], s[5 * 33]); o.w = pk2(s[6 * 33], s[7 * 33]);
            *(GAS v4u*)(C.WT + (size_t)(nd0 + n) * C.K + C.k0 + 8 * c) = o; }
        LDS_WAIT(); asm volatile("" ::: "memory");
    }
}
__device__ __forceinline__ void p0_xrows(const float* xp, const float* xs, bf16* XB, float* rstd1, int gw, int NGW, int lane) {
    f32x4 v[8];
    int m = gw;
    if (m < M) { const GAS f32x4* xr = (const GAS f32x4*)((m < MP) ? xp + (size_t)m * DM : xs + (size_t)(m - MP) * DM) + lane;
#pragma unroll
        for (int j = 0; j < 8; ++j) v[j] = xr[64 * j]; }
#pragma unroll 1
    for (; m < M; m += NGW) {
        float s = 0.f; unsigned long long pk[8];
#pragma unroll
        for (int j = 0; j < 8; ++j) { s += (v[j].x * v[j].x + v[j].y * v[j].y) + (v[j].z * v[j].z + v[j].w * v[j].w); pk[j] = (unsigned long long)cvtpk(v[j].x, v[j].y) | ((unsigned long long)cvtpk(v[j].z, v[j].w) << 32); }
        const int mn = m + NGW;
        if (mn < M) { const GAS f32x4* xr = (const GAS f32x4*)((mn < MP) ? xp + (size_t)mn * DM : xs + (size_t)(mn - MP) * DM) + lane;
#pragma unroll
            for (int j = 0; j < 8; ++j) v[j] = xr[64 * j]; }
        __builtin_amdgcn_sched_barrier(0);
        s = wave_sum(s);
        if (lane == 0) rstd1[m] = 1.0f / sqrtf(s * (1.0f / DM) + EPS);
        GAS unsigned long long* o8 = (GAS unsigned long long*)(XB + (size_t)m * DM) + lane;
#pragma unroll
        for (int j = 0; j < 8; ++j) o8[64 * j] = pk[j];
    }
}

constexpr int KV_RS = 144;
__device__ __forceinline__ int crow(int r, int hi) { return (r & 3) + 8 * (r >> 2) + 4 * hi; }
__device__ __forceinline__ s16x4 vtr(const LAS unsigned char* p) { return __builtin_bit_cast(s16x4, __builtin_amdgcn_ds_read_tr16_b64_v4i16((LAS s16x4*)p)); }

__device__ __forceinline__ void q_issue(const bf16* qrow, int h, v4u (&raw)[4]) {
#pragma unroll
    for (int d0 = 0; d0 < 4; ++d0) raw[d0] = *(const v4u*)(qrow + 16 * d0 + 8 * h);
}
__device__ __forceinline__ void q_finish(const v4u (&raw)[4], int h, const LAS float* gq, bf16x8 (&qf)[4]) {
    float v[4][8]; float ss = 0.f;
#pragma unroll
    for (int d0 = 0; d0 < 4; ++d0)
#pragma unroll
        for (int e = 0; e < 4; ++e) { v[d0][2 * e] = bf_lo(raw[d0][e]); v[d0][2 * e + 1] = bf_hi(raw[d0][e]); ss += v[d0][2 * e] * v[d0][2 * e] + v[d0][2 * e + 1] * v[d0][2 * e + 1]; }
    ss += __shfl_xor(ss, 32);
    const float rs = (1.0f / sqrtf(ss * (1.0f / HD) + EPS)) * QSCALE;
#pragma unroll
    for (int d0 = 0; d0 < 4; ++d0) { const f32x4 g0 = *(const LAS f32x4*)(gq + 16 * d0 + 8 * h), g1 = *(const LAS f32x4*)(gq + 16 * d0 + 8 * h + 4);
        v4u w; w.x = cvtpk(v[d0][0] * rs * g0[0], v[d0][1] * rs * g0[1]); w.y = cvtpk(v[d0][2] * rs * g0[2], v[d0][3] * rs * g0[3]);
        w.z = cvtpk(v[d0][4] * rs * g1[0], v[d0][5] * rs * g1[1]); w.w = cvtpk(v[d0][6] * rs * g1[2], v[d0][7] * rs * g1[3]);
        qf[d0] = __builtin_bit_cast(bf16x8, w); }
}
__device__ __forceinline__ void attn_core(const LAS unsigned char* Kt, const LAS unsigned char* Vt, int tt0, int qrel, int kvmin, const bf16x8 (&qf)[4], float sink2, int lane, f32x16 (&o)[2]) {
    const int r32 = lane & 31, h = lane >> 5;
    f32x16 s[5];
#pragma unroll
    for (int i = 0; i < 5; ++i) {
        const LAS unsigned char* kp = Kt + (32 * (tt0 + i) + r32) * KV_RS + h * 16;
        f32x16 a = {0.f, 0.f, 0.f, 0.f, 0.f, 0.f, 0.f, 0.f, 0.f, 0.f, 0.f, 0.f, 0.f, 0.f, 0.f, 0.f};
#pragma unroll
        for (int d0 = 0; d0 < 4; ++d0) { const bf16x8 kf = *(const LAS bf16x8*)(kp + 32 * d0); a = __builtin_amdgcn_mfma_f32_32x32x16_bf16(kf, qf[d0], a, 0, 0, 0); }
        s[i] = a;
    }
    const int qloc = qrel - 32 * tt0, ndead = (kvmin >> 5) - tt0;
    float mx = -1e30f;
#pragma unroll
    for (int i = 0; i < 5; ++i)
#pragma unroll
        for (int r = 0; r < 16; ++r) { const int cr = (r & 3) + 8 * (r >> 2); bool ok = (i >= ndead);
            if (i == 0) ok = ok && (cr + 4 * h > qloc);
            if (i == 4) ok = ok && (cr + 4 * h <= qloc);
            const float x = ok ? s[i][r] : -1e30f; s[i][r] = x; mx = fmaxf(mx, x); }
    mx = fmaxf(mx, __shfl_xor(mx, 32));
    const float mref = fmaxf(mx, sink2);
    float ls = 0.f;
#pragma unroll
    for (int i = 0; i < 5; ++i)
#pragma unroll
        for (int r = 0; r < 16; ++r) { const float p = __builtin_amdgcn_exp2f(s[i][r] - mref); s[i][r] = p; ls += p; }
    ls += __shfl_xor(ls, 32);
    const float inv = 1.0f / (ls + __builtin_amdgcn_exp2f(sink2 - mref));
    o[0] = (f32x16){0.f, 0.f, 0.f, 0.f, 0.f, 0.f, 0.f, 0.f, 0.f, 0.f, 0.f, 0.f, 0.f, 0.f, 0.f, 0.f}; o[1] = o[0];
    const LAS unsigned char* vb = Vt + (4 * h + ((lane & 15) >> 2)) * KV_RS + ((lane >> 4) & 1) * 32 + (lane & 3) * 8;
#pragma unroll
    for (int i = 0; i < 5; ++i)
#pragma unroll
        for (int st = 0; st < 2; ++st) {
            v4u pw; pw.x = cvtpk(s[i][8 * st + 0], s[i][8 * st + 1]); pw.y = cvtpk(s[i][8 * st + 2], s[i][8 * st + 3]); pw.z = cvtpk(s[i][8 * st + 4], s[i][8 * st + 5]); pw.w = cvtpk(s[i][8 * st + 6], s[i][8 * st + 7]);
            const bf16x8 pf = __builtin_bit_cast(bf16x8, pw);
#pragma unroll
            for (int dt = 0; dt < 2; ++dt) {
                const LAS unsigned char* vp = vb + (32 * (tt0 + i) + 16 * st) * KV_RS + dt * 64;
                const s16x4 lo = vtr(vp), hi = vtr(vp + 8 * KV_RS);
                const bf16x8 vf = (bf16x8){lo[0], lo[1], lo[2], lo[3], hi[0], hi[1], hi[2], hi[3]};
                o[dt] = __builtin_amdgcn_mfma_f32_32x32x16_bf16(vf, pf, o[dt], 0, 0, 0);
            }
        }
#pragma unroll
    for (int dt = 0; dt < 2; ++dt)
#pragma unroll
        for (int r = 0; r < 16; ++r) o[dt][r] *= inv;
}
__device__ __forceinline__ void store_o(bf16* orow, int h, const f32x16 (&o)[2]) {
#pragma unroll
    for (int dt = 0; dt < 2; ++dt)
#pragma unroll
        for (int g = 0; g < 4; ++g) { unsigned long long w = (unsigned long long)cvtpk(o[dt][4 * g], o[dt][4 * g + 1]) | ((unsigned long long)cvtpk(o[dt][4 * g + 2], o[dt][4 * g + 3]) << 32);
            *(unsigned long long*)(orow + 32 * dt + 8 * g + 4 * h) = w; }
}
__device__ __forceinline__ void knorm32(const v4u (&raw)[4], const LAS float* gk32, float (&kf)[32]) {
    float ss = 0.f;
#pragma unroll
    for (int i = 0; i < 4; ++i)
#pragma unroll
        for (int e = 0; e < 4; ++e) { kf[8 * i + 2 * e] = bf_lo(raw[i][e]); kf[8 * i + 2 * e + 1] = bf_hi(raw[i][e]); ss += kf[8 * i + 2 * e] * kf[8 * i + 2 * e] + kf[8 * i + 2 * e + 1] * kf[8 * i + 2 * e + 1]; }
    ss += __shfl_xor(ss, 1);
    const float rs = 1.0f / sqrtf(ss * (1.0f / HD) + EPS);
#pragma unroll
    for (int i = 0; i < 8; ++i) { const f32x4 g = *(const LAS f32x4*)(gk32 + 4 * i);
#pragma unroll
        for (int e = 0; e < 4; ++e) kf[4 * i + e] = kf[4 * i + e] * rs * g[e]; }
}
__device__ __forceinline__ void lds_put32(LAS unsigned char* dst, const float (&f)[32]) {
#pragma unroll
    for (int i = 0; i < 4; ++i) { v4u w; w.x = cvtpk(f[8 * i], f[8 * i + 1]); w.y = cvtpk(f[8 * i + 2], f[8 * i + 3]); w.z = cvtpk(f[8 * i + 4], f[8 * i + 5]); w.w = cvtpk(f[8 * i + 6], f[8 * i + 7]); *(LAS v4u*)(dst + 16 * i) = w; }
}
__device__ __forceinline__ void glb_put32(float* dst, const float (&f)[32]) {
#pragma unroll
    for (int i = 0; i < 8; ++i) *(f32x4*)(dst + 4 * i) = (f32x4){f[4 * i], f[4 * i + 1], f[4 * i + 2], f[4 * i + 3]};
}

struct P2Args { const bf16* Z; const bf16* U; bf16* MIX; const float *ck, *cv, *sc, *gq, *gk, *sinks, *wdw, *bdw, *gln, *bln; float* out; };

__device__ __forceinline__ void kv_issue(const P2Args& A, int au, int tid, v4u (&kr)[4], v4u (&vr)[4]) {
    const int b = au >> 6, qb = (au >> 2) & 15, hk = au & 3, r = tid >> 1, half = tid & 1, t = 128 * (qb - 1) + r, tc = t < 0 ? 0 : t;
    const bf16* zr = A.Z + (size_t)(b * SEQ + tc) * ZW + hk * HD + half * 32;
#pragma unroll
    for (int i = 0; i < 4; ++i) { kr[i] = *(const v4u*)(zr + 1024 + 8 * i); vr[i] = *(const v4u*)(zr + 1280 + 8 * i); }
}
__device__ __forceinline__ void attn_prompt_all(const P2Args& A, LAS unsigned char* lds, const LAS float* gq, const LAS float* gk, int bx, int G, int tid, int lane, int wave) {
    LAS unsigned char* Kt = lds; LAS unsigned char* Vt = lds + 49152;
    constexpr int NU = NB * 16 * NKV;
    const int r32 = lane & 31, h = lane >> 5;
    v4u kr[4], vr[4];
    int au = bx;
    if (au < NU) kv_issue(A, au, tid, kr, vr);
#pragma unroll 1
    for (; au < NU; au += G) {
        const int b = au >> 6, qb = (au >> 2) & 15, hk = au & 3;
        v4u qcur[4];
        { const int wu = wave * 2, g = wu >> 2, q0 = (wu & 3) * 32, head = hk * 4 + g; const size_t row = (size_t)b * SEQ + 128 * qb + q0 + r32; q_issue(A.Z + row * ZW + head * HD, h, qcur); }
        {   const int r = tid >> 1, half = tid & 1, t = 128 * (qb - 1) + r;
            if (t < 0) {
#pragma unroll
                for (int i = 0; i < 4; ++i) { kr[i] = (v4u){0u, 0u, 0u, 0u}; vr[i] = (v4u){0u, 0u, 0u, 0u}; } }
            float kf[32]; knorm32(kr, gk + half * 32, kf);
            lds_put32(Kt + r * KV_RS + half * 64, kf);
#pragma unroll
            for (int i = 0; i < 4; ++i) *(LAS v4u*)(Vt + r * KV_RS + half * 64 + 16 * i) = vr[i];
            if (qb == 15 && r >= 128) {
                const size_t oo = ((size_t)(b * 128 + (r - 128)) * NKV + hk) * HD + half * 32;
                glb_put32(A.out + O_KP + oo, kf);
                float vf[32];
#pragma unroll
                for (int i = 0; i < 4; ++i)
#pragma unroll
                    for (int e = 0; e < 4; ++e) { vf[8 * i + 2 * e] = bf_lo(vr[i][e]); vf[8 * i + 2 * e + 1] = bf_hi(vr[i][e]); }
                glb_put32(A.out + O_VP + oo, vf);
            }
        }
        __syncthreads();
#pragma unroll 1
        for (int w2 = 0; w2 < 2; ++w2) {
            const int wu = wave * 2 + w2, g = wu >> 2, q0 = (wu & 3) * 32, head = hk * 4 + g; const size_t row = (size_t)b * SEQ + 128 * qb + q0 + r32;
            v4u qnext[4];
            if (w2 == 0) q_issue(A.Z + (row + 32) * ZW + (hk * 4 + ((wu + 1) >> 2)) * HD, h, qnext);
            else {
#pragma unroll
                for (int i = 0; i < 4; ++i) qnext[i] = qcur[i]; }
            bf16x8 qf[4]; q_finish(qcur, h, gq, qf);
            if (w2 == 0 && au + G < NU) kv_issue(A, au + G, tid, kr, vr);
            f32x16 o[2];
            attn_core(Kt, Vt, q0 >> 5, q0 + r32, qb == 0 ? 128 : 0, qf, A.sinks[head] * LOG2E, lane, o);
            store_o(A.MIX + row * DM + head * HD, h, o);
#pragma unroll
            for (int i = 0; i < 4; ++i) qcur[i] = qnext[i];
        }
        __syncthreads();
    }
}
__device__ __forceinline__ void attn_sample_unit(const P2Args& A, LAS unsigned char* lds, const LAS float* gq, const LAS float* gk, int b, int hp, int tid, int lane, int wave) {
    LAS unsigned char* Kt = lds; LAS unsigned char* Vt = lds + 49152;
#pragma unroll 1
    for (int it = 0; it < 2; ++it) {
        const int task = tid + it * 512;
        if (task < 640) {
            const int hl = task / 320, rem = task % 320, r = rem >> 1, half = rem & 1, hk = 2 * hp + hl;
            LAS unsigned char* kd = Kt + hl * (160 * KV_RS) + r * KV_RS + half * 64; LAS unsigned char* vd = Vt + hl * (160 * KV_RS) + r * KV_RS + half * 64;
            float kf[32], vf[32];
            if (r < 128) {
                const size_t io = ((size_t)(b * 128 + r) * NKV + hk) * HD + half * 32;
#pragma unroll
                for (int i = 0; i < 8; ++i) { const f32x4 a = *(const f32x4*)(A.ck + io + 4 * i), c = *(const f32x4*)(A.cv + io + 4 * i);
                    kf[4 * i] = a[0]; kf[4 * i + 1] = a[1]; kf[4 * i + 2] = a[2]; kf[4 * i + 3] = a[3]; vf[4 * i] = c[0]; vf[4 * i + 1] = c[1]; vf[4 * i + 2] = c[2]; vf[4 * i + 3] = c[3]; }
                if (r >= 4) { const size_t oo = ((size_t)(b * 128 + r - 4) * NKV + hk) * HD + half * 32; glb_put32(A.out + O_KS + oo, kf); glb_put32(A.out + O_VS + oo, vf); }
            } else if (r < 132) {
                const bf16* zr = A.Z + (size_t)(MP + b * DS + (r - 128)) * ZW + hk * HD + half * 32;
                v4u kr[4], vr[4];
#pragma unroll
                for (int i = 0; i < 4; ++i) { kr[i] = *(const v4u*)(zr + 1024 + 8 * i); vr[i] = *(const v4u*)(zr + 1280 + 8 * i); }
                knorm32(kr, gk + half * 32, kf);
#pragma unroll
                for (int i = 0; i < 4; ++i)
#pragma unroll
                    for (int e = 0; e < 4; ++e) { vf[8 * i + 2 * e] = bf_lo(vr[i][e]); vf[8 * i + 2 * e + 1] = bf_hi(vr[i][e]); }
                const size_t oo = ((size_t)(b * 128 + r - 4) * NKV + hk) * HD + half * 32; glb_put32(A.out + O_KS + oo, kf); glb_put32(A.out + O_VS + oo, vf);
            } else {
#pragma unroll
                for (int i = 0; i < 32; ++i) { kf[i] = 0.f; vf[i] = 0.f; }
            }
            lds_put32(kd, kf); lds_put32(vd, vf);
        }
    }
    __syncthreads();
    if (wave < 2) {
        const int hk = 2 * hp + wave, r32 = lane & 31, h = lane >> 5, g = (r32 >> 2) & 3, i = r32 & 3, head = hk * 4 + g;
        const size_t row = (size_t)MP + b * DS + i;
        v4u qraw[4]; q_issue(A.Z + row * ZW + head * HD, h, qraw);
        bf16x8 qf[4]; q_finish(qraw, h, gq, qf);
        f32x16 o[2];
        attn_core(Kt + wave * (160 * KV_RS), Vt + wave * (160 * KV_RS), 0, i, 0, qf, A.sinks[head] * LOG2E, lane, o);
        if (r32 < 16) store_o(A.MIX + row * DM + head * HD, h, o);
    }
    __syncthreads();
}

template <int TT>
__device__ __forceinline__ void conv_ln_store(f32x2 (&acc)[TT], f32x2 bdw, f32x2 gln, f32x2 bln, LAS float* red, LAS float* fin, bf16* mixrow0  , int tid) {
#pragma unroll
    for (int tt = 0; tt < TT; ++tt) { const f32x2 y = acc[tt] + bdw; acc[tt] = y; red[(2 * tt) * 512 + tid] = y.x + y.y; red[(2 * tt + 1) * 512 + tid] = y.x * y.x + y.y * y.y; }
    __syncthreads();
    {   constexpr int NV = 2 * TT, PER = 512 / NV;
        const int v = tid / PER, p = tid % PER; float s = 0.f;
#pragma unroll
        for (int k = 0; k < NV; ++k) s += red[v * 512 + k * PER + p];
#pragma unroll
        for (int o = 1; o < PER; o <<= 1) s += __shfl_xor(s, o);
        if (p == 0) fin[v] = s; }
    __syncthreads();
#pragma unroll
    for (int tt = 0; tt < TT; ++tt) {
        const float mean = fin[2 * tt] * (1.0f / CCH), var = fin[2 * tt + 1] * (1.0f / CCH) - mean * mean, rstd = 1.0f / sqrtf(var + EPS);
        const f32x2 val = (acc[tt] - mean) * rstd * gln + bln;
        const float o0 = val.x * __builtin_amdgcn_rcpf(1.0f + __expf(-val.x)), o1 = val.y * __builtin_amdgcn_rcpf(1.0f + __expf(-val.y));
        *(unsigned*)(mixrow0 + (size_t)tt * DM) = cvtpk(o0, o1);
    }
}
constexpr int CTT = 16;
__device__ __forceinline__ void conv_issue(const P2Args& A, int cu, int c, unsigned (&raw)[CTT + 30]) {
    const int b = cu >> 7, t0 = (cu & 127) * CTT;
#pragma unroll
    for (int rr = 0; rr < CTT + 30; ++rr) { const int t = t0 - 30 + rr, tc = t < 0 ? 0 : t; raw[rr] = *(const unsigned*)(A.U + (size_t)(b * SEQ + tc) * CCH + c); }
}
__device__ __forceinline__ void conv_prompt_all(const P2Args& A, LAS unsigned char* lds, const f32x2 (&w)[CW], f32x2 bdw, f32x2 gln, f32x2 bln, int bx, int G, int tid) {
    LAS float* red = (LAS float*)lds; LAS float* fin = (LAS float*)(lds + 65536);
    constexpr int NU = MP / CTT;
    const int c = 2 * tid;
    unsigned raw[CTT + 30];
    int cu = bx;
    if (cu < NU) conv_issue(A, cu, c, raw);
#pragma unroll 1
    for (; cu < NU; cu += G) {
        const int b = cu >> 7, t0 = (cu & 127) * CTT;
        float ax[CTT], ay[CTT];
#pragma unroll
        for (int tt = 0; tt < CTT; ++tt) { ax[tt] = 0.f; ay[tt] = 0.f; }
#pragma unroll
        for (int rr = 0; rr < CTT + 30; ++rr) {
            const bool ok = (t0 - 30 + rr) >= 0; const float ux = ok ? bf_lo(raw[rr]) : 0.f, uy = ok ? bf_hi(raw[rr]) : 0.f;
#pragma unroll
            for (int tt = 0; tt < CTT; ++tt) { const int j = rr - tt; if (j >= 0 && j < CW) { fmac1(ax[tt], w[j].x, ux); fmac1(ay[tt], w[j].y, uy); } }
        }
        f32x2 acc[CTT];
#pragma unroll
        for (int tt = 0; tt < CTT; ++tt) acc[tt] = (f32x2){ax[tt], ay[tt]};
        if (t0 + CTT > SEQ - 30) {
#pragma unroll
            for (int rr = 30; rr < CTT + 30; ++rr) { const int t = t0 - 30 + rr; if (t >= SEQ - 30) *(f32x2*)(A.out + O_CP + ((size_t)b * 30 + t - (SEQ - 30)) * CCH + c) = (f32x2){bf_lo(raw[rr]), bf_hi(raw[rr])}; }
        }
        if (cu + G < NU) conv_issue(A, cu + G, c, raw);
        conv_ln_store<CTT>(acc, bdw, gln, bln, red, fin, A.MIX + (size_t)(b * SEQ + t0) * DM + 1024 + c, tid);
    }
}
__device__ __forceinline__ void conv_sample_unit(const P2Args& A, LAS unsigned char* lds, int b, const f32x2 (&w)[CW], f32x2 bdw, f32x2 gln, f32x2 bln, int tid) {
    LAS float* red = (LAS float*)lds; LAS float* fin = (LAS float*)(lds + 65536);
    const int c = 2 * tid;
    f32x2 ue[30 + DS];
#pragma unroll
    for (int rr = 0; rr < 30; ++rr) ue[rr] = *(const f32x2*)(A.sc + ((size_t)b * 30 + rr) * CCH + c);
#pragma unroll
    for (int rr = 0; rr < DS; ++rr) { const unsigned raw = *(const unsigned*)(A.U + (size_t)(MP + b * DS + rr) * CCH + c); ue[30 + rr] = (f32x2){bf_lo(raw), bf_hi(raw)}; }
    f32x2 acc[DS];
#pragma unroll
    for (int tt = 0; tt < DS; ++tt) acc[tt] = (f32x2){0.f, 0.f};
#pragma unroll
    for (int rr = 0; rr < DS + 30; ++rr)
#pragma unroll
        for (int tt = 0; tt < DS; ++tt) { const int j = rr - tt; if (j >= 0 && j < CW) acc[tt] += w[j] * ue[rr]; }
#pragma unroll
    for (int rr = DS; rr < 30 + DS; ++rr) *(f32x2*)(A.out + O_CS + ((size_t)b * 30 + rr - DS) * CCH + c) = ue[rr];
    conv_ln_store<DS>(acc, bdw, gln, bln, red, fin, A.MIX + (size_t)(MP + b * DS) * DM + 1024 + c, tid);
}

__device__ __forceinline__ void run_p2(const P2Args& A, LAS unsigned char* lds, int bx, int G, int tid, int lane, int wave) {
    LAS float* gq = (LAS float*)(lds + 98304); LAS float* gk = gq + 64;
    if (tid < 64) gq[tid] = A.gq[tid]; else if (tid < 128) gk[tid - 64] = A.gk[tid - 64];
    __syncthreads();
    attn_prompt_all(A, lds, gq, gk, bx, G, tid, lane, wave);
#if PROBE == 4
    attn_prompt_all(A, lds, gq, gk, bx, G, tid, lane, wave);
#endif
    for (int su = bx; su < DB * 2; su += G) attn_sample_unit(A, lds, gq, gk, su >> 1, su & 1, tid, lane, wave);
#if PROBE == 6
    for (int su = bx; su < DB * 2; su += G) attn_sample_unit(A, lds, gq, gk, su >> 1, su & 1, tid, lane, wave);
#endif
    f32x2 w[CW];
#pragma unroll
    for (int j = 0; j < CW; ++j) w[j] = *(const f32x2*)(A.wdw + j * CCH + 2 * tid);
    const f32x2 bdw = *(const f32x2*)(A.bdw + 2 * tid), gln = *(const f32x2*)(A.gln + 2 * tid), bln = *(const f32x2*)(A.bln + 2 * tid);
    conv_prompt_all(A, lds, w, bdw, gln, bln, bx, G, tid);
#if PROBE == 5
    conv_prompt_all(A, lds, w, bdw, gln, bln, bx, G, tid);
#endif
    for (int cu = bx; cu < DB; cu += G) conv_sample_unit(A, lds, cu, w, bdw, gln, bln, tid);
#if PROBE == 6
    for (int cu = bx; cu < DB; cu += G) conv_sample_unit(A, lds, cu, w, bdw, gln, bln, tid);
#endif
}

template <int MODE> struct SEpi;
struct SgPtrs { bf16* Z; bf16* U; const float* rstd1; const float* xs; float* out; bf16* XB; float* ssqs; bf16* H; const float* r2; };
__device__ __forceinline__ void sg_store_bf16(bf16* p, float x) { *p = (bf16)f2bf(x); }
template <int MODE>
__device__ __forceinline__ void sg_epilogue(const SgPtrs& P, const float (&v)[2][4], int rs0  , int nblk  , int r) {
#pragma unroll
    for (int e = 0; e < 4; ++e) {
        const int rs = rs0 + e; const size_t row = (size_t)MP + rs;
        if (MODE == 0) { const float s = P.rstd1[row];
#pragma unroll
            for (int cb = 0; cb < 2; ++cb) sg_store_bf16(P.Z + row * ZW + 64 * nblk + 32 * cb + r, v[cb][e] * s); }
        if (MODE == 1) { const float s = P.rstd1[row]; const float a = v[0][e] * s, g = v[1][e] * s; sg_store_bf16(P.U + row * CCH + 32 * nblk + r, a * __builtin_amdgcn_rcpf(1.0f + __expf(-g))); }
        if (MODE == 2) {
#pragma unroll
            for (int cb = 0; cb < 2; ++cb) { const int col = 64 * nblk + 32 * cb + r; const float x1 = P.xs[(size_t)rs * DM + col] + v[cb][e];
                P.out[row * DM + col] = x1; sg_store_bf16(P.XB + row * DM + col, x1);
                float q = x1 * x1;
#pragma unroll
                for (int o = 1; o < 32; o <<= 1) q += __shfl_xor(q, o);
                if (r == 0) P.ssqs[(size_t)rs * 64 + 2 * nblk + cb] = q; } }
        if (MODE == 3) {
#pragma unroll
            for (int cb = 0; cb < 2; ++cb) { const float a = fmaxf(v[cb][e], 0.f); sg_store_bf16(P.H + row * FF + 64 * nblk + 32 * cb + r, a * a); } }
        if (MODE == 4) { const float s = P.r2[row];
#pragma unroll
            for (int cb = 0; cb < 2; ++cb) { float* o = P.out + row * DM + 64 * nblk + 32 * cb + r; *o = *o + s * v[cb][e]; } }
    }
}
#define SG_MMA(a0, a1, b0, b1) do { _Pragma("unroll") for (int j_ = 0; j_ < 4; ++j_) { \
        acc[0][0] = __builtin_amdgcn_mfma_f32_32x32x16_bf16(a0[j_], b0[j_], acc[0][0], 0, 0, 0); \
        acc[0][1] = __builtin_amdgcn_mfma_f32_32x32x16_bf16(a0[j_], b1[j_], acc[0][1], 0, 0, 0); \
        acc[1][0] = __builtin_amdgcn_mfma_f32_32x32x16_bf16(a1[j_], b0[j_], acc[1][0], 0, 0, 0); \
        acc[1][1] = __builtin_amdgcn_mfma_f32_32x32x16_bf16(a1[j_], b1[j_], acc[1][1], 0, 0, 0); } } while (0)
template <int MODE>
__device__ __forceinline__ void sgemm_tile(LAS unsigned char* lds, const SgPtrs& P, const bf16* A0  , const bf16* Bb0, const bf16* Bb1, int K, int mi, int nblk, int lane_, int wave) {
    int lane = lane_; asm volatile("" : "+v"(lane));
    const int r = lane & 31, h = lane >> 5, kw = K >> 3, ns = kw >> 6, lr = lane >> 3, lc = lane & 7;
    const unsigned goff = (unsigned)(lr * K + wave * kw) * 2u + (unsigned)lc * 16u, gp = (unsigned)(8 * K) * 2u;
    LAS unsigned char* wb = lds + wave * 16384;
    const int wofs0 = lr * 128 + ((lc ^ lr) * 16), wofs1 = lr * 128 + ((lc ^ lr ^ 1) * 16);
    const int rm = (r & 7) ^ ((r >> 3) & 1);
    __syncthreads();
    f32x16 acc[2][2];
#pragma unroll
    for (int i = 0; i < 2; ++i)
#pragma unroll
        for (int j = 0; j < 2; ++j) acc[i][j] = (f32x16){0.f, 0.f, 0.f, 0.f, 0.f, 0.f, 0.f, 0.f, 0.f, 0.f, 0.f, 0.f, 0.f, 0.f, 0.f, 0.f};
    v4u g[4][4];
#define SG_ISSUE(kb) do { _Pragma("unroll") for (int p_ = 0; p_ < 4; ++p_) { \
        g[0][p_] = *(const v4u*)((const char*)A0 + (goff + p_ * gp + (kb))); g[1][p_] = *(const v4u*)((const char*)A0 + (goff + (p_ + 4) * gp + (kb))); \
        g[2][p_] = *(const v4u*)((const char*)Bb0 + (goff + p_ * gp + (kb))); g[3][p_] = *(const v4u*)((const char*)Bb1 + (goff + p_ * gp + (kb))); } } while (0)
#define SG_WRITE() do { _Pragma("unroll") for (int b_ = 0; b_ < 4; ++b_) _Pragma("unroll") for (int p_ = 0; p_ < 4; ++p_) \
        *(LAS v4u*)(wb + b_ * 4096 + p_ * 1024 + ((p_ & 1) ? wofs1 : wofs0)) = g[b_][p_]; } while (0)
    SG_ISSUE(0u);
    SG_WRITE();
#pragma unroll 1
    for (int s = 0; s < ns; ++s) {
        const bool more = (s + 1 < ns);
        if (more) SG_ISSUE(128u * (unsigned)(s + 1));
        __builtin_amdgcn_sched_barrier(0);
        bf16x8 a0[4], a1[4], b0[4], b1[4];
#pragma unroll
        for (int j = 0; j < 4; ++j) { const int co = r * 128 + (((2 * j + h) ^ rm) * 16);
            a0[j] = *(const LAS bf16x8*)(wb + co); a1[j] = *(const LAS bf16x8*)(wb + 4096 + co); b0[j] = *(const LAS bf16x8*)(wb + 8192 + co); b1[j] = *(const LAS bf16x8*)(wb + 12288 + co); }
        SG_MMA(a0, a1, b0, b1);
        __builtin_amdgcn_sched_barrier(0);
        if (more) SG_WRITE();
    }
#undef SG_ISSUE
#undef SG_WRITE
    LAS float* red = (LAS float*)lds;
    __syncthreads();
#pragma unroll
    for (int rb = 0; rb < 2; ++rb)
#pragma unroll
        for (int cb = 0; cb < 2; ++cb)
#pragma unroll
            for (int g2 = 0; g2 < 16; ++g2) red[(wave * 64 + rb * 32 + cb * 16 + g2) * 64 + lane] = acc[rb][cb][g2];
    __syncthreads();
    const int rb = wave >> 2, q = wave & 3;
    float v[2][4];
#pragma unroll
    for (int cb = 0; cb < 2; ++cb)
#pragma unroll
        for (int e2 = 0; e2 < 4; ++e2) { float sm = 0.f;
#pragma unroll
            for (int ww = 0; ww < 8; ++ww) sm += red[(ww * 64 + rb * 32 + cb * 16 + 4 * q + e2) * 64 + lane];
            v[cb][e2] = sm; }
    sg_epilogue<MODE>(P, v, 64 * mi + 32 * rb + 8 * q + 4 * h, nblk, r);
}
#undef SG_MMA

struct Args { const float* in[18]; float* out; unsigned char* ws; };
__global__ void __launch_bounds__(NWAVES * 64, 2) fwd_kernel(Args args) {
    extern __shared__ __attribute__((aligned(16))) unsigned char lds_raw[];
    LAS unsigned char* lds = (LAS unsigned char*)lds_raw;
    volatile LAS unsigned* MISC = (volatile LAS unsigned*)(lds + MISC_OFF);
    const int tid = threadIdx.x, lane = tid & 63, wave = __builtin_amdgcn_readfirstlane(tid >> 6);
    const int G = gridDim.x, bx = blockIdx.x;
    unsigned char* ws = args.ws;
    unsigned* ctl = (unsigned*)(ws + WS_CTL);
    const float* xp = args.in[0]; const float* xs = args.in[1];
    bf16* Wi = (bf16*)(ws + WS_WIN); bf16* Wo = (bf16*)(ws + WS_WOUT); bf16* Wu = (bf16*)(ws + WS_WUP); bf16* Wd = (bf16*)(ws + WS_WDN);
    float* rstd1 = (float*)(ws + WS_RSTD1); float* r2 = (float*)(ws + WS_R2); float* ssq = (float*)(ws + WS_SSQ); float* ssqs = (float*)(ws + WS_SSQS);
    bf16* XB = (bf16*)(ws + WS_XB); bf16* Z = (bf16*)(ws + WS_Z); bf16* U = (bf16*)(ws + WS_U); bf16* MIX = (bf16*)(ws + WS_MIX); bf16* H = (bf16*)(ws + WS_H);
    float* out = args.out;
    const SgPtrs SP{Z, U, rstd1, xs, out, XB, ssqs, H, r2};
    const int SG_XCD = bx & 7, SG_MI = (bx >> 3) >> 2, SG_NS = (bx >> 3) & 3;
    for (int u = tid; u < (LDS_BYTES - RING_BYTES) / 4; u += NWAVES * 64) ((LAS unsigned*)(lds + RING_BYTES))[u] = 0u;
    __syncthreads();
    XcdBarrier bar = xcd_barrier_post(ctl + CW_BAR, MISC + 8);

    for (int rep_ = 0; rep_ < (PROBE == 1 ? 2 : 1); ++rep_) {
        LAS float* scr = (LAS float*)(lds + wave * 16384);
        const int gw = bx * NWAVES + wave, NGW = G * NWAVES;
        const P0Mats Mx{args.in[6], args.in[5], args.in[14], args.in[16], args.in[15], args.in[17], Wi, Wo, Wu, Wd};
        p0_weights(Mx, scr, gw, NGW, lane);
        p0_xrows(xp, xs, XB, rstd1, gw, NGW, lane);
    }
    xcd_barrier(bar);

    {
#define SGR_IN(lo, hi) for (int rd = (lo); rd < (hi); ++rd) { const int mi = SG_MI, ni = (rd * 8 + SG_XCD) * 4 + SG_NS; \
            if (ni < 24) sgemm_tile<0>(lds, SP, XB + (size_t)(MP + 64 * mi) * DM, Wi + (size_t)(64 * ni) * DM, Wi + (size_t)(64 * ni + 32) * DM, DM, mi, ni, lane, wave); \
            else if (ni < 56) { const int ci = ni - 24, ch = 32 * ci; const bf16* b0 = Wi + (size_t)(ZW + 256 * (ch >> 7) + (ch & 127)) * DM; \
                sgemm_tile<1>(lds, SP, XB + (size_t)(MP + 64 * mi) * DM, b0, b0 + (size_t)128 * DM, DM, mi, ci, lane, wave); } }
        const int nf = (SG_NS * 2) / 3;
        SGR_IN(0, nf);
        __syncthreads();
        pg8::Gemm g{XB, Wi, MP, INW, DM}; pg8::StaticOrder S; S.init(MP, INW, G, bx);
        pg8::EpiIn E{Z, U, rstd1};
        pg8::gemm_phase<pg8::EpiIn, pg8::StaticOrder, true, true>(lds, g, S, E);
        SGR_IN(nf, 2);
#undef SGR_IN
    }
    xcd_barrier(bar);

    {
        P2Args A{Z, U, MIX, args.in[2], args.in[3], args.in[4], args.in[7], args.in[8], args.in[9], args.in[10], args.in[11], args.in[12], args.in[13], out};
        run_p2(A, lds, bx, G, tid, lane, wave);
#if PROBE == 2
        run_p2(A, lds, bx, G, tid, lane, wave);
#endif
    }
    xcd_barrier(bar);

    for (int rep_ = 0; rep_ < (PROBE == 3 ? 2 : 1); ++rep_) {
#define SGR_OUT(lo, hi) for (int rd = (lo); rd < (hi); ++rd) { const int mi = SG_MI, ni = SG_XCD * 4 + SG_NS; sgemm_tile<2>(lds, SP, MIX + (size_t)(MP + 64 * mi) * DM, Wo + (size_t)(64 * ni) * DM, Wo + (size_t)(64 * ni + 32) * DM, DM, mi, ni, lane, wave); }
        const int nf = SG_NS & 1;
        SGR_OUT(0, nf);
        __syncthreads();
        pg8::Gemm g{MIX, Wo, MP, DM, DM}; pg8::StaticOrder S; S.init(MP, DM, G, bx, 4);
        pg8::EpiOut E{xp, xs, out, XB, ssq};
        pg8::gemm_phase<pg8::EpiOut, pg8::StaticOrder, true, true>(lds, g, S, E);
        SGR_OUT(nf, 1);
#undef SGR_OUT
    }
    xcd_barrier(bar);

    {
        for (int row = bx * (NWAVES * 64) + tid; row < M; row += G * NWAVES * 64) {
            float s = 0.f;
            if (row < MP) { const f32x4* p = (const f32x4*)(ssq + (size_t)row * 32);
#pragma unroll
                for (int i = 0; i < 8; ++i) { const f32x4 v = p[i]; s += (v.x + v.y) + (v.z + v.w); } }
            else { const f32x4* p = (const f32x4*)(ssqs + (size_t)(row - MP) * 64);
#pragma unroll
                for (int i = 0; i < 16; ++i) { const f32x4 v = p[i]; s += (v.x + v.y) + (v.z + v.w); } }
            r2[row] = 1.0f / (s * (1.0f / DM) + EPS);
        }
#define SGR_UP(lo, hi) for (int rd = (lo); rd < (hi); ++rd) { const int mi = SG_MI, ni = (rd * 8 + SG_XCD) * 4 + SG_NS; sgemm_tile<3>(lds, SP, XB + (size_t)(MP + 64 * mi) * DM, Wu + (size_t)(64 * ni) * DM, Wu + (size_t)(64 * ni + 32) * DM, DM, mi, ni, lane, wave); }
        const int nf = SG_NS;
        SGR_UP(0, nf);
        __syncthreads();
        pg8::Gemm g{XB, Wu, MP, FF, DM}; pg8::StaticOrder S; S.init(MP, FF, G, bx);
        pg8::EpiUp E{H};
        pg8::gemm_phase<pg8::EpiUp, pg8::StaticOrder, true, true>(lds, g, S, E);
        SGR_UP(nf, 4);
#undef SGR_UP
    }
    xcd_barrier(bar);

    {
#define SGR_DN(lo, hi) for (int rd = (lo); rd < (hi); ++rd) { const int mi = SG_MI, ni = SG_XCD * 4 + SG_NS; sgemm_tile<4>(lds, SP, H + (size_t)(MP + 64 * mi) * FF, Wd + (size_t)(64 * ni) * FF, Wd + (size_t)(64 * ni + 32) * FF, FF, mi, ni, lane, wave); }
        const int nf = SG_NS & 1;
        SGR_DN(0, nf);
        __syncthreads();
        pg8::Gemm g{H, Wd, MP, DM, FF}; pg8::StaticOrder S; S.init(MP, DM, G, bx, 4, 1);
        pg8::EpiDown E{out, r2, XB};
        pg8::gemm_phase<pg8::EpiDown, pg8::StaticOrder, true, true>(lds, g, S, E);
        SGR_DN(nf, 1);
#undef SGR_DN
    }
}

extern "C" void kernel_launch(void* const* d_in, const int* in_sizes, int n_in, void* d_out, int out_size, void* d_ws, size_t ws_size, hipStream_t stream) {
    static int grid = 0;
    if (grid == 0) {
        if (n_in != 18 || (size_t)out_size != O_END || ws_size < WS_END) { fprintf(stderr, "kernel_launch: unexpected shapes (n_in %d, out %d, ws %zu); nothing launched\n", n_in, out_size, ws_size); grid = -1; return; }
        int dev = 0, cus = 0, per_cu = 0;
        if (hipGetDevice(&dev) != hipSuccess || hipDeviceGetAttribute(&cus, hipDeviceAttributeMultiprocessorCount, dev) != hipSuccess) { grid = -1; return; }
        if (hipFuncSetAttribute((const void*)fwd_kernel, hipFuncAttributeMaxDynamicSharedMemorySize, LDS_BYTES) != hipSuccess) { fprintf(stderr, "kernel_launch: hipFuncSetAttribute failed\n"); grid = -1; return; }
        if (hipOccupancyMaxActiveBlocksPerMultiprocessor(&per_cu, (const void*)fwd_kernel, NWAVES * 64, LDS_BYTES) != hipSuccess || per_cu < 1) { fprintf(stderr, "kernel_launch: occupancy query reports %d\n", per_cu); }
        (void)hipGetLastError();
        if (cus < 256) { fprintf(stderr, "kernel_launch: built for a 256-CU device (got %d CUs); nothing launched\n", cus); grid = -1; return; }
        grid = 256;
    }
    if (grid < 0) return;
    if (hipMemsetAsync((char*)d_ws + WS_CTL, 0, CTL_ZERO_BYTES, stream) != hipSuccess) return;
    Args a{};
    for (int i = 0; i < 18; ++i) a.in[i] = (const float*)d_in[i];
    a.out = (float*)d_out; a.ws = (unsigned char*)d_ws;
    hipLaunchKernelGGL(fwd_kernel, dim3(grid), dim3(NWAVES * 64), LDS_BYTES, stream, a);
}
```

```cpp
#include <hip/hip_runtime.h>
#include <cstdio>
#include <cstdint>
#ifndef RES_BF16
#define RES_BF16 1
#endif
#ifndef PROBE
#define PROBE 0
#endif
namespace pg8 {
#define PG8_LAS __attribute__((address_space(3)))
typedef unsigned short bf16_t;
typedef short bf16x8 __attribute__((ext_vector_type(8)));
typedef float f32x4 __attribute__((ext_vector_type(4)));
typedef unsigned u32x4 __attribute__((ext_vector_type(4)));
constexpr int BM = 256, BK = 64, HALF = 128, HTB = HALF * BK * 2  , STAGE_BYTES = 8 * HTB, NXCD = 8, WGM = 8;

__host__ __device__ __forceinline__ int lds_byte(int r, int c) { const int st = (r >> 4) * 2 + (c >> 5), rr = r & 15, cc = c & 31, ob = rr * 64 + cc * 2; return st * 1024 + (ob ^ (((ob >> 9) & 1) << 5)); }
__host__ __device__ __forceinline__ void stage_rc(int b, int& R, int& C) { const int st = b / 1024, sb = b % 1024, swz = sb ^ (((sb >> 9) & 1) << 5); R = (st >> 1) * 16 + swz / 64; C = (st & 1) * 32 + (swz % 64) / 2; }
__host__ __device__ __forceinline__ int perm32(int rho) { const int n = rho >> 4, i = rho & 15; return 8 * (i >> 2) + 4 * n + (i & 3); }

struct Unit { int pm, pn; };
struct Gemm { const bf16_t* A; const bf16_t* Bt; int M, N, K; };

struct StaticOrder {
    int nM, nN, nwg, G, c, wgm;
    __host__ __device__ void init(int M, int N, int G_, int c_, int wgm_ = WGM) { nM = M / BM; nN = N / BM; nwg = nM * nN; G = G_; c = c_; wgm = wgm_; }
    __host__ __device__ bool next(int i, Unit& u) const {
        const long L = (long)i * G + c; if (L >= nwg) return false;
        int wgid = (int)L; { const int q = nwg / NXCD, r = nwg % NXCD, xcd = wgid % NXCD, off = wgid / NXCD; wgid = (xcd < r ? xcd * (q + 1) : r * (q + 1) + (xcd - r) * q) + off; }
        const int nig = wgm * nN, gid = wgid / nig, fm = gid * wgm, gsz = (nM - fm) < wgm ? (nM - fm) : wgm;
        u.pm = fm + ((wgid % nig) % gsz); u.pn = (wgid % nig) / gsz; return true;
    }
    __device__ __forceinline__ void a_ready(const Unit&) const {}
    __device__ __forceinline__ void done(const Unit&) const {}
};

__device__ __forceinline__ unsigned cvt_pk_bf16(float lo, float hi) { unsigned r; asm volatile("v_cvt_pk_bf16_f32 %0, %1, %2" : "=v"(r) : "v"(lo), "v"(hi)); return r; }
typedef float f32x2 __attribute__((ext_vector_type(2)));
struct EpiIn {
    static constexpr bool PERM = true, AFTER_DRAIN = false;
    bf16_t* Z; bf16_t* U; const float* rstd;
    __device__ __forceinline__ void operator()(const f32x4 (&acc)[2][2][4][2], const Unit& u, int wr, int wc, int fr, int fq) const {
        const int row0 = u.pm * BM + wr * 64 + fr;
        if (u.pn < 6) {
            const int col0 = u.pn * BM + wc * 32 + 8 * fq;
#pragma unroll
            for (int ai = 0; ai < 2; ++ai)
#pragma unroll
                for (int m = 0; m < 4; ++m) { const int row = row0 + ai * HALF + m * 16; const float rs = rstd[row]; bf16_t* rowp = Z + (size_t)row * 1536 + col0;
#pragma unroll
                    for (int bj = 0; bj < 2; ++bj) { const f32x4 v0 = acc[ai][bj][m][0] * rs, v1 = acc[ai][bj][m][1] * rs;
                        u32x4 w; w.x = cvt_pk_bf16(v0[0], v0[1]); w.y = cvt_pk_bf16(v0[2], v0[3]); w.z = cvt_pk_bf16(v1[0], v1[1]); w.w = cvt_pk_bf16(v1[2], v1[3]);
                        *(u32x4*)(rowp + bj * HALF) = w; } }
        } else {
            const int c0 = (u.pn - 6) * HALF + wc * 32 + 8 * fq;
#pragma unroll
            for (int ai = 0; ai < 2; ++ai)
#pragma unroll
                for (int m = 0; m < 4; ++m) { const int row = row0 + ai * HALF + m * 16; const float rs = rstd[row];
                    float o[8];
#pragma unroll
                    for (int n = 0; n < 2; ++n)
#pragma unroll
                        for (int e = 0; e < 4; ++e) { const float a = acc[ai][0][m][n][e] * rs, g = acc[ai][1][m][n][e] * rs; o[n * 4 + e] = a * __builtin_amdgcn_rcpf(1.0f + __expf(-g)); }
                    u32x4 w; w.x = cvt_pk_bf16(o[0], o[1]); w.y = cvt_pk_bf16(o[2], o[3]); w.z = cvt_pk_bf16(o[4], o[5]); w.w = cvt_pk_bf16(o[6], o[7]);
                    *(u32x4*)(U + (size_t)row * 1024 + c0) = w; }
        }
    }
};
struct EpiOut {
#if RES_BF16
    static constexpr bool PERM = true, AFTER_DRAIN = false;
    const float* xp; const float* xs; float* out; bf16_t* XB; float* ssq;
    __device__ __forceinline__ void operator()(const f32x4 (&acc)[2][2][4][2], const Unit& u, int wr, int wc, int fr, int fq) const {
        const int row0 = u.pm * BM + wr * 64 + fr, col0 = u.pn * BM + wc * 32 + 8 * fq;
#pragma unroll
        for (int ai = 0; ai < 2; ++ai) {
            u32x4 xr[4][2];
#pragma unroll
            for (int m = 0; m < 4; ++m) { const size_t ro = (size_t)(row0 + ai * HALF + m * 16) * 2048 + col0;
#pragma unroll
                for (int bj = 0; bj < 2; ++bj) xr[m][bj] = *(const u32x4*)(XB + ro + bj * HALF); }
            __builtin_amdgcn_sched_barrier(0);
#pragma unroll
            for (int m = 0; m < 4; ++m) { const int row = row0 + ai * HALF + m * 16; const size_t ro = (size_t)row * 2048 + col0; float q = 0.f;
#pragma unroll
                for (int bj = 0; bj < 2; ++bj) { const u32x4 xw = xr[m][bj];
                    const f32x4 x0 = (f32x4){__builtin_bit_cast(float, xw.x << 16), __builtin_bit_cast(float, xw.x & 0xffff0000u), __builtin_bit_cast(float, xw.y << 16), __builtin_bit_cast(float, xw.y & 0xffff0000u)};
                    const f32x4 x1 = (f32x4){__builtin_bit_cast(float, xw.z << 16), __builtin_bit_cast(float, xw.z & 0xffff0000u), __builtin_bit_cast(float, xw.w << 16), __builtin_bit_cast(float, xw.w & 0xffff0000u)};
                    const f32x4 v0 = acc[ai][bj][m][0] + x0, v1 = acc[ai][bj][m][1] + x1;
                    u32x4 w; w.x = cvt_pk_bf16(v0[0], v0[1]); w.y = cvt_pk_bf16(v0[2], v0[3]); w.z = cvt_pk_bf16(v1[0], v1[1]); w.w = cvt_pk_bf16(v1[2], v1[3]);
                    *(u32x4*)(XB + ro + bj * HALF) = w;
                    q += (v0[0] * v0[0] + v0[1] * v0[1]) + (v0[2] * v0[2] + v0[3] * v0[3]) + (v1[0] * v1[0] + v1[1] * v1[1]) + (v1[2] * v1[2] + v1[3] * v1[3]); }
                q += __shfl_xor(q, 16); q += __shfl_xor(q, 32);
                if (fq == 0) ssq[(size_t)row * 32 + u.pn * 4 + wc] = q; }
            __builtin_amdgcn_sched_barrier(0);
        }
    }
#else
    static constexpr bool PERM = false, AFTER_DRAIN = false;
    const float* xp; const float* xs; float* out; bf16_t* XB; float* ssq;
    __device__ __forceinline__ void operator()(const f32x4 (&acc)[2][2][4][2], const Unit& u, int wr, int wc, int fr, int fq) const {
        typedef unsigned u32x2 __attribute__((ext_vector_type(2)));
        const int row0 = u.pm * BM + wr * 64 + fr, col0 = u.pn * BM + wc * 32 + 4 * fq;
        const float* xb = (u.pm < 128) ? xp : (xs - (size_t)32768 * 2048);
#pragma unroll
        for (int ai = 0; ai < 2; ++ai) {
            f32x4 xr[4][2][2];
#pragma unroll
            for (int m = 0; m < 4; ++m) { const size_t ro = (size_t)(row0 + ai * HALF + m * 16) * 2048 + col0;
#pragma unroll
                for (int bj = 0; bj < 2; ++bj) { xr[m][bj][0] = *(const f32x4*)(xb + ro + bj * HALF); xr[m][bj][1] = *(const f32x4*)(xb + ro + bj * HALF + 16); } }
            __builtin_amdgcn_sched_barrier(0);
#pragma unroll
            for (int m = 0; m < 4; ++m) { const int row = row0 + ai * HALF + m * 16; const size_t ro = (size_t)row * 2048 + col0; float q = 0.f;
#pragma unroll
                for (int bj = 0; bj < 2; ++bj)
#pragma unroll
                    for (int n = 0; n < 2; ++n) { const f32x4 v = acc[ai][bj][m][n] + xr[m][bj][n];
                        *(f32x4*)(out + ro + bj * HALF + n * 16) = v;
                        u32x2 w; w.x = cvt_pk_bf16(v[0], v[1]); w.y = cvt_pk_bf16(v[2], v[3]);
                        *(u32x2*)(XB + ro + bj * HALF + n * 16) = w;
                        q += (v[0] * v[0] + v[1] * v[1]) + (v[2] * v[2] + v[3] * v[3]); }
                q += __shfl_xor(q, 16); q += __shfl_xor(q, 32);
                if (fq == 0) ssq[(size_t)row * 32 + u.pn * 4 + wc] = q; }
            __builtin_amdgcn_sched_barrier(0);
        }
    }
#endif
};
struct EpiUp {
    static constexpr bool PERM = true, AFTER_DRAIN = false;
    bf16_t* H;
    __device__ __forceinline__ void operator()(const f32x4 (&acc)[2][2][4][2], const Unit& u, int wr, int wc, int fr, int fq) const {
        const int row0 = u.pm * BM + wr * 64 + fr, col0 = u.pn * BM + wc * 32 + 8 * fq;
#pragma unroll
        for (int ai = 0; ai < 2; ++ai)
#pragma unroll
            for (int m = 0; m < 4; ++m) { bf16_t* rowp = H + (size_t)(row0 + ai * HALF + m * 16) * 8192 + col0;
#pragma unroll
                for (int bj = 0; bj < 2; ++bj) { f32x4 v0 = acc[ai][bj][m][0], v1 = acc[ai][bj][m][1];
#pragma unroll
                    for (int e = 0; e < 4; ++e) { const float a = fmaxf(v0[e], 0.f), b = fmaxf(v1[e], 0.f); v0[e] = a * a; v1[e] = b * b; }
                    u32x4 w; w.x = cvt_pk_bf16(v0[0], v0[1]); w.y = cvt_pk_bf16(v0[2], v0[3]); w.z = cvt_pk_bf16(v1[0], v1[1]); w.w = cvt_pk_bf16(v1[2], v1[3]);
                    *(u32x4*)(rowp + bj * HALF) = w; } }
    }
};
struct EpiDown {
    static constexpr bool PERM = false, AFTER_DRAIN = false;
    float* out; const float* r2; const bf16_t* XB;
    __device__ __forceinline__ void operator()(const f32x4 (&acc)[2][2][4][2], const Unit& u, int wr, int wc, int fr, int fq) const {
        typedef unsigned u32x2 __attribute__((ext_vector_type(2)));
        const int row0 = u.pm * BM + wr * 64 + fr, col0 = u.pn * BM + wc * 32 + 4 * fq;
#pragma unroll
        for (int ai = 0; ai < 2; ++ai) {
#if RES_BF16
            u32x2 xr[4][2][2]; float sc[4];
#pragma unroll
            for (int m = 0; m < 4; ++m) { const int row = row0 + ai * HALF + m * 16; const bf16_t* rowp = XB + (size_t)row * 2048 + col0; sc[m] = r2[row];
#pragma unroll
                for (int bj = 0; bj < 2; ++bj) { xr[m][bj][0] = *(const u32x2*)(rowp + bj * HALF); xr[m][bj][1] = *(const u32x2*)(rowp + bj * HALF + 16); } }
            __builtin_amdgcn_sched_barrier(0);
#pragma unroll
            for (int m = 0; m < 4; ++m) { float* rowp = out + (size_t)(row0 + ai * HALF + m * 16) * 2048 + col0;
#pragma unroll
                for (int bj = 0; bj < 2; ++bj)
#pragma unroll
                    for (int n = 0; n < 2; ++n) { const u32x2 w = xr[m][bj][n];
                        const f32x4 x = (f32x4){__builtin_bit_cast(float, w.x << 16), __builtin_bit_cast(float, w.x & 0xffff0000u), __builtin_bit_cast(float, w.y << 16), __builtin_bit_cast(float, w.y & 0xffff0000u)};
                        *(f32x4*)(rowp + bj * HALF + n * 16) = x + acc[ai][bj][m][n] * sc[m]; } }
            __builtin_amdgcn_sched_barrier(0);
#else
            f32x4 xr[4][2][2]; float sc[4];
#pragma unroll
            for (int m = 0; m < 4; ++m) { const int row = row0 + ai * HALF + m * 16; const float* rowp = out + (size_t)row * 2048 + col0; sc[m] = r2[row];
#pragma unroll
                for (int bj = 0; bj < 2; ++bj) { xr[m][bj][0] = *(const f32x4*)(rowp + bj * HALF); xr[m][bj][1] = *(const f32x4*)(rowp + bj * HALF + 16); } }
            __builtin_amdgcn_sched_barrier(0);
#pragma unroll
            for (int m = 0; m < 4; ++m) { float* rowp = out + (size_t)(row0 + ai * HALF + m * 16) * 2048 + col0;
#pragma unroll
                for (int bj = 0; bj < 2; ++bj) { *(f32x4*)(rowp + bj * HALF) = xr[m][bj][0] + acc[ai][bj][m][0] * sc[m]; *(f32x4*)(rowp + bj * HALF + 16) = xr[m][bj][1] + acc[ai][bj][m][1] * sc[m]; } }
            __builtin_amdgcn_sched_barrier(0);
#endif
        }
    }
};

template <class Epi, class Sched, bool ALIGN_EPI = false, bool SP2 = false>
__device__ __forceinline__ void gemm_phase(PG8_LAS unsigned char* lds, const Gemm g, const Sched& S, const Epi& E) {
    int tid_ = threadIdx.x; asm volatile("" : "+v"(tid_));
    const int tid = tid_, wid = __builtin_amdgcn_readfirstlane(tid >> 6), lane = tid & 63, wr = wid >> 2, wc = wid & 3, fr = lane & 15, fq = lane >> 4;
    const int K = g.K, nt = K / BK;
    unsigned voffA[2], voffB[2];
#pragma unroll
    for (int i = 0; i < 2; ++i) { int R, C; stage_rc(tid * 16 + i * 8192, R, C); const int Rb = Epi::PERM ? ((R & ~31) + perm32(R & 31)) : R;
        voffA[i] = (unsigned)(R * K + C) * 2u; voffB[i] = (unsigned)(Rb * K + C) * 2u; }
    const size_t kstep = (size_t)(BK * 2);
    const size_t hstep = (size_t)HALF * K * 2;
    const size_t tstep = 2 * hstep;
    const unsigned ldsw = (unsigned)wid * 1024u;
    const int aoff = lds_byte(wr * 64 + fr, fq * 8), boff = lds_byte(wc * 32 + fr, fq * 8);
#define PG8_SA(b, h) (((b) * 2 + (h)) * HTB)
#define PG8_SB(b, h) ((4 + (b) * 2 + (h)) * HTB)
#define PG8_STAGE(bufoff, gbase, voff) do { _Pragma("unroll") for (int _i = 0; _i < 2; ++_i) \
        __builtin_amdgcn_global_load_lds((const unsigned*)((const char*)(gbase) + (voff)[_i]), (PG8_LAS unsigned*)(lds + (bufoff) + ldsw + _i * 8192), 16, 0, 0); } while (0)
#define PG8_LDA(dst, b, h) do { _Pragma("unroll") for (int m = 0; m < 4; ++m) _Pragma("unroll") for (int k = 0; k < 2; ++k) dst[m][k] = *(const PG8_LAS bf16x8*)(lds + PG8_SA(b, h) + aoff + m * 2048 + k * 1024); } while (0)
#define PG8_LDB(dst, b, h) do { _Pragma("unroll") for (int n = 0; n < 2; ++n) _Pragma("unroll") for (int k = 0; k < 2; ++k) dst[n][k] = *(const PG8_LAS bf16x8*)(lds + PG8_SB(b, h) + boff + n * 2048 + k * 1024); } while (0)
#define PG8_MMA(ai, bj, At, Bt) do { __builtin_amdgcn_s_setprio(1); _Pragma("unroll") for (int m = 0; m < 4; ++m) _Pragma("unroll") for (int n = 0; n < 2; ++n) _Pragma("unroll") for (int k = 0; k < 2; ++k) \
        acc[ai][bj][m][n] = __builtin_amdgcn_mfma_f32_16x16x32_bf16(Bt[n][k], At[m][k], acc[ai][bj][m][n], 0, 0, 0); __builtin_amdgcn_s_setprio(0); } while (0)
#define PG8_WAIT_V(n) asm volatile("s_waitcnt vmcnt(" #n ")" ::: "memory")
#define PG8_WAIT_L(n) asm volatile("s_waitcnt lgkmcnt(" #n ")" ::: "memory")
#define PG8_BAR __builtin_amdgcn_s_barrier()
#define PG8_SCHED __builtin_amdgcn_sched_barrier(0)
    Unit cur, nxt; int ui = 0;
    if (!S.next(0, cur)) return;
    f32x4 acc[2][2][4][2];
#pragma unroll
    for (int a = 0; a < 2; ++a)
#pragma unroll
        for (int b = 0; b < 2; ++b)
#pragma unroll
            for (int m = 0; m < 4; ++m)
#pragma unroll
                for (int n = 0; n < 2; ++n) acc[a][b][m][n] = (f32x4){0.f, 0.f, 0.f, 0.f};
    bf16x8 At[4][2], B0[2][2], B1[2][2];
    const char* cA = (const char*)g.A + (size_t)cur.pm * tstep; const char* cB = (const char*)g.Bt + (size_t)cur.pn * tstep;
    S.a_ready(cur);
    if constexpr (SP2) {
        PG8_STAGE(PG8_SB(0, 0), cB, voffB); PG8_STAGE(PG8_SB(0, 1), cB + hstep, voffB); PG8_STAGE(PG8_SA(0, 0), cA, voffA); PG8_STAGE(PG8_SA(0, 1), cA + hstep, voffA);
        if (wr == 1) PG8_BAR;
        PG8_WAIT_V(2); PG8_BAR;
        PG8_STAGE(PG8_SB(1, 0), cB + kstep, voffB); PG8_STAGE(PG8_SA(1, 0), cA + kstep, voffA); PG8_STAGE(PG8_SB(1, 1), cB + hstep + kstep, voffB);
        PG8_WAIT_V(6); PG8_BAR;
    } else {
        PG8_STAGE(PG8_SB(0, 0), cB, voffB); PG8_STAGE(PG8_SA(0, 0), cA, voffA); PG8_STAGE(PG8_SB(0, 1), cB + hstep, voffB); PG8_STAGE(PG8_SA(0, 1), cA + hstep, voffA);
        if (wr == 1) PG8_BAR;
        PG8_WAIT_V(4); PG8_BAR;
        PG8_STAGE(PG8_SB(1, 0), cB + kstep, voffB); PG8_STAGE(PG8_SA(1, 0), cA + kstep, voffA); PG8_STAGE(PG8_SB(1, 1), cB + hstep + kstep, voffB);
        PG8_WAIT_V(6); PG8_BAR;
    }
    for (;;) {
        const bool has_next = S.next(ui + 1, nxt);
        const char* nA = has_next ? (const char*)g.A + (size_t)nxt.pm * tstep : cA; const char* nB = has_next ? (const char*)g.Bt + (size_t)nxt.pn * tstep : cB;
        for (int t = 0; t < nt; t += 2) {
            const bool last = (t == nt - 2);
            const char* a1 = cA + (size_t)(t + 1) * kstep;
            const char* a2 = last ? nA : cA + (size_t)(t + 2) * kstep; const char* b2 = last ? nB : cB + (size_t)(t + 2) * kstep;
            const char* a3 = a2 + kstep; const char* b3 = b2 + kstep;
            if (last && has_next) S.a_ready(nxt);
            if constexpr (SP2) {
            PG8_LDB(B0, 0, 0); PG8_LDB(B1, 0, 1); PG8_SCHED; PG8_LDA(At, 0, 0); PG8_STAGE(PG8_SA(1, 1), a1 + hstep, voffA);
            PG8_WAIT_V(8); PG8_WAIT_L(0); PG8_BAR; PG8_MMA(0, 0, At, B0); PG8_MMA(0, 1, At, B1); PG8_BAR; PG8_SCHED;
            PG8_LDA(At, 0, 1); PG8_STAGE(PG8_SB(0, 0), b2, voffB); PG8_STAGE(PG8_SB(0, 1), b2 + hstep, voffB); PG8_STAGE(PG8_SA(0, 0), a2, voffA);
            PG8_WAIT_V(8); PG8_WAIT_L(0); PG8_BAR; PG8_MMA(1, 0, At, B0); PG8_MMA(1, 1, At, B1); PG8_BAR; PG8_SCHED;
            PG8_LDB(B0, 1, 0); PG8_LDB(B1, 1, 1); PG8_SCHED; PG8_LDA(At, 1, 0); PG8_STAGE(PG8_SA(0, 1), a2 + hstep, voffA);
            PG8_WAIT_V(8); PG8_WAIT_L(0); PG8_BAR; PG8_MMA(0, 0, At, B0); PG8_MMA(0, 1, At, B1); PG8_BAR; PG8_SCHED;
            PG8_LDA(At, 1, 1); PG8_STAGE(PG8_SB(1, 0), b3, voffB); PG8_STAGE(PG8_SB(1, 1), b3 + hstep, voffB); PG8_STAGE(PG8_SA(1, 0), a3, voffA);
            PG8_WAIT_V(8); PG8_WAIT_L(0); PG8_BAR; PG8_MMA(1, 0, At, B0); PG8_MMA(1, 1, At, B1); PG8_BAR; PG8_SCHED;
            } else {
            PG8_LDB(B0, 0, 0); PG8_SCHED; PG8_LDA(At, 0, 0); PG8_STAGE(PG8_SA(1, 1), a1 + hstep, voffA);
            PG8_WAIT_L(8); PG8_BAR; PG8_WAIT_L(0); PG8_MMA(0, 0, At, B0); PG8_BAR; PG8_SCHED;
            PG8_LDB(B1, 0, 1); PG8_STAGE(PG8_SB(0, 0), b2, voffB);
            PG8_BAR; PG8_WAIT_L(0); PG8_MMA(0, 1, At, B1); PG8_BAR;
            PG8_LDA(At, 0, 1); PG8_STAGE(PG8_SA(0, 0), a2, voffA);
            PG8_BAR; PG8_WAIT_L(0); PG8_MMA(1, 0, At, B0); PG8_BAR; PG8_SCHED;
            PG8_STAGE(PG8_SB(0, 1), b2 + hstep, voffB);
            PG8_WAIT_V(6); PG8_BAR; PG8_MMA(1, 1, At, B1); PG8_BAR;
            PG8_LDB(B0, 1, 0); PG8_SCHED; PG8_LDA(At, 1, 0); PG8_STAGE(PG8_SA(0, 1), a2 + hstep, voffA);
            PG8_WAIT_L(8); PG8_BAR; PG8_WAIT_L(0); PG8_MMA(0, 0, At, B0); PG8_BAR; PG8_SCHED;
            PG8_LDB(B1, 1, 1); PG8_STAGE(PG8_SB(1, 0), b3, voffB);
            PG8_BAR; PG8_WAIT_L(0); PG8_MMA(0, 1, At, B1); PG8_BAR;
            PG8_LDA(At, 1, 1); PG8_STAGE(PG8_SA(1, 0), a3, voffA);
            PG8_BAR; PG8_WAIT_L(0); PG8_MMA(1, 0, At, B0); PG8_BAR; PG8_SCHED;
            PG8_STAGE(PG8_SB(1, 1), b3 + hstep, voffB);
            PG8_WAIT_V(6); PG8_BAR; PG8_MMA(1, 1, At, B1); PG8_BAR;
            }
        }
        if constexpr (ALIGN_EPI) { if (wr == 0) PG8_BAR; }
        if constexpr (!Epi::AFTER_DRAIN) { E(acc, cur, wr, wc, fr, fq); S.done(cur); }
        if (!has_next) break;
#pragma unroll
        for (int a = 0; a < 2; ++a)
#pragma unroll
            for (int b = 0; b < 2; ++b)
#pragma unroll
                for (int m = 0; m < 4; ++m)
#pragma unroll
                    for (int n = 0; n < 2; ++n) acc[a][b][m][n] = (f32x4){0.f, 0.f, 0.f, 0.f};
        cur = nxt; cA = nA; cB = nB; ++ui;
        if constexpr (ALIGN_EPI) { if (wr == 1) PG8_BAR; }
    }
    PG8_WAIT_V(0);
    if constexpr (!ALIGN_EPI) { if (wr == 0) PG8_BAR; }
    PG8_BAR;
    if constexpr (Epi::AFTER_DRAIN) { E.fused(acc, cur, wr, wc, fr, fq, lds, wid, lane); S.done(cur); }
#undef PG8_SA
#undef PG8_SB
#undef PG8_STAGE
#undef PG8_LDA
#undef PG8_LDB
#undef PG8_MMA
#undef PG8_WAIT_V
#undef PG8_WAIT_L
#undef PG8_BAR
#undef PG8_SCHED
}
}

constexpr int NWAVES = 8;
constexpr int DM = 2048, NB = 16, SEQ = 2048, DB = 128, DS = 4, HD = 64, NH = 16, NKV = 4, CCH = 1024, CW = 31, FF = 8192;
constexpr int MP = NB * SEQ, MS = DB * DS, M = MP + MS;
constexpr int INW = 3584, ZW = 1536;
constexpr float EPS = 1e-6f;
constexpr float QSCALE = 0.125f * 1.4426950408889634f;
constexpr float LOG2E = 1.4426950408889634f;
constexpr size_t O_Y = 0, O_KP = (size_t)M * DM, O_VP = O_KP + (size_t)NB * 128 * 256, O_CP = O_VP + (size_t)NB * 128 * 256,
                 O_KS = O_CP + (size_t)NB * 30 * CCH, O_VS = O_KS + (size_t)DB * 128 * 256, O_CS = O_VS + (size_t)DB * 128 * 256, O_END = O_CS + (size_t)DB * 30 * CCH;
constexpr size_t MiB = 1u << 20;
constexpr size_t WS_CTL = 0, CTL_ZERO_BYTES = 64 * 1024;
constexpr size_t WS_WIN = 1 * MiB, WS_WOUT = 15 * MiB, WS_WUP = 23 * MiB, WS_WDN = 55 * MiB;
constexpr size_t WS_RSTD1 = 87 * MiB, WS_R2 = 88 * MiB, WS_SSQS = 88 * MiB + 512 * 1024, WS_SSQ = 89 * MiB;
constexpr size_t WS_XB = 94 * MiB;
constexpr size_t WS_Z = 224 * MiB, WS_U = 322 * MiB, WS_MIX = 387 * MiB;
constexpr size_t WS_H = 224 * MiB, WS_END = 744 * MiB;
static_assert(WS_Z + (size_t)M * ZW * 2 <= WS_U && WS_U + (size_t)M * CCH * 2 <= WS_MIX && WS_MIX + (size_t)M * DM * 2 <= WS_END && WS_H + (size_t)M * FF * 2 <= WS_END, "d_ws map");
static_assert(WS_XB + (size_t)M * DM * 2 <= WS_Z && WS_SSQ + (size_t)M * 32 * 4 <= WS_XB && WS_WIN + (size_t)INW * DM * 2 <= WS_WOUT, "d_ws map");
constexpr int CW_BAR = 4096;
constexpr int RING_BYTES = 131072, MISC_OFF = RING_BYTES + 320, LDS_BYTES = 147456;
#define GAS __attribute__((address_space(1)))
#define LAS __attribute__((address_space(3)))
typedef unsigned short bf16;
typedef unsigned v4u __attribute__((ext_vector_type(4)));
typedef float f32x4 __attribute__((ext_vector_type(4)));
typedef short bf16x8 __attribute__((ext_vector_type(8)));
typedef GAS unsigned gu32;
typedef GAS unsigned long long gu64;
#define RLX_AGENT __ATOMIC_RELAXED, __HIP_MEMORY_SCOPE_AGENT
#define LDS_WAIT() asm volatile("s_waitcnt lgkmcnt(0)" ::: "memory")
#define VM_WAIT() asm volatile("s_waitcnt vmcnt(0)" ::: "memory")
__device__ __forceinline__ unsigned long long rt() { return __builtin_amdgcn_s_memrealtime(); }
__device__ __forceinline__ unsigned f2bf(float f) { unsigned u = __builtin_bit_cast(unsigned, f); return (u + 0x7fffu + ((u >> 16) & 1u)) >> 16; }
__device__ __forceinline__ unsigned pk2(float lo, float hi) { return f2bf(lo) | (f2bf(hi) << 16); }

#define XB_TMO      128
#define XB_XCNT(j)  (256  + 64 * (j))
#define XB_XSUB(j)  (1280 + 64 * (j))
#define XB_XGEN(j)  (2304 + 64 * (j))
#define XB_TOP      3328
#define XB_TOPGEN   3392
#define XCD_BAR_WORDS 3456
#define XB_SPIN_CAP (1u << 18)

__device__ __forceinline__ unsigned xb_ld(unsigned* p)              { return __hip_atomic_load(p, __ATOMIC_RELAXED, __HIP_MEMORY_SCOPE_AGENT); }
__device__ __forceinline__ unsigned xb_add(unsigned* p, unsigned v) { return __hip_atomic_fetch_add(p, v, __ATOMIC_RELAXED, __HIP_MEMORY_SCOPE_AGENT); }
__device__ __forceinline__ unsigned xb_xcc_id() { return (unsigned)__builtin_amdgcn_s_getreg((3 << 11) | 20) & 0xFu; }
#define XB_SPIN(cond, bar) do { unsigned _sp = 0; while (cond) { __builtin_amdgcn_s_sleep(1); \
    if ((++_sp & 255u) == 0u) { if (xb_ld(&(bar)[XB_TMO])) break; if (_sp > XB_SPIN_CAP) { atomicAdd(&(bar)[XB_TMO], 1u); break; } } } } while (0)

struct XcdBarrier {
    unsigned* bar; unsigned x;
    volatile LAS unsigned* st;
};

__device__ __forceinline__ XcdBarrier xcd_barrier_post(unsigned* bar, volatile LAS unsigned* st) {
    XcdBarrier b; b.bar = bar; b.x = xb_xcc_id(); b.st = st;
    if (threadIdx.x == 0) (void)xb_add(&bar[XB_XCNT(b.x)], 1u);
    return b;
}
__device__ __forceinline__ void xcd_barrier_complete(unsigned* bar, unsigned x, unsigned& nloc, unsigned& nx) {
    const unsigned G = gridDim.x * gridDim.y * gridDim.z;
    unsigned sum, cnt, mine, sp = 0u;
    for (;;) {
        sum = 0u; cnt = 0u; mine = 0u;
#pragma unroll
        for (unsigned j = 0; j < 16; ++j) { const unsigned c = xb_ld(&bar[XB_XCNT(j)]); sum += c; cnt += (c > 0u) ? 1u : 0u; mine = (j == x) ? c : mine; }
        if (sum == G) break;
        __builtin_amdgcn_s_sleep(1);
        if ((++sp & 255u) == 0u) { if (xb_ld(&bar[XB_TMO])) break; if (sp > XB_SPIN_CAP) { atomicAdd(&bar[XB_TMO], 1u); break; } }
    }
    nloc = mine > 0u ? mine : 1u; nx = cnt > 0u ? cnt : 1u;
}

__device__ __forceinline__ void xcd_barrier(const XcdBarrier& b) {
    asm volatile("s_waitcnt vmcnt(0)" ::: "memory");
    __syncthreads();
    if (threadIdx.x == 0) {
        unsigned* bar = b.bar;
        __builtin_amdgcn_s_waitcnt(0);
        unsigned nloc = b.st[0], nx = b.st[1];
        if (nloc == 0u) { xcd_barrier_complete(bar, b.x, nloc, nx); b.st[0] = nloc; b.st[1] = nx; }
        const unsigned old = xb_add(&bar[XB_XSUB(b.x)], 1u);
        const unsigned gen = old / nloc;
        if (old + 1u == (gen + 1u) * nloc) {
            __builtin_amdgcn_fence(__ATOMIC_RELEASE, "agent");
            asm volatile("s_waitcnt vmcnt(0)" ::: "memory");
            const unsigned og = xb_add(&bar[XB_TOP], 1u);
            const unsigned tg = og / nx;
            if (og + 1u == (tg + 1u) * nx) xb_add(&bar[XB_TOPGEN], 1u);
            else XB_SPIN(xb_ld(&bar[XB_TOPGEN]) == tg, bar);
            __builtin_amdgcn_fence(__ATOMIC_ACQUIRE, "agent");
            xb_add(&bar[XB_XGEN(b.x)], 1u);
            asm volatile("s_waitcnt vmcnt(0)" ::: "memory");
        } else {
            XB_SPIN(xb_ld(&bar[XB_XGEN(b.x)]) == gen, bar);
            __builtin_amdgcn_fence(__ATOMIC_ACQUIRE, "agent");
            asm volatile("s_waitcnt vmcnt(0)" ::: "memory");
        }
    }
    __syncthreads();
}

typedef float f32x2 __attribute__((ext_vector_type(2)));
typedef float f32x16 __attribute__((ext_vector_type(16)));
typedef short s16x4 __attribute__((ext_vector_type(4)));
__device__ __forceinline__ unsigned cvtpk(float lo, float hi) { unsigned r; asm volatile("v_cvt_pk_bf16_f32 %0, %1, %2" : "=v"(r) : "v"(lo), "v"(hi)); return r; }
__device__ __forceinline__ float bf_lo(unsigned u) { return __builtin_bit_cast(float, u << 16); }
__device__ __forceinline__ float bf_hi(unsigned u) { return __builtin_bit_cast(float, u & 0xffff0000u); }
__device__ __forceinline__ void fmac1(float& acc, float a, float b) { asm("v_fmac_f32 %0, %1, %2" : "+v"(acc) : "v"(a), "v"(b)); }
__device__ __forceinline__ float wave_sum(float v) {
#pragma unroll
    for (int o = 1; o < 64; o <<= 1) v += __shfl_xor(v, o);
    return v;
}

struct P0Item { const float* W; const float* gain; bf16* WT; int K, N, rowmap, k0, n0; };
struct P0Mats { const float *w_in, *g_in, *w_out, *w_up, *g_up, *w_dn; bf16 *Wi, *Wo, *Wu, *Wd; };
constexpr int P0_I_IN = (DM / 64) * (INW / 32), P0_I_OUT = (DM / 64) * (DM / 32), P0_I_UP = (DM / 64) * (FF / 32), P0_I_DN = (FF / 64) * (DM / 32), P0_NITEMS = P0_I_IN + P0_I_OUT + P0_I_UP + P0_I_DN;
__device__ __forceinline__ P0Item p0_item(const P0Mats& Mx, int it) {
    P0Item I; int r = it;
    if (r < P0_I_IN) { I.W = Mx.w_in; I.gain = Mx.g_in; I.WT = Mx.Wi; I.K = DM; I.N = INW; I.rowmap = 1; }
    else if ((r -= P0_I_IN) < P0_I_OUT) { I.W = Mx.w_out; I.gain = nullptr; I.WT = Mx.Wo; I.K = DM; I.N = DM; I.rowmap = 0; }
    else if ((r -= P0_I_OUT) < P0_I_UP) { I.W = Mx.w_up; I.gain = Mx.g_up; I.WT = Mx.Wu; I.K = DM; I.N = FF; I.rowmap = 0; }
    else { r -= P0_I_UP; I.W = Mx.w_dn; I.gain = nullptr; I.WT = Mx.Wd; I.K = FF; I.N = DM; I.rowmap = 0; }
    const int nblk = I.N / 32; I.k0 = 64 * (r / nblk); I.n0 = 32 * (r % nblk); return I;
}
__device__ __forceinline__ void p0_item_issue(const P0Item& I, int lane, f32x4 (&v)[8], float (&g)[8]) {
    const int kr = lane >> 3, nc = lane & 7;
#pragma unroll
    for (int j = 0; j < 8; ++j) { v[j] = *(const f32x4*)(I.W + (size_t)(I.k0 + 8 * j + kr) * I.N + I.n0 + 4 * nc); g[j] = I.gain ? I.gain[I.k0 + 8 * j + kr] : 1.0f; }
}
__device__ __forceinline__ void p0_weights(const P0Mats& Mx, LAS float* scr, int gw, int NGW, int lane) {
    f32x4 v[8]; float g[8];
    int it = gw;
    P0Item I = p0_item(Mx, it < P0_NITEMS ? it : 0);
    if (it < P0_NITEMS) p0_item_issue(I, lane, v, g);
#pragma unroll 1
    for (; it < P0_NITEMS; it += NGW) {
        {   const int kr = lane >> 3, nc = lane & 7;
#pragma unroll
            for (int j = 0; j < 8; ++j) { LAS float* d = scr + (8 * j + kr) * 33 + 4 * nc; d[0] = v[j].x * g[j]; d[1] = v[j].y * g[j]; d[2] = v[j].z * g[j]; d[3] = v[j].w * g[j]; } }
        const P0Item C = I;
        if (it + NGW < P0_NITEMS) { I = p0_item(Mx, it + NGW); p0_item_issue(I, lane, v, g); }
        __builtin_amdgcn_sched_barrier(0);
        LDS_WAIT(); asm volatile("" ::: "memory");
        int nd0 = C.n0;
        if (C.rowmap == 1 && C.n0 >= ZW) { int c = C.n0 - ZW; if (c < CCH) nd0 = ZW + 256 * (c >> 7) + (c & 127); else { c -= CCH; nd0 = ZW + 256 * (c >> 7) + 128 + (c & 127); } }
        const int c = lane & 7;
#pragma unroll
        for (int j = 0; j < 4; ++j) { const int n = (lane >> 3) + 8 * j; const LAS float* s = scr + (8 * c) * 33 + n;
            v4u o; o.x = pk2(s[0 * 33], s[1 * 33]); o.y = pk2(s[2 * 33], s[3 * 33]); o.z = pk2(s[4 * 33], s[5 * 33]); o.w = pk2(s[6 * 33], s[7 * 33]);
            *(GAS v4u*)(C.WT + (size_t)(nd0 + n) * C.K + C.k0 + 8 * c) = o; }
        LDS_WAIT(); asm volatile("" ::: "memory");
    }
}
__device__ __forceinline__ void p0_xrows(const float* xp, const float* xs, bf16* XB, float* rstd1, int gw, int NGW, int lane) {
    f32x4 v[8];
    int m = gw;
    if (m < M) { const GAS f32x4* xr = (const GAS f32x4*)((m < MP) ? xp + (size_t)m * DM : xs + (size_t)(m - MP) * DM) + lane;
#pragma unroll
        for (int j = 0; j < 8; ++j) v[j] = xr[64 * j]; }
#pragma unroll 1
    for (; m < M; m += NGW) {
        float s = 0.f; unsigned long long pk[8];
#pragma unroll
        for (int j = 0; j < 8; ++j) { s += (v[j].x * v[j].x + v[j].y * v[j].y) + (v[j].z * v[j].z + v[j].w * v[j].w); pk[j] = (unsigned long long)cvtpk(v[j].x, v[j].y) | ((unsigned long long)cvtpk(v[j].z, v[j].w) << 32); }
        const int mn = m + NGW;
        if (mn < M) { const GAS f32x4* xr = (const GAS f32x4*)((mn < MP) ? xp + (size_t)mn * DM : xs + (size_t)(mn - MP) * DM) + lane;
#pragma unroll
            for (int j = 0; j < 8; ++j) v[j] = xr[64 * j]; }
        __builtin_amdgcn_sched_barrier(0);
        s = wave_sum(s);
        if (lane == 0) rstd1[m] = 1.0f / sqrtf(s * (1.0f / DM) + EPS);
        GAS unsigned long long* o8 = (GAS unsigned long long*)(XB + (size_t)m * DM) + lane;
#pragma unroll
        for (int j = 0; j < 8; ++j) o8[64 * j] = pk[j];
    }
}

constexpr int KV_RS = 144;
__device__ __forceinline__ int crow(int r, int hi) { return (r & 3) + 8 * (r >> 2) + 4 * hi; }
__device__ __forceinline__ s16x4 vtr(const LAS unsigned char* p) { return __builtin_bit_cast(s16x4, __builtin_amdgcn_ds_read_tr16_b64_v4i16((LAS s16x4*)p)); }

__device__ __forceinline__ void q_issue(const bf16* qrow, int h, v4u (&raw)[4]) {
#pragma unroll
    for (int d0 = 0; d0 < 4; ++d0) raw[d0] = *(const v4u*)(qrow + 16 * d0 + 8 * h);
}
__device__ __forceinline__ void q_finish(const v4u (&raw)[4], int h, const LAS float* gq, bf16x8 (&qf)[4]) {
    float v[4][8]; float ss = 0.f;
#pragma unroll
    for (int d0 = 0; d0 < 4; ++d0)
#pragma unroll
        for (int e = 0; e < 4; ++e) { v[d0][2 * e] = bf_lo(raw[d0][e]); v[d0][2 * e + 1] = bf_hi(raw[d0][e]); ss += v[d0][2 * e] * v[d0][2 * e] + v[d0][2 * e + 1] * v[d0][2 * e + 1]; }
    ss += __shfl_xor(ss, 32);
    const float rs = (1.0f / sqrtf(ss * (1.0f / HD) + EPS)) * QSCALE;
#pragma unroll
    for (int d0 = 0; d0 < 4; ++d0) { const f32x4 g0 = *(const LAS f32x4*)(gq + 16 * d0 + 8 * h), g1 = *(const LAS f32x4*)(gq + 16 * d0 + 8 * h + 4);
        v4u w; w.x = cvtpk(v[d0][0] * rs * g0[0], v[d0][1] * rs * g0[1]); w.y = cvtpk(v[d0][2] * rs * g0[2], v[d0][3] * rs * g0[3]);
        w.z = cvtpk(v[d0][4] * rs * g1[0], v[d0][5] * rs * g1[1]); w.w = cvtpk(v[d0][6] * rs * g1[2], v[d0][7] * rs * g1[3]);
        qf[d0] = __builtin_bit_cast(bf16x8, w); }
}
__device__ __forceinline__ void attn_core(const LAS unsigned char* Kt, const LAS unsigned char* Vt, int tt0, int qrel, int kvmin, const bf16x8 (&qf)[4], float sink2, int lane, f32x16 (&o)[2]) {
    const int r32 = lane & 31, h = lane >> 5;
    f32x16 s[5];
#pragma unroll
    for (int i = 0; i < 5; ++i) {
        const LAS unsigned char* kp = Kt + (32 * (tt0 + i) + r32) * KV_RS + h * 16;
        f32x16 a = {0.f, 0.f, 0.f, 0.f, 0.f, 0.f, 0.f, 0.f, 0.f, 0.f, 0.f, 0.f, 0.f, 0.f, 0.f, 0.f};
#pragma unroll
        for (int d0 = 0; d0 < 4; ++d0) { const bf16x8 kf = *(const LAS bf16x8*)(kp + 32 * d0); a = __builtin_amdgcn_mfma_f32_32x32x16_bf16(kf, qf[d0], a, 0, 0, 0); }
        s[i] = a;
    }
    const int qloc = qrel - 32 * tt0, ndead = (kvmin >> 5) - tt0;
    float mx = -1e30f;
#pragma unroll
    for (int i = 0; i < 5; ++i)
#pragma unroll
        for (int r = 0; r < 16; ++r) { const int cr = (r & 3) + 8 * (r >> 2); bool ok = (i >= ndead);
            if (i == 0) ok = ok && (cr + 4 * h > qloc);
            if (i == 4) ok = ok && (cr + 4 * h <= qloc);
            const float x = ok ? s[i][r] : -1e30f; s[i][r] = x; mx = fmaxf(mx, x); }
    mx = fmaxf(mx, __shfl_xor(mx, 32));
    const float mref = fmaxf(mx, sink2);
    float ls = 0.f;
#pragma unroll
    for (int i = 0; i < 5; ++i)
#pragma unroll
        for (int r = 0; r < 16; ++r) { const float p = __builtin_amdgcn_exp2f(s[i][r] - mref); s[i][r] = p; ls += p; }
    ls += __shfl_xor(ls, 32);
    const float inv = 1.0f / (ls + __builtin_amdgcn_exp2f(sink2 - mref));
    o[0] = (f32x16){0.f, 0.f, 0.f, 0.f, 0.f, 0.f, 0.f, 0.f, 0.f, 0.f, 0.f, 0.f, 0.f, 0.f, 0.f, 0.f}; o[1] = o[0];
    const LAS unsigned char* vb = Vt + (4 * h + ((lane & 15) >> 2)) * KV_RS + ((lane >> 4) & 1) * 32 + (lane & 3) * 8;
#pragma unroll
    for (int i = 0; i < 5; ++i)
#pragma unroll
        for (int st = 0; st < 2; ++st) {
            v4u pw; pw.x = cvtpk(s[i][8 * st + 0], s[i][8 * st + 1]); pw.y = cvtpk(s[i][8 * st + 2], s[i][8 * st + 3]); pw.z = cvtpk(s[i][8 * st + 4], s[i][8 * st + 5]); pw.w = cvtpk(s[i][8 * st + 6], s[i][8 * st + 7]);
            const bf16x8 pf = __builtin_bit_cast(bf16x8, pw);
#pragma unroll
            for (int dt = 0; dt < 2; ++dt) {
                const LAS unsigned char* vp = vb + (32 * (tt0 + i) + 16 * st) * KV_RS + dt * 64;
                const s16x4 lo = vtr(vp), hi = vtr(vp + 8 * KV_RS);
                const bf16x8 vf = (bf16x8){lo[0], lo[1], lo[2], lo[3], hi[0], hi[1], hi[2], hi[3]};
                o[dt] = __builtin_amdgcn_mfma_f32_32x32x16_bf16(vf, pf, o[dt], 0, 0, 0);
            }
        }
#pragma unroll
    for (int dt = 0; dt < 2; ++dt)
#pragma unroll
        for (int r = 0; r < 16; ++r) o[dt][r] *= inv;
}
__device__ __forceinline__ void store_o(bf16* orow, int h, const f32x16 (&o)[2]) {
#pragma unroll
    for (int dt = 0; dt < 2; ++dt)
#pragma unroll
        for (int g = 0; g < 4; ++g) { unsigned long long w = (unsigned long long)cvtpk(o[dt][4 * g], o[dt][4 * g + 1]) | ((unsigned long long)cvtpk(o[dt][4 * g + 2], o[dt][4 * g + 3]) << 32);
            *(unsigned long long*)(orow + 32 * dt + 8 * g + 4 * h) = w; }
}
__device__ __forceinline__ void knorm32(const v4u (&raw)[4], const LAS float* gk32, float (&kf)[32]) {
    float ss = 0.f;
#pragma unroll
    for (int i = 0; i < 4; ++i)
#pragma unroll
        for (int e = 0; e < 4; ++e) { kf[8 * i + 2 * e] = bf_lo(raw[i][e]); kf[8 * i + 2 * e + 1] = bf_hi(raw[i][e]); ss += kf[8 * i + 2 * e] * kf[8 * i + 2 * e] + kf[8 * i + 2 * e + 1] * kf[8 * i + 2 * e + 1]; }
    ss += __shfl_xor(ss, 1);
    const float rs = 1.0f / sqrtf(ss * (1.0f / HD) + EPS);
#pragma unroll
    for (int i = 0; i < 8; ++i) { const f32x4 g = *(const LAS f32x4*)(gk32 + 4 * i);
#pragma unroll
        for (int e = 0; e < 4; ++e) kf[4 * i + e] = kf[4 * i + e] * rs * g[e]; }
}
__device__ __forceinline__ void lds_put32(LAS unsigned char* dst, const float (&f)[32]) {
#pragma unroll
    for (int i = 0; i < 4; ++i) { v4u w; w.x = cvtpk(f[8 * i], f[8 * i + 1]); w.y = cvtpk(f[8 * i + 2], f[8 * i + 3]); w.z = cvtpk(f[8 * i + 4], f[8 * i + 5]); w.w = cvtpk(f[8 * i + 6], f[8 * i + 7]); *(LAS v4u*)(dst + 16 * i) = w; }
}
__device__ __forceinline__ void glb_put32(float* dst, const float (&f)[32]) {
#pragma unroll
    for (int i = 0; i < 8; ++i) *(f32x4*)(dst + 4 * i) = (f32x4){f[4 * i], f[4 * i + 1], f[4 * i + 2], f[4 * i + 3]};
}

struct P2Args { const bf16* Z; const bf16* U; bf16* MIX; const float *ck, *cv, *sc, *gq, *gk, *sinks, *wdw, *bdw, *gln, *bln; float* out; };

__device__ __forceinline__ void kv_issue(const P2Args& A, int au, int tid, v4u (&kr)[4], v4u (&vr)[4]) {
    const int b = au >> 6, qb = (au >> 2) & 15, hk = au & 3, r = tid >> 1, half = tid & 1, t = 128 * (qb - 1) + r, tc = t < 0 ? 0 : t;
    const bf16* zr = A.Z + (size_t)(b * SEQ + tc) * ZW + hk * HD + half * 32;
#pragma unroll
    for (int i = 0; i < 4; ++i) { kr[i] = *(const v4u*)(zr + 1024 + 8 * i); vr[i] = *(const v4u*)(zr + 1280 + 8 * i); }
}
__device__ __forceinline__ void attn_prompt_all(const P2Args& A, LAS unsigned char* lds, const LAS float* gq, const LAS float* gk, int bx, int G, int tid, int lane, int wave) {
    LAS unsigned char* Kt = lds; LAS unsigned char* Vt = lds + 49152;
    constexpr int NU = NB * 16 * NKV;
    const int r32 = lane & 31, h = lane >> 5;
    v4u kr[4], vr[4];
    int au = bx;
    if (au < NU) kv_issue(A, au, tid, kr, vr);
#pragma unroll 1
    for (; au < NU; au += G) {
        const int b = au >> 6, qb = (au >> 2) & 15, hk = au & 3;
        v4u qcur[4];
        { const int wu = wave * 2, g = wu >> 2, q0 = (wu & 3) * 32, head = hk * 4 + g; const size_t row = (size_t)b * SEQ + 128 * qb + q0 + r32; q_issue(A.Z + row * ZW + head * HD, h, qcur); }
        {   const int r = tid >> 1, half = tid & 1, t = 128 * (qb - 1) + r;
            if (t < 0) {
#pragma unroll
                for (int i = 0; i < 4; ++i) { kr[i] = (v4u){0u, 0u, 0u, 0u}; vr[i] = (v4u){0u, 0u, 0u, 0u}; } }
            float kf[32]; knorm32(kr, gk + half * 32, kf);
            lds_put32(Kt + r * KV_RS + half * 64, kf);
#pragma unroll
            for (int i = 0; i < 4; ++i) *(LAS v4u*)(Vt + r * KV_RS + half * 64 + 16 * i) = vr[i];
            if (qb == 15 && r >= 128) {
                const size_t oo = ((size_t)(b * 128 + (r - 128)) * NKV + hk) * HD + half * 32;
                glb_put32(A.out + O_KP + oo, kf);
                float vf[32];
#pragma unroll
                for (int i = 0; i < 4; ++i)
#pragma unroll
                    for (int e = 0; e < 4; ++e) { vf[8 * i + 2 * e] = bf_lo(vr[i][e]); vf[8 * i + 2 * e + 1] = bf_hi(vr[i][e]); }
                glb_put32(A.out + O_VP + oo, vf);
            }
        }
        __syncthreads();
#pragma unroll 1
        for (int w2 = 0; w2 < 2; ++w2) {
            const int wu = wave * 2 + w2, g = wu >> 2, q0 = (wu & 3) * 32, head = hk * 4 + g; const size_t row = (size_t)b * SEQ + 128 * qb + q0 + r32;
            v4u qnext[4];
            if (w2 == 0) q_issue(A.Z + (row + 32) * ZW + (hk * 4 + ((wu + 1) >> 2)) * HD, h, qnext);
            else {
#pragma unroll
                for (int i = 0; i < 4; ++i) qnext[i] = qcur[i]; }
            bf16x8 qf[4]; q_finish(qcur, h, gq, qf);
            if (w2 == 0 && au + G < NU) kv_issue(A, au + G, tid, kr, vr);
            f32x16 o[2];
            attn_core(Kt, Vt, q0 >> 5, q0 + r32, qb == 0 ? 128 : 0, qf, A.sinks[head] * LOG2E, lane, o);
            store_o(A.MIX + row * DM + head * HD, h, o);
#pragma unroll
            for (int i = 0; i < 4; ++i) qcur[i] = qnext[i];
        }
        __syncthreads();
    }
}
__device__ __forceinline__ void attn_sample_unit(const P2Args& A, LAS unsigned char* lds, const LAS float* gq, const LAS float* gk, int b, int hp, int tid, int lane, int wave) {
    LAS unsigned char* Kt = lds; LAS unsigned char* Vt = lds + 49152;
#pragma unroll 1
    for (int it = 0; it < 2; ++it) {
        const int task = tid + it * 512;
        if (task < 640) {
            const int hl = task / 320, rem = task % 320, r = rem >> 1, half = rem & 1, hk = 2 * hp + hl;
            LAS unsigned char* kd = Kt + hl * (160 * KV_RS) + r * KV_RS + half * 64; LAS unsigned char* vd = Vt + hl * (160 * KV_RS) + r * KV_RS + half * 64;
            float kf[32], vf[32];
            if (r < 128) {
                const size_t io = ((size_t)(b * 128 + r) * NKV + hk) * HD + half * 32;
#pragma unroll
                for (int i = 0; i < 8; ++i) { const f32x4 a = *(const f32x4*)(A.ck + io + 4 * i), c = *(const f32x4*)(A.cv + io + 4 * i);
                    kf[4 * i] = a[0]; kf[4 * i + 1] = a[1]; kf[4 * i + 2] = a[2]; kf[4 * i + 3] = a[3]; vf[4 * i] = c[0]; vf[4 * i + 1] = c[1]; vf[4 * i + 2] = c[2]; vf[4 * i + 3] = c[3]; }
                if (r >= 4) { const size_t oo = ((size_t)(b * 128 + r - 4) * NKV + hk) * HD + half * 32; glb_put32(A.out + O_KS + oo, kf); glb_put32(A.out + O_VS + oo, vf); }
            } else if (r < 132) {
                const bf16* zr = A.Z + (size_t)(MP + b * DS + (r - 128)) * ZW + hk * HD + half * 32;
                v4u kr[4], vr[4];
#pragma unroll
                for (int i = 0; i < 4; ++i) { kr[i] = *(const v4u*)(zr + 1024 + 8 * i); vr[i] = *(const v4u*)(zr + 1280 + 8 * i); }
                knorm32(kr, gk + half * 32, kf);
#pragma unroll
                for (int i = 0; i < 4; ++i)
#pragma unroll
                    for (int e = 0; e < 4; ++e) { vf[8 * i + 2 * e] = bf_lo(vr[i][e]); vf[8 * i + 2 * e + 1] = bf_hi(vr[i][e]); }
                const size_t oo = ((size_t)(b * 128 + r - 4) * NKV + hk) * HD + half * 32; glb_put32(A.out + O_KS + oo, kf); glb_put32(A.out + O_VS + oo, vf);
            } else {
#pragma unroll
                for (int i = 0; i < 32; ++i) { kf[i] = 0.f; vf[i] = 0.f; }
            }
            lds_put32(kd, kf); lds_put32(vd, vf);
        }
    }
    __syncthreads();
    if (wave < 2) {
        const int hk = 2 * hp + wave, r32 = lane & 31, h = lane >> 5, g = (r32 >> 2) & 3, i = r32 & 3, head = hk * 4 + g;
        const size_t row = (size_t)MP + b * DS + i;
        v4u qraw[4]; q_issue(A.Z + row * ZW + head * HD, h, qraw);
        bf16x8 qf[4]; q_finish(qraw, h, gq, qf);
        f32x16 o[2];
        attn_core(Kt + wave * (160 * KV_RS), Vt + wave * (160 * KV_RS), 0, i, 0, qf, A.sinks[head] * LOG2E, lane, o);
        if (r32 < 16) store_o(A.MIX + row * DM + head * HD, h, o);
    }
    __syncthreads();
}

template <int TT>
__device__ __forceinline__ void conv_ln_store(f32x2 (&acc)[TT], f32x2 bdw, f32x2 gln, f32x2 bln, LAS float* red, LAS float* fin, bf16* mixrow0  , int tid) {
#pragma unroll
    for (int tt = 0; tt < TT; ++tt) { const f32x2 y = acc[tt] + bdw; acc[tt] = y; red[(2 * tt) * 512 + tid] = y.x + y.y; red[(2 * tt + 1) * 512 + tid] = y.x * y.x + y.y * y.y; }
    __syncthreads();
    {   constexpr int NV = 2 * TT, PER = 512 / NV;
        const int v = tid / PER, p = tid % PER; float s = 0.f;
#pragma unroll
        for (int k = 0; k < NV; ++k) s += red[v * 512 + k * PER + p];
#pragma unroll
        for (int o = 1; o < PER; o <<= 1) s += __shfl_xor(s, o);
        if (p == 0) fin[v] = s; }
    __syncthreads();
#pragma unroll
    for (int tt = 0; tt < TT; ++tt) {
        const float mean = fin[2 * tt] * (1.0f / CCH), var = fin[2 * tt + 1] * (1.0f / CCH) - mean * mean, rstd = 1.0f / sqrtf(var + EPS);
        const f32x2 val = (acc[tt] - mean) * rstd * gln + bln;
        const float o0 = val.x * __builtin_amdgcn_rcpf(1.0f + __expf(-val.x)), o1 = val.y * __builtin_amdgcn_rcpf(1.0f + __expf(-val.y));
        *(unsigned*)(mixrow0 + (size_t)tt * DM) = cvtpk(o0, o1);
    }
}
constexpr int CTT = 16;
__device__ __forceinline__ void conv_issue(const P2Args& A, int cu, int c, unsigned (&raw)[CTT + 30]) {
    const int b = cu >> 7, t0 = (cu & 127) * CTT;
#pragma unroll
    for (int rr = 0; rr < CTT + 30; ++rr) { const int t = t0 - 30 + rr, tc = t < 0 ? 0 : t; raw[rr] = *(const unsigned*)(A.U + (size_t)(b * SEQ + tc) * CCH + c); }
}
__device__ __forceinline__ void conv_prompt_all(const P2Args& A, LAS unsigned char* lds, const f32x2 (&w)[CW], f32x2 bdw, f32x2 gln, f32x2 bln, int bx, int G, int tid) {
    LAS float* red = (LAS float*)lds; LAS float* fin = (LAS float*)(lds + 65536);
    constexpr int NU = MP / CTT;
    const int c = 2 * tid;
    unsigned raw[CTT + 30];
    int cu = bx;
    if (cu < NU) conv_issue(A, cu, c, raw);
#pragma unroll 1
    for (; cu < NU; cu += G) {
        const int b = cu >> 7, t0 = (cu & 127) * CTT;
        float ax[CTT], ay[CTT];
#pragma unroll
        for (int tt = 0; tt < CTT; ++tt) { ax[tt] = 0.f; ay[tt] = 0.f; }
#pragma unroll
        for (int rr = 0; rr < CTT + 30; ++rr) {
            const bool ok = (t0 - 30 + rr) >= 0; const float ux = ok ? bf_lo(raw[rr]) : 0.f, uy = ok ? bf_hi(raw[rr]) : 0.f;
#pragma unroll
            for (int tt = 0; tt < CTT; ++tt) { const int j = rr - tt; if (j >= 0 && j < CW) { fmac1(ax[tt], w[j].x, ux); fmac1(ay[tt], w[j].y, uy); } }
        }
        f32x2 acc[CTT];
#pragma unroll
        for (int tt = 0; tt < CTT; ++tt) acc[tt] = (f32x2){ax[tt], ay[tt]};
        if (t0 + CTT > SEQ - 30) {
#pragma unroll
            for (int rr = 30; rr < CTT + 30; ++rr) { const int t = t0 - 30 + rr; if (t >= SEQ - 30) *(f32x2*)(A.out + O_CP + ((size_t)b * 30 + t - (SEQ - 30)) * CCH + c) = (f32x2){bf_lo(raw[rr]), bf_hi(raw[rr])}; }
        }
        if (cu + G < NU) conv_issue(A, cu + G, c, raw);
        conv_ln_store<CTT>(acc, bdw, gln, bln, red, fin, A.MIX + (size_t)(b * SEQ + t0) * DM + 1024 + c, tid);
    }
}
__device__ __forceinline__ void conv_sample_unit(const P2Args& A, LAS unsigned char* lds, int b, const f32x2 (&w)[CW], f32x2 bdw, f32x2 gln, f32x2 bln, int tid) {
    LAS float* red = (LAS float*)lds; LAS float* fin = (LAS float*)(lds + 65536);
    const int c = 2 * tid;
    f32x2 ue[30 + DS];
#pragma unroll
    for (int rr = 0; rr < 30; ++rr) ue[rr] = *(const f32x2*)(A.sc + ((size_t)b * 30 + rr) * CCH + c);
#pragma unroll
    for (int rr = 0; rr < DS; ++rr) { const unsigned raw = *(const unsigned*)(A.U + (size_t)(MP + b * DS + rr) * CCH + c); ue[30 + rr] = (f32x2){bf_lo(raw), bf_hi(raw)}; }
    f32x2 acc[DS];
#pragma unroll
    for (int tt = 0; tt < DS; ++tt) acc[tt] = (f32x2){0.f, 0.f};
#pragma unroll
    for (int rr = 0; rr < DS + 30; ++rr)
#pragma unroll
        for (int tt = 0; tt < DS; ++tt) { const int j = rr - tt; if (j >= 0 && j < CW) acc[tt] += w[j] * ue[rr]; }
#pragma unroll
    for (int rr = DS; rr < 30 + DS; ++rr) *(f32x2*)(A.out + O_CS + ((size_t)b * 30 + rr - DS) * CCH + c) = ue[rr];
    conv_ln_store<DS>(acc, bdw, gln, bln, red, fin, A.MIX + (size_t)(MP + b * DS) * DM + 1024 + c, tid);
}

__device__ __forceinline__ void run_p2(const P2Args& A, LAS unsigned char* lds, int bx, int G, int tid, int lane, int wave) {
    LAS float* gq = (LAS float*)(lds + 98304); LAS float* gk = gq + 64;
    if (tid < 64) gq[tid] = A.gq[tid]; else if (tid < 128) gk[tid - 64] = A.gk[tid - 64];
    __syncthreads();
    attn_prompt_all(A, lds, gq, gk, bx, G, tid, lane, wave);
#if PROBE == 4
    attn_prompt_all(A, lds, gq, gk, bx, G, tid, lane, wave);
#endif
    for (int su = bx; su < DB * 2; su += G) attn_sample_unit(A, lds, gq, gk, su >> 1, su & 1, tid, lane, wave);
#if PROBE == 6
    for (int su = bx; su < DB * 2; su += G) attn_sample_unit(A, lds, gq, gk, su >> 1, su & 1, tid, lane, wave);
#endif
    f32x2 w[CW];
#pragma unroll
    for (int j = 0; j < CW; ++j) w[j] = *(const f32x2*)(A.wdw + j * CCH + 2 * tid);
    const f32x2 bdw = *(const f32x2*)(A.bdw + 2 * tid), gln = *(const f32x2*)(A.gln + 2 * tid), bln = *(const f32x2*)(A.bln + 2 * tid);
    conv_prompt_all(A, lds, w, bdw, gln, bln, bx, G, tid);
#if PROBE == 5
    conv_prompt_all(A, lds, w, bdw, gln, bln, bx, G, tid);
#endif
    for (int cu = bx; cu < DB; cu += G) conv_sample_unit(A, lds, cu, w, bdw, gln, bln, tid);
#if PROBE == 6
    for (int cu = bx; cu < DB; cu += G) conv_sample_unit(A, lds, cu, w, bdw, gln, bln, tid);
#endif
}

template <int MODE> struct SEpi;
struct SgPtrs { bf16* Z; bf16* U; const float* rstd1; const float* xs; float* out; bf16* XB; float* ssqs; bf16* H; const float* r2; };
__device__ __forceinline__ void sg_store_bf16(bf16* p, float x) { *p = (bf16)f2bf(x); }
template <int MODE>
__device__ __forceinline__ void sg_epilogue(const SgPtrs& P, const float (&v)[2][4], int rs0  , int nblk  , int r) {
#pragma unroll
    for (int e = 0; e < 4; ++e) {
        const int rs = rs0 + e; const size_t row = (size_t)MP + rs;
        if (MODE == 0) { const float s = P.rstd1[row];
#pragma unroll
            for (int cb = 0; cb < 2; ++cb) sg_store_bf16(P.Z + row * ZW + 64 * nblk + 32 * cb + r, v[cb][e] * s); }
        if (MODE == 1) { const float s = P.rstd1[row]; const float a = v[0][e] * s, g = v[1][e] * s; sg_store_bf16(P.U + row * CCH + 32 * nblk + r, a * __builtin_amdgcn_rcpf(1.0f + __expf(-g))); }
        if (MODE == 2) {
#pragma unroll
            for (int cb = 0; cb < 2; ++cb) { const int col = 64 * nblk + 32 * cb + r; const float x1 = P.xs[(size_t)rs * DM + col] + v[cb][e];
                P.out[row * DM + col] = x1; sg_store_bf16(P.XB + row * DM + col, x1);
                float q = x1 * x1;
#pragma unroll
                for (int o = 1; o < 32; o <<= 1) q += __shfl_xor(q, o);
                if (r == 0) P.ssqs[(size_t)rs * 64 + 2 * nblk + cb] = q; } }
        if (MODE == 3) {
#pragma unroll
            for (int cb = 0; cb < 2; ++cb) { const float a = fmaxf(v[cb][e], 0.f); sg_store_bf16(P.H + row * FF + 64 * nblk + 32 * cb + r, a * a); } }
        if (MODE == 4) { const float s = P.r2[row];
#pragma unroll
            for (int cb = 0; cb < 2; ++cb) { float* o = P.out + row * DM + 64 * nblk + 32 * cb + r; *o = *o + s * v[cb][e]; } }
    }
}
#define SG_MMA(a0, a1, b0, b1) do { _Pragma("unroll") for (int j_ = 0; j_ < 4; ++j_) { \
        acc[0][0] = __builtin_amdgcn_mfma_f32_32x32x16_bf16(a0[j_], b0[j_], acc[0][0], 0, 0, 0); \
        acc[0][1] = __builtin_amdgcn_mfma_f32_32x32x16_bf16(a0[j_], b1[j_], acc[0][1], 0, 0, 0); \
        acc[1][0] = __builtin_amdgcn_mfma_f32_32x32x16_bf16(a1[j_], b0[j_], acc[1][0], 0, 0, 0); \
        acc[1][1] = __builtin_amdgcn_mfma_f32_32x32x16_bf16(a1[j_], b1[j_], acc[1][1], 0, 0, 0); } } while (0)
template <int MODE>
__device__ __forceinline__ void sgemm_tile(LAS unsigned char* lds, const SgPtrs& P, const bf16* A0  , const bf16* Bb0, const bf16* Bb1, int K, int mi, int nblk, int lane_, int wave) {
    int lane = lane_; asm volatile("" : "+v"(lane));
    const int r = lane & 31, h = lane >> 5, kw = K >> 3, ns = kw >> 6, lr = lane >> 3, lc = lane & 7;
    const unsigned goff = (unsigned)(lr * K + wave * kw) * 2u + (unsigned)lc * 16u, gp = (unsigned)(8 * K) * 2u;
    LAS unsigned char* wb = lds + wave * 16384;
    const int wofs0 = lr * 128 + ((lc ^ lr) * 16), wofs1 = lr * 128 + ((lc ^ lr ^ 1) * 16);
    const int rm = (r & 7) ^ ((r >> 3) & 1);
    __syncthreads();
    f32x16 acc[2][2];
#pragma unroll
    for (int i = 0; i < 2; ++i)
#pragma unroll
        for (int j = 0; j < 2; ++j) acc[i][j] = (f32x16){0.f, 0.f, 0.f, 0.f, 0.f, 0.f, 0.f, 0.f, 0.f, 0.f, 0.f, 0.f, 0.f, 0.f, 0.f, 0.f};
    v4u g[4][4];
#define SG_ISSUE(kb) do { _Pragma("unroll") for (int p_ = 0; p_ < 4; ++p_) { \
        g[0][p_] = *(const v4u*)((const char*)A0 + (goff + p_ * gp + (kb))); g[1][p_] = *(const v4u*)((const char*)A0 + (goff + (p_ + 4) * gp + (kb))); \
        g[2][p_] = *(const v4u*)((const char*)Bb0 + (goff + p_ * gp + (kb))); g[3][p_] = *(const v4u*)((const char*)Bb1 + (goff + p_ * gp + (kb))); } } while (0)
#define SG_WRITE() do { _Pragma("unroll") for (int b_ = 0; b_ < 4; ++b_) _Pragma("unroll") for (int p_ = 0; p_ < 4; ++p_) \
        *(LAS v4u*)(wb + b_ * 4096 + p_ * 1024 + ((p_ & 1) ? wofs1 : wofs0)) = g[b_][p_]; } while (0)
    SG_ISSUE(0u);
    SG_WRITE();
#pragma unroll 1
    for (int s = 0; s < ns; ++s) {
        const bool more = (s + 1 < ns);
        if (more) SG_ISSUE(128u * (unsigned)(s + 1));
        __builtin_amdgcn_sched_barrier(0);
        bf16x8 a0[4], a1[4], b0[4], b1[4];
#pragma unroll
        for (int j = 0; j < 4; ++j) { const int co = r * 128 + (((2 * j + h) ^ rm) * 16);
            a0[j] = *(const LAS bf16x8*)(wb + co); a1[j] = *(const LAS bf16x8*)(wb + 4096 + co); b0[j] = *(const LAS bf16x8*)(wb + 8192 + co); b1[j] = *(const LAS bf16x8*)(wb + 12288 + co); }
        SG_MMA(a0, a1, b0, b1);
        __builtin_amdgcn_sched_barrier(0);
        if (more) SG_WRITE();
    }
#undef SG_ISSUE
#undef SG_WRITE
    LAS float* red = (LAS float*)lds;
    __syncthreads();
#pragma unroll
    for (int rb = 0; rb < 2; ++rb)
#pragma unroll
        for (int cb = 0; cb < 2; ++cb)
#pragma unroll
            for (int g2 = 0; g2 < 16; ++g2) red[(wave * 64 + rb * 32 + cb * 16 + g2) * 64 + lane] = acc[rb][cb][g2];
    __syncthreads();
    const int rb = wave >> 2, q = wave & 3;
    float v[2][4];
#pragma unroll
    for (int cb = 0; cb < 2; ++cb)
#pragma unroll
        for (int e2 = 0; e2 < 4; ++e2) { float sm = 0.f;
#pragma unroll
            for (int ww = 0; ww < 8; ++ww) sm += red[(ww * 64 + rb * 32 + cb * 16 + 4 * q + e2) * 64 + lane];
            v[cb][e2] = sm; }
    sg_epilogue<MODE>(P, v, 64 * mi + 32 * rb + 8 * q + 4 * h, nblk, r);
}
#undef SG_MMA

struct Args { const float* in[18]; float* out; unsigned char* ws; };
__global__ void __launch_bounds__(NWAVES * 64, 2) fwd_kernel(Args args) {
    extern __shared__ __attribute__((aligned(16))) unsigned char lds_raw[];
    LAS unsigned char* lds = (LAS unsigned char*)lds_raw;
    volatile LAS unsigned* MISC = (volatile LAS unsigned*)(lds + MISC_OFF);
    const int tid = threadIdx.x, lane = tid & 63, wave = __builtin_amdgcn_readfirstlane(tid >> 6);
    const int G = gridDim.x, bx = blockIdx.x;
    unsigned char* ws = args.ws;
    unsigned* ctl = (unsigned*)(ws + WS_CTL);
    const float* xp = args.in[0]; const float* xs = args.in[1];
    bf16* Wi = (bf16*)(ws + WS_WIN); bf16* Wo = (bf16*)(ws + WS_WOUT); bf16* Wu = (bf16*)(ws + WS_WUP); bf16* Wd = (bf16*)(ws + WS_WDN);
    float* rstd1 = (float*)(ws + WS_RSTD1); float* r2 = (float*)(ws + WS_R2); float* ssq = (float*)(ws + WS_SSQ); float* ssqs = (float*)(ws + WS_SSQS);
    bf16* XB = (bf16*)(ws + WS_XB); bf16* Z = (bf16*)(ws + WS_Z); bf16* U = (bf16*)(ws + WS_U); bf16* MIX = (bf16*)(ws + WS_MIX); bf16* H = (bf16*)(ws + WS_H);
    float* out = args.out;
    const SgPtrs SP{Z, U, rstd1, xs, out, XB, ssqs, H, r2};
    const int SG_XCD = bx & 7, SG_MI = (bx >> 3) >> 2, SG_NS = (bx >> 3) & 3;
    for (int u = tid; u < (LDS_BYTES - RING_BYTES) / 4; u += NWAVES * 64) ((LAS unsigned*)(lds + RING_BYTES))[u] = 0u;
    __syncthreads();
    XcdBarrier bar = xcd_barrier_post(ctl + CW_BAR, MISC + 8);

    for (int rep_ = 0; rep_ < (PROBE == 1 ? 2 : 1); ++rep_) {
        LAS float* scr = (LAS float*)(lds + wave * 16384);
        const int gw = bx * NWAVES + wave, NGW = G * NWAVES;
        const P0Mats Mx{args.in[6], args.in[5], args.in[14], args.in[16], args.in[15], args.in[17], Wi, Wo, Wu, Wd};
        p0_weights(Mx, scr, gw, NGW, lane);
        p0_xrows(xp, xs, XB, rstd1, gw, NGW, lane);
    }
    xcd_barrier(bar);

    {
#define SGR_IN(lo, hi) for (int rd = (lo); rd < (hi); ++rd) { const int mi = SG_MI, ni = (rd * 8 + SG_XCD) * 4 + SG_NS; \
            if (ni < 24) sgemm_tile<0>(lds, SP, XB + (size_t)(MP + 64 * mi) * DM, Wi + (size_t)(64 * ni) * DM, Wi + (size_t)(64 * ni + 32) * DM, DM, mi, ni, lane, wave); \
            else if (ni < 56) { const int ci = ni - 24, ch = 32 * ci; const bf16* b0 = Wi + (size_t)(ZW + 256 * (ch >> 7) + (ch & 127)) * DM; \
                sgemm_tile<1>(lds, SP, XB + (size_t)(MP + 64 * mi) * DM, b0, b0 + (size_t)128 * DM, DM, mi, ci, lane, wave); } }
        const int nf = (SG_NS * 2) / 3;
        SGR_IN(0, nf);
        __syncthreads();
        pg8::Gemm g{XB, Wi, MP, INW, DM}; pg8::StaticOrder S; S.init(MP, INW, G, bx);
        pg8::EpiIn E{Z, U, rstd1};
        pg8::gemm_phase<pg8::EpiIn, pg8::StaticOrder, true, true>(lds, g, S, E);
        SGR_IN(nf, 2);
#undef SGR_IN
    }
    xcd_barrier(bar);

    {
        P2Args A{Z, U, MIX, args.in[2], args.in[3], args.in[4], args.in[7], args.in[8], args.in[9], args.in[10], args.in[11], args.in[12], args.in[13], out};
        run_p2(A, lds, bx, G, tid, lane, wave);
#if PROBE == 2
        run_p2(A, lds, bx, G, tid, lane, wave);
#endif
    }
    xcd_barrier(bar);

    for (int rep_ = 0; rep_ < (PROBE == 3 ? 2 : 1); ++rep_) {
#define SGR_OUT(lo, hi) for (int rd = (lo); rd < (hi); ++rd) { const int mi = SG_MI, ni = SG_XCD * 4 + SG_NS; sgemm_tile<2>(lds, SP, MIX + (size_t)(MP + 64 * mi) * DM, Wo + (size_t)(64 * ni) * DM, Wo + (size_t)(64 * ni + 32) * DM, DM, mi, ni, lane, wave); }
        const int nf = SG_NS & 1;
        SGR_OUT(0, nf);
        __syncthreads();
        pg8::Gemm g{MIX, Wo, MP, DM, DM}; pg8::StaticOrder S; S.init(MP, DM, G, bx, 4);
        pg8::EpiOut E{xp, xs, out, XB, ssq};
        pg8::gemm_phase<pg8::EpiOut, pg8::StaticOrder, true, true>(lds, g, S, E);
        SGR_OUT(nf, 1);
#undef SGR_OUT
    }
    xcd_barrier(bar);

    {
        for (int row = bx * (NWAVES * 64) + tid; row < M; row += G * NWAVES * 64) {
            float s = 0.f;
            if (row < MP) { const f32x4* p = (const f32x4*)(ssq + (size_t)row * 32);
#pragma unroll
                for (int i = 0; i < 8; ++i) { const f32x4 v = p[i]; s += (v.x + v.y) + (v.z + v.w); } }
            else { const f32x4* p = (const f32x4*)(ssqs + (size_t)(row - MP) * 64);
#pragma unroll
                for (int i = 0; i < 16; ++i) { const f32x4 v = p[i]; s += (v.x + v.y) + (v.z + v.w); } }
            r2[row] = 1.0f / (s * (1.0f / DM) + EPS);
        }
#define SGR_UP(lo, hi) for (int rd = (lo); rd < (hi); ++rd) { const int mi = SG_MI, ni = (rd * 8 + SG_XCD) * 4 + SG_NS; sgemm_tile<3>(lds, SP, XB + (size_t)(MP + 64 * mi) * DM, Wu + (size_t)(64 * ni) * DM, Wu + (size_t)(64 * ni + 32) * DM, DM, mi, ni, lane, wave); }
        const int nf = SG_NS;
        SGR_UP(0, nf);
        __syncthreads();
        pg8::Gemm g{XB, Wu, MP, FF, DM}; pg8::StaticOrder S; S.init(MP, FF, G, bx);
        pg8::EpiUp E{H};
        pg8::gemm_phase<pg8::EpiUp, pg8::StaticOrder, true, true>(lds, g, S, E);
        SGR_UP(nf, 4);
#undef SGR_UP
    }
    xcd_barrier(bar);

    {
#define SGR_DN(lo, hi) for (int rd = (lo); rd < (hi); ++rd) { const int mi = SG_MI, ni = SG_XCD * 4 + SG_NS; sgemm_tile<4>(lds, SP, H + (size_t)(MP + 64 * mi) * FF, Wd + (size_t)(64 * ni) * FF, Wd + (size_t)(64 * ni + 32) * FF, FF, mi, ni, lane, wave); }
        const int nf = SG_NS & 1;
        SGR_DN(0, nf);
        __syncthreads();
        pg8::Gemm g{H, Wd, MP, DM, FF}; pg8::StaticOrder S; S.init(MP, DM, G, bx, 4);
        pg8::EpiDown E{out, r2, XB};
        pg8::gemm_phase<pg8::EpiDown, pg8::StaticOrder, true, true>(lds, g, S, E);
        SGR_DN(nf, 1);
#undef SGR_DN
    }
}

extern "C" void kernel_launch(void* const* d_in, const int* in_sizes, int n_in, void* d_out, int out_size, void* d_ws, size_t ws_size, hipStream_t stream) {
    static int grid = 0;
    if (grid == 0) {
        if (n_in != 18 || (size_t)out_size != O_END || ws_size < WS_END) { fprintf(stderr, "kernel_launch: unexpected shapes (n_in %d, out %d, ws %zu); nothing launched\n", n_in, out_size, ws_size); grid = -1; return; }
        int dev = 0, cus = 0, per_cu = 0;
        if (hipGetDevice(&dev) != hipSuccess || hipDeviceGetAttribute(&cus, hipDeviceAttributeMultiprocessorCount, dev) != hipSuccess) { grid = -1; return; }
        if (hipFuncSetAttribute((const void*)fwd_kernel, hipFuncAttributeMaxDynamicSharedMemorySize, LDS_BYTES) != hipSuccess) { fprintf(stderr, "kernel_launch: hipFuncSetAttribute failed\n"); grid = -1; return; }
        if (hipOccupancyMaxActiveBlocksPerMultiprocessor(&per_cu, (const void*)fwd_kernel, NWAVES * 64, LDS_BYTES) != hipSuccess || per_cu < 1) { fprintf(stderr, "kernel_launch: occupancy query reports %d\n", per_cu); }
        (void)hipGetLastError();
        if (cus < 256) { fprintf(stderr, "kernel_launch: built for a 256-CU device (got %d CUs); nothing launched\n", cus); grid = -1; return; }
        grid = 256;
    }
    if (grid < 0) return;
    if (hipMemsetAsync((char*)d_ws + WS_CTL, 0, CTL_ZERO_BYTES, stream) != hipSuccess) return;
    Args a{};
    for (int i = 0; i < 18; ++i) a.in[i] = (const float*)d_in[i];
    a.out = (float*)d_out; a.ws = (unsigned char*)d_ws;
    hipLaunchKernelGGL(fwd_kernel, dim3(grid), dim3(NWAVES * 64), LDS_BYTES, stream, a);
}
```

```cpp
#include <hip/hip_runtime.h>
#include <cstdio>
#include <cstdint>
#ifndef RES_BF16
#define RES_BF16 1
#endif
#ifndef PROBE
#define PROBE 0
#endif
namespace pg8 {
#define PG8_LAS __attribute__((address_space(3)))
typedef unsigned short bf16_t;
typedef short bf16x8 __attribute__((ext_vector_type(8)));
typedef float f32x4 __attribute__((ext_vector_type(4)));
typedef unsigned u32x4 __attribute__((ext_vector_type(4)));
constexpr int BM = 256, BK = 64, HALF = 128, HTB = HALF * BK * 2  , STAGE_BYTES = 8 * HTB, NXCD = 8, WGM = 8;

__host__ __device__ __forceinline__ int lds_byte(int r, int c) { const int st = (r >> 4) * 2 + (c >> 5), rr = r & 15, cc = c & 31, ob = rr * 64 + cc * 2; return st * 1024 + (ob ^ (((ob >> 9) & 1) << 5)); }
__host__ __device__ __forceinline__ void stage_rc(int b, int& R, int& C) { const int st = b / 1024, sb = b % 1024, swz = sb ^ (((sb >> 9) & 1) << 5); R = (st >> 1) * 16 + swz / 64; C = (st & 1) * 32 + (swz % 64) / 2; }
__host__ __device__ __forceinline__ int perm32(int rho) { const int n = rho >> 4, i = rho & 15; return 8 * (i >> 2) + 4 * n + (i & 3); }

struct Unit { int pm, pn; };
struct Gemm { const bf16_t* A; const bf16_t* Bt; int M, N, K; };

struct StaticOrder {
    int nM, nN, nwg, G, c, wgm;
    __host__ __device__ void init(int M, int N, int G_, int c_, int wgm_ = WGM) { nM = M / BM; nN = N / BM; nwg = nM * nN; G = G_; c = c_; wgm = wgm_; }
    __host__ __device__ bool next(int i, Unit& u) const {
        const long L = (long)i * G + c; if (L >= nwg) return false;
        int wgid = (int)L; { const int q = nwg / NXCD, r = nwg % NXCD, xcd = wgid % NXCD, off = wgid / NXCD; wgid = (xcd < r ? xcd * (q + 1) : r * (q + 1) + (xcd - r) * q) + off; }
        const int nig = wgm * nN, gid = wgid / nig, fm = gid * wgm, gsz = (nM - fm) < wgm ? (nM - fm) : wgm;
        u.pm = fm + ((wgid % nig) % gsz); u.pn = (wgid % nig) / gsz; return true;
    }
    __device__ __forceinline__ void a_ready(const Unit&) const {}
    __device__ __forceinline__ void done(const Unit&) const {}
};

__device__ __forceinline__ unsigned cvt_pk_bf16(float lo, float hi) { unsigned r; asm volatile("v_cvt_pk_bf16_f32 %0, %1, %2" : "=v"(r) : "v"(lo), "v"(hi)); return r; }
typedef float f32x2 __attribute__((ext_vector_type(2)));
struct EpiIn {
    static constexpr bool PERM = true, AFTER_DRAIN = false;
    bf16_t* Z; bf16_t* U; const float* rstd;
    __device__ __forceinline__ void operator()(const f32x4 (&acc)[2][2][4][2], const Unit& u, int wr, int wc, int fr, int fq) const {
        const int row0 = u.pm * BM + wr * 64 + fr;
        if (u.pn < 6) {
            const int col0 = u.pn * BM + wc * 32 + 8 * fq;
#pragma unroll
            for (int ai = 0; ai < 2; ++ai)
#pragma unroll
                for (int m = 0; m < 4; ++m) { const int row = row0 + ai * HALF + m * 16; const float rs = rstd[row]; bf16_t* rowp = Z + (size_t)row * 1536 + col0;
#pragma unroll
                    for (int bj = 0; bj < 2; ++bj) { const f32x4 v0 = acc[ai][bj][m][0] * rs, v1 = acc[ai][bj][m][1] * rs;
                        u32x4 w; w.x = cvt_pk_bf16(v0[0], v0[1]); w.y = cvt_pk_bf16(v0[2], v0[3]); w.z = cvt_pk_bf16(v1[0], v1[1]); w.w = cvt_pk_bf16(v1[2], v1[3]);
                        *(u32x4*)(rowp + bj * HALF) = w; } }
        } else {
            const int c0 = (u.pn - 6) * HALF + wc * 32 + 8 * fq;
#pragma unroll
            for (int ai = 0; ai < 2; ++ai)
#pragma unroll
                for (int m = 0; m < 4; ++m) { const int row = row0 + ai * HALF + m * 16; const float rs = rstd[row];
                    float o[8];
#pragma unroll
                    for (int n = 0; n < 2; ++n)
#pragma unroll
                        for (int e = 0; e < 4; ++e) { const float a = acc[ai][0][m][n][e] * rs, g = acc[ai][1][m][n][e] * rs; o[n * 4 + e] = a * __builtin_amdgcn_rcpf(1.0f + __expf(-g)); }
                    u32x4 w; w.x = cvt_pk_bf16(o[0], o[1]); w.y = cvt_pk_bf16(o[2], o[3]); w.z = cvt_pk_bf16(o[4], o[5]); w.w = cvt_pk_bf16(o[6], o[7]);
                    *(u32x4*)(U + (size_t)row * 1024 + c0) = w; }
        }
    }
};
struct EpiOut {
#if RES_BF16
    static constexpr bool PERM = true, AFTER_DRAIN = false;
    const float* xp; const float* xs; float* out; bf16_t* XB; float* ssq;
    __device__ __forceinline__ void operator()(const f32x4 (&acc)[2][2][4][2], const Unit& u, int wr, int wc, int fr, int fq) const {
        const int row0 = u.pm * BM + wr * 64 + fr, col0 = u.pn * BM + wc * 32 + 8 * fq;
#pragma unroll
        for (int ai = 0; ai < 2; ++ai) {
            u32x4 xr[4][2];
#pragma unroll
            for (int m = 0; m < 4; ++m) { const size_t ro = (size_t)(row0 + ai * HALF + m * 16) * 2048 + col0;
#pragma unroll
                for (int bj = 0; bj < 2; ++bj) xr[m][bj] = *(const u32x4*)(XB + ro + bj * HALF); }
            __builtin_amdgcn_sched_barrier(0);
#pragma unroll
            for (int m = 0; m < 4; ++m) { const int row = row0 + ai * HALF + m * 16; const size_t ro = (size_t)row * 2048 + col0; float q = 0.f;
#pragma unroll
                for (int bj = 0; bj < 2; ++bj) { const u32x4 xw = xr[m][bj];
                    const f32x4 x0 = (f32x4){__builtin_bit_cast(float, xw.x << 16), __builtin_bit_cast(float, xw.x & 0xffff0000u), __builtin_bit_cast(float, xw.y << 16), __builtin_bit_cast(float, xw.y & 0xffff0000u)};
                    const f32x4 x1 = (f32x4){__builtin_bit_cast(float, xw.z << 16), __builtin_bit_cast(float, xw.z & 0xffff0000u), __builtin_bit_cast(float, xw.w << 16), __builtin_bit_cast(float, xw.w & 0xffff0000u)};
                    const f32x4 v0 = acc[ai][bj][m][0] + x0, v1 = acc[ai][bj][m][1] + x1;
                    u32x4 w; w.x = cvt_pk_bf16(v0[0], v0[1]); w.y = cvt_pk_bf16(v0[2], v0[3]); w.z = cvt_pk_bf16(v1[0], v1[1]); w.w = cvt_pk_bf16(v1[2], v1[3]);
                    *(u32x4*)(XB + ro + bj * HALF) = w;
                    q += (v0[0] * v0[0] + v0[1] * v0[1]) + (v0[2] * v0[2] + v0[3] * v0[3]) + (v1[0] * v1[0] + v1[1] * v1[1]) + (v1[2] * v1[2] + v1[3] * v1[3]); }
                q += __shfl_xor(q, 16); q += __shfl_xor(q, 32);
                if (fq == 0) ssq[(size_t)row * 32 + u.pn * 4 + wc] = q; }
            __builtin_amdgcn_sched_barrier(0);
        }
    }
#else
    static constexpr bool PERM = false, AFTER_DRAIN = false;
    const float* xp; const float* xs; float* out; bf16_t* XB; float* ssq;
    __device__ __forceinline__ void operator()(const f32x4 (&acc)[2][2][4][2], const Unit& u, int wr, int wc, int fr, int fq) const {
        typedef unsigned u32x2 __attribute__((ext_vector_type(2)));
        const int row0 = u.pm * BM + wr * 64 + fr, col0 = u.pn * BM + wc * 32 + 4 * fq;
        const float* xb = (u.pm < 128) ? xp : (xs - (size_t)32768 * 2048);
#pragma unroll
        for (int ai = 0; ai < 2; ++ai) {
            f32x4 xr[4][2][2];
#pragma unroll
            for (int m = 0; m < 4; ++m) { const size_t ro = (size_t)(row0 + ai * HALF + m * 16) * 2048 + col0;
#pragma unroll
                for (int bj = 0; bj < 2; ++bj) { xr[m][bj][0] = *(const f32x4*)(xb + ro + bj * HALF); xr[m][bj][1] = *(const f32x4*)(xb + ro + bj * HALF + 16); } }
            __builtin_amdgcn_sched_barrier(0);
#pragma unroll
            for (int m = 0; m < 4; ++m) { const int row = row0 + ai * HALF + m * 16; const size_t ro = (size_t)row * 2048 + col0; float q = 0.f;
#pragma unroll
                for (int bj = 0; bj < 2; ++bj)
#pragma unroll
                    for (int n = 0; n < 2; ++n) { const f32x4 v = acc[ai][bj][m][n] + xr[m][bj][n];
                        *(f32x4*)(out + ro + bj * HALF + n * 16) = v;
                        u32x2 w; w.x = cvt_pk_bf16(v[0], v[1]); w.y = cvt_pk_bf16(v[2], v[3]);
                        *(u32x2*)(XB + ro + bj * HALF + n * 16) = w;
                        q += (v[0] * v[0] + v[1] * v[1]) + (v[2] * v[2] + v[3] * v[3]); }
                q += __shfl_xor(q, 16); q += __shfl_xor(q, 32);
                if (fq == 0) ssq[(size_t)row * 32 + u.pn * 4 + wc] = q; }
            __builtin_amdgcn_sched_barrier(0);
        }
    }
#endif
};
struct EpiUp {
    static constexpr bool PERM = true, AFTER_DRAIN = false;
    bf16_t* H;
    __device__ __forceinline__ void operator()(const f32x4 (&acc)[2][2][4][2], const Unit& u, int wr, int wc, int fr, int fq) const {
        const int row0 = u.pm * BM + wr * 64 + fr, col0 = u.pn * BM + wc * 32 + 8 * fq;
#pragma unroll
        for (int ai = 0; ai < 2; ++ai)
#pragma unroll
            for (int m = 0; m < 4; ++m) { bf16_t* rowp = H + (size_t)(row0 + ai * HALF + m * 16) * 8192 + col0;
#pragma unroll
                for (int bj = 0; bj < 2; ++bj) { f32x4 v0 = acc[ai][bj][m][0], v1 = acc[ai][bj][m][1];
#pragma unroll
                    for (int e = 0; e < 4; ++e) { const float a = fmaxf(v0[e], 0.f), b = fmaxf(v1[e], 0.f); v0[e] = a * a; v1[e] = b * b; }
                    u32x4 w; w.x = cvt_pk_bf16(v0[0], v0[1]); w.y = cvt_pk_bf16(v0[2], v0[3]); w.z = cvt_pk_bf16(v1[0], v1[1]); w.w = cvt_pk_bf16(v1[2], v1[3]);
                    *(u32x4*)(rowp + bj * HALF) = w; } }
    }
};
struct EpiDown {
    static constexpr bool PERM = false, AFTER_DRAIN = false;
    float* out; const float* r2; const bf16_t* XB;
    __device__ __forceinline__ void operator()(const f32x4 (&acc)[2][2][4][2], const Unit& u, int wr, int wc, int fr, int fq) const {
        typedef unsigned u32x2 __attribute__((ext_vector_type(2)));
        const int row0 = u.pm * BM + wr * 64 + fr, col0 = u.pn * BM + wc * 32 + 4 * fq;
#pragma unroll
        for (int ai = 0; ai < 2; ++ai) {
#if RES_BF16
            u32x2 xr[4][2][2]; float sc[4];
#pragma unroll
            for (int m = 0; m < 4; ++m) { const int row = row0 + ai * HALF + m * 16; const bf16_t* rowp = XB + (size_t)row * 2048 + col0; sc[m] = r2[row];
#pragma unroll
                for (int bj = 0; bj < 2; ++bj) { xr[m][bj][0] = *(const u32x2*)(rowp + bj * HALF); xr[m][bj][1] = *(const u32x2*)(rowp + bj * HALF + 16); } }
            __builtin_amdgcn_sched_barrier(0);
#pragma unroll
            for (int m = 0; m < 4; ++m) { float* rowp = out + (size_t)(row0 + ai * HALF + m * 16) * 2048 + col0;
#pragma unroll
                for (int bj = 0; bj < 2; ++bj)
#pragma unroll
                    for (int n = 0; n < 2; ++n) { const u32x2 w = xr[m][bj][n];
                        const f32x4 x = (f32x4){__builtin_bit_cast(float, w.x << 16), __builtin_bit_cast(float, w.x & 0xffff0000u), __builtin_bit_cast(float, w.y << 16), __builtin_bit_cast(float, w.y & 0xffff0000u)};
                        *(f32x4*)(rowp + bj * HALF + n * 16) = x + acc[ai][bj][m][n] * sc[m]; } }
            __builtin_amdgcn_sched_barrier(0);
#else
            f32x4 xr[4][2][2]; float sc[4];
#pragma unroll
            for (int m = 0; m < 4; ++m) { const int row = row0 + ai * HALF + m * 16; const float* rowp = out + (size_t)row * 2048 + col0; sc[m] = r2[row];
#pragma unroll
                for (int bj = 0; bj < 2; ++bj) { xr[m][bj][0] = *(const f32x4*)(rowp + bj * HALF); xr[m][bj][1] = *(const f32x4*)(rowp + bj * HALF + 16); } }
            __builtin_amdgcn_sched_barrier(0);
#pragma unroll
            for (int m = 0; m < 4; ++m) { float* rowp = out + (size_t)(row0 + ai * HALF + m * 16) * 2048 + col0;
#pragma unroll
                for (int bj = 0; bj < 2; ++bj) { *(f32x4*)(rowp + bj * HALF) = xr[m][bj][0] + acc[ai][bj][m][0] * sc[m]; *(f32x4*)(rowp + bj * HALF + 16) = xr[m][bj][1] + acc[ai][bj][m][1] * sc[m]; } }
            __builtin_amdgcn_sched_barrier(0);
#endif
        }
    }
};

template <class Epi, class Sched, bool ALIGN_EPI = false, bool SP2 = false>
__device__ __forceinline__ void gemm_phase(PG8_LAS unsigned char* lds, const Gemm g, const Sched& S, const Epi& E) {
    int tid_ = threadIdx.x; asm volatile("" : "+v"(tid_));
    const int tid = tid_, wid = __builtin_amdgcn_readfirstlane(tid >> 6), lane = tid & 63, wr = wid >> 2, wc = wid & 3, fr = lane & 15, fq = lane >> 4;
    const int K = g.K, nt = K / BK;
    unsigned voffA[2], voffB[2];
#pragma unroll
    for (int i = 0; i < 2; ++i) { int R, C; stage_rc(tid * 16 + i * 8192, R, C); const int Rb = Epi::PERM ? ((R & ~31) + perm32(R & 31)) : R;
        voffA[i] = (unsigned)(R * K + C) * 2u; voffB[i] = (unsigned)(Rb * K + C) * 2u; }
    const size_t kstep = (size_t)(BK * 2);
    const size_t hstep = (size_t)HALF * K * 2;
    const size_t tstep = 2 * hstep;
    const unsigned ldsw = (unsigned)wid * 1024u;
    const int aoff = lds_byte(wr * 64 + fr, fq * 8), boff = lds_byte(wc * 32 + fr, fq * 8);
#define PG8_SA(b, h) (((b) * 2 + (h)) * HTB)
#define PG8_SB(b, h) ((4 + (b) * 2 + (h)) * HTB)
#define PG8_STAGE(bufoff, gbase, voff) do { _Pragma("unroll") for (int _i = 0; _i < 2; ++_i) \
        __builtin_amdgcn_global_load_lds((const unsigned*)((const char*)(gbase) + (voff)[_i]), (PG8_LAS unsigned*)(lds + (bufoff) + ldsw + _i * 8192), 16, 0, 0); } while (0)
#define PG8_LDA(dst, b, h) do { _Pragma("unroll") for (int m = 0; m < 4; ++m) _Pragma("unroll") for (int k = 0; k < 2; ++k) dst[m][k] = *(const PG8_LAS bf16x8*)(lds + PG8_SA(b, h) + aoff + m * 2048 + k * 1024); } while (0)
#define PG8_LDB(dst, b, h) do { _Pragma("unroll") for (int n = 0; n < 2; ++n) _Pragma("unroll") for (int k = 0; k < 2; ++k) dst[n][k] = *(const PG8_LAS bf16x8*)(lds + PG8_SB(b, h) + boff + n * 2048 + k * 1024); } while (0)
#define PG8_MMA(ai, bj, At, Bt) do { __builtin_amdgcn_s_setprio(1); _Pragma("unroll") for (int m = 0; m < 4; ++m) _Pragma("unroll") for (int n = 0; n < 2; ++n) _Pragma("unroll") for (int k = 0; k < 2; ++k) \
        acc[ai][bj][m][n] = __builtin_amdgcn_mfma_f32_16x16x32_bf16(Bt[n][k], At[m][k], acc[ai][bj][m][n], 0, 0, 0); __builtin_amdgcn_s_setprio(0); } while (0)
#define PG8_WAIT_V(n) asm volatile("s_waitcnt vmcnt(" #n ")" ::: "memory")
#define PG8_WAIT_L(n) asm volatile("s_waitcnt lgkmcnt(" #n ")" ::: "memory")
#define PG8_BAR __builtin_amdgcn_s_barrier()
#define PG8_SCHED __builtin_amdgcn_sched_barrier(0)
    Unit cur, nxt; int ui = 0;
    if (!S.next(0, cur)) return;
    f32x4 acc[2][2][4][2];
#pragma unroll
    for (int a = 0; a < 2; ++a)
#pragma unroll
        for (int b = 0; b < 2; ++b)
#pragma unroll
            for (int m = 0; m < 4; ++m)
#pragma unroll
                for (int n = 0; n < 2; ++n) acc[a][b][m][n] = (f32x4){0.f, 0.f, 0.f, 0.f};
    bf16x8 At[4][2], B0[2][2], B1[2][2];
    const char* cA = (const char*)g.A + (size_t)cur.pm * tstep; const char* cB = (const char*)g.Bt + (size_t)cur.pn * tstep;
    S.a_ready(cur);
    if constexpr (SP2) {
        PG8_STAGE(PG8_SB(0, 0), cB, voffB); PG8_STAGE(PG8_SB(0, 1), cB + hstep, voffB); PG8_STAGE(PG8_SA(0, 0), cA, voffA); PG8_STAGE(PG8_SA(0, 1), cA + hstep, voffA);
        if (wr == 1) PG8_BAR;
        PG8_WAIT_V(2); PG8_BAR;
        PG8_STAGE(PG8_SB(1, 0), cB + kstep, voffB); PG8_STAGE(PG8_SA(1, 0), cA + kstep, voffA); PG8_STAGE(PG8_SB(1, 1), cB + hstep + kstep, voffB);
        PG8_WAIT_V(6); PG8_BAR;
    } else {
        PG8_STAGE(PG8_SB(0, 0), cB, voffB); PG8_STAGE(PG8_SA(0, 0), cA, voffA); PG8_STAGE(PG8_SB(0, 1), cB + hstep, voffB); PG8_STAGE(PG8_SA(0, 1), cA + hstep, voffA);
        if (wr == 1) PG8_BAR;
        PG8_WAIT_V(4); PG8_BAR;
        PG8_STAGE(PG8_SB(1, 0), cB + kstep, voffB); PG8_STAGE(PG8_SA(1, 0), cA + kstep, voffA); PG8_STAGE(PG8_SB(1, 1), cB + hstep + kstep, voffB);
        PG8_WAIT_V(6); PG8_BAR;
    }
    for (;;) {
        const bool has_next = S.next(ui + 1, nxt);
        const char* nA = has_next ? (const char*)g.A + (size_t)nxt.pm * tstep : cA; const char* nB = has_next ? (const char*)g.Bt + (size_t)nxt.pn * tstep : cB;
        for (int t = 0; t < nt; t += 2) {
            const bool last = (t == nt - 2);
            const char* a1 = cA + (size_t)(t + 1) * kstep;
            const char* a2 = last ? nA : cA + (size_t)(t + 2) * kstep; const char* b2 = last ? nB : cB + (size_t)(t + 2) * kstep;
            const char* a3 = a2 + kstep; const char* b3 = b2 + kstep;
            if (last && has_next) S.a_ready(nxt);
            if constexpr (SP2) {
            PG8_LDB(B0, 0, 0); PG8_LDB(B1, 0, 1); PG8_SCHED; PG8_LDA(At, 0, 0); PG8_STAGE(PG8_SA(1, 1), a1 + hstep, voffA);
            PG8_WAIT_V(8); PG8_WAIT_L(0); PG8_BAR; PG8_MMA(0, 0, At, B0); PG8_MMA(0, 1, At, B1); PG8_BAR; PG8_SCHED;
            PG8_LDA(At, 0, 1); PG8_STAGE(PG8_SB(0, 0), b2, voffB); PG8_STAGE(PG8_SB(0, 1), b2 + hstep, voffB); PG8_STAGE(PG8_SA(0, 0), a2, voffA);
            PG8_WAIT_V(8); PG8_WAIT_L(0); PG8_BAR; PG8_MMA(1, 0, At, B0); PG8_MMA(1, 1, At, B1); PG8_BAR; PG8_SCHED;
            PG8_LDB(B0, 1, 0); PG8_LDB(B1, 1, 1); PG8_SCHED; PG8_LDA(At, 1, 0); PG8_STAGE(PG8_SA(0, 1), a2 + hstep, voffA);
            PG8_WAIT_V(8); PG8_WAIT_L(0); PG8_BAR; PG8_MMA(0, 0, At, B0); PG8_MMA(0, 1, At, B1); PG8_BAR; PG8_SCHED;
            PG8_LDA(At, 1, 1); PG8_STAGE(PG8_SB(1, 0), b3, voffB); PG8_STAGE(PG8_SB(1, 1), b3 + hstep, voffB); PG8_STAGE(PG8_SA(1, 0), a3, voffA);
            PG8_WAIT_V(8); PG8_WAIT_L(0); PG8_BAR; PG8_MMA(1, 0, At, B0); PG8_MMA(1, 1, At, B1); PG8_BAR; PG8_SCHED;
            } else {
            PG8_LDB(B0, 0, 0); PG8_SCHED; PG8_LDA(At, 0, 0); PG8_STAGE(PG8_SA(1, 1), a1 + hstep, voffA);
            PG8_WAIT_L(8); PG8_BAR; PG8_WAIT_L(0); PG8_MMA(0, 0, At, B0); PG8_BAR; PG8_SCHED;
            PG8_LDB(B1, 0, 1); PG8_STAGE(PG8_SB(0, 0), b2, voffB);
            PG8_BAR; PG8_WAIT_L(0); PG8_MMA(0, 1, At, B1); PG8_BAR;
            PG8_LDA(At, 0, 1); PG8_STAGE(PG8_SA(0, 0), a2, voffA);
            PG8_BAR; PG8_WAIT_L(0); PG8_MMA(1, 0, At, B0); PG8_BAR; PG8_SCHED;
            PG8_STAGE(PG8_SB(0, 1), b2 + hstep, voffB);
            PG8_WAIT_V(6); PG8_BAR; PG8_MMA(1, 1, At, B1); PG8_BAR;
            PG8_LDB(B0, 1, 0); PG8_SCHED; PG8_LDA(At, 1, 0); PG8_STAGE(PG8_SA(0, 1), a2 + hstep, voffA);
            PG8_WAIT_L(8); PG8_BAR; PG8_WAIT_L(0); PG8_MMA(0, 0, At, B0); PG8_BAR; PG8_SCHED;
            PG8_LDB(B1, 1, 1); PG8_STAGE(PG8_SB(1, 0), b3, voffB);
            PG8_BAR; PG8_WAIT_L(0); PG8_MMA(0, 1, At, B1); PG8_BAR;
            PG8_LDA(At, 1, 1); PG8_STAGE(PG8_SA(1, 0), a3, voffA);
            PG8_BAR; PG8_WAIT_L(0); PG8_MMA(1, 0, At, B0); PG8_BAR; PG8_SCHED;
            PG8_STAGE(PG8_SB(1, 1), b3 + hstep, voffB);
            PG8_WAIT_V(6); PG8_BAR; PG8_MMA(1, 1, At, B1); PG8_BAR;
            }
        }
        if constexpr (ALIGN_EPI) { if (wr == 0) PG8_BAR; }
        if constexpr (!Epi::AFTER_DRAIN) { E(acc, cur, wr, wc, fr, fq); S.done(cur); }
        if (!has_next) break;
#pragma unroll
        for (int a = 0; a < 2; ++a)
#pragma unroll
            for (int b = 0; b < 2; ++b)
#pragma unroll
                for (int m = 0; m < 4; ++m)
#pragma unroll
                    for (int n = 0; n < 2; ++n) acc[a][b][m][n] = (f32x4){0.f, 0.f, 0.f, 0.f};
        cur = nxt; cA = nA; cB = nB; ++ui;
        if constexpr (ALIGN_EPI) { if (wr == 1) PG8_BAR; }
    }
    PG8_WAIT_V(0);
    if constexpr (!ALIGN_EPI) { if (wr == 0) PG8_BAR; }
    PG8_BAR;
    if constexpr (Epi::AFTER_DRAIN) { E.fused(acc, cur, wr, wc, fr, fq, lds, wid, lane); S.done(cur); }
#undef PG8_SA
#undef PG8_SB
#undef PG8_STAGE
#undef PG8_LDA
#undef PG8_LDB
#undef PG8_MMA
#undef PG8_WAIT_V
#undef PG8_WAIT_L
#undef PG8_BAR
#undef PG8_SCHED
}
}

constexpr int NWAVES = 8;
constexpr int DM = 2048, NB = 16, SEQ = 2048, DB = 128, DS = 4, HD = 64, NH = 16, NKV = 4, CCH = 1024, CW = 31, FF = 8192;
constexpr int MP = NB * SEQ, MS = DB * DS, M = MP + MS;
constexpr int INW = 3584, ZW = 1536;
constexpr float EPS = 1e-6f;
constexpr float QSCALE = 0.125f * 1.4426950408889634f;
constexpr float LOG2E = 1.4426950408889634f;
constexpr size_t O_Y = 0, O_KP = (size_t)M * DM, O_VP = O_KP + (size_t)NB * 128 * 256, O_CP = O_VP + (size_t)NB * 128 * 256,
                 O_KS = O_CP + (size_t)NB * 30 * CCH, O_VS = O_KS + (size_t)DB * 128 * 256, O_CS = O_VS + (size_t)DB * 128 * 256, O_END = O_CS + (size_t)DB * 30 * CCH;
constexpr size_t MiB = 1u << 20;
constexpr size_t WS_CTL = 0, CTL_ZERO_BYTES = 64 * 1024, WS_ZROW = 48 * 1024;
constexpr size_t WS_WIN = 1 * MiB, WS_WOUT = 15 * MiB, WS_WUP = 23 * MiB, WS_WDN = 55 * MiB;
constexpr size_t WS_RSTD1 = 87 * MiB, WS_R2 = 88 * MiB, WS_SSQS = 88 * MiB + 512 * 1024, WS_SSQ = 89 * MiB;
constexpr size_t WS_XB = 94 * MiB;
constexpr size_t WS_Z = 224 * MiB, WS_U = 322 * MiB, WS_MIX = 387 * MiB;
constexpr size_t WS_H = 224 * MiB, WS_END = 744 * MiB;
static_assert(WS_Z + (size_t)M * ZW * 2 <= WS_U && WS_U + (size_t)M * CCH * 2 <= WS_MIX && WS_MIX + (size_t)M * DM * 2 <= WS_END && WS_H + (size_t)M * FF * 2 <= WS_END, "d_ws map");
static_assert(WS_XB + (size_t)M * DM * 2 <= WS_Z && WS_SSQ + (size_t)M * 32 * 4 <= WS_XB && WS_WIN + (size_t)INW * DM * 2 <= WS_WOUT, "d_ws map");
constexpr int CW_BAR = 4096;
constexpr int RING_BYTES = 131072, MISC_OFF = RING_BYTES + 320, LDS_BYTES = 147456;
#define GAS __attribute__((address_space(1)))
#define LAS __attribute__((address_space(3)))
typedef unsigned short bf16;
typedef unsigned v4u __attribute__((ext_vector_type(4)));
typedef float f32x4 __attribute__((ext_vector_type(4)));
typedef short bf16x8 __attribute__((ext_vector_type(8)));
typedef GAS unsigned gu32;
typedef GAS unsigned long long gu64;
#define RLX_AGENT __ATOMIC_RELAXED, __HIP_MEMORY_SCOPE_AGENT
#define LDS_WAIT() asm volatile("s_waitcnt lgkmcnt(0)" ::: "memory")
#define VM_WAIT() asm volatile("s_waitcnt vmcnt(0)" ::: "memory")
__device__ __forceinline__ unsigned long long rt() { return __builtin_amdgcn_s_memrealtime(); }
__device__ __forceinline__ unsigned f2bf(float f) { unsigned u = __builtin_bit_cast(unsigned, f); return (u + 0x7fffu + ((u >> 16) & 1u)) >> 16; }
__device__ __forceinline__ unsigned pk2(float lo, float hi) { return f2bf(lo) | (f2bf(hi) << 16); }

#define XB_TMO      128
#define XB_XCNT(j)  (256  + 64 * (j))
#define XB_XSUB(j)  (1280 + 64 * (j))
#define XB_XGEN(j)  (2304 + 64 * (j))
#define XB_TOP      3328
#define XB_TOPGEN   3392
#define XCD_BAR_WORDS 3456
#define XB_SPIN_CAP (1u << 18)

__device__ __forceinline__ unsigned xb_ld(unsigned* p)              { return __hip_atomic_load(p, __ATOMIC_RELAXED, __HIP_MEMORY_SCOPE_AGENT); }
__device__ __forceinline__ unsigned xb_add(unsigned* p, unsigned v) { return __hip_atomic_fetch_add(p, v, __ATOMIC_RELAXED, __HIP_MEMORY_SCOPE_AGENT); }
__device__ __forceinline__ unsigned xb_xcc_id() { return (unsigned)__builtin_amdgcn_s_getreg((3 << 11) | 20) & 0xFu; }
#define XB_SPIN(cond, bar) do { unsigned _sp = 0; while (cond) { __builtin_amdgcn_s_sleep(1); \
    if ((++_sp & 255u) == 0u) { if (xb_ld(&(bar)[XB_TMO])) break; if (_sp > XB_SPIN_CAP) { atomicAdd(&(bar)[XB_TMO], 1u); break; } } } } while (0)

struct XcdBarrier {
    unsigned* bar; unsigned x;
    volatile LAS unsigned* st;
};

__device__ __forceinline__ XcdBarrier xcd_barrier_post(unsigned* bar, volatile LAS unsigned* st) {
    XcdBarrier b; b.bar = bar; b.x = xb_xcc_id(); b.st = st;
    if (threadIdx.x == 0) (void)xb_add(&bar[XB_XCNT(b.x)], 1u);
    return b;
}
__device__ __forceinline__ void xcd_barrier_complete(unsigned* bar, unsigned x, unsigned& nloc, unsigned& nx) {
    const unsigned G = gridDim.x * gridDim.y * gridDim.z;
    unsigned sum, cnt, mine, sp = 0u;
    for (;;) {
        sum = 0u; cnt = 0u; mine = 0u;
#pragma unroll
        for (unsigned j = 0; j < 16; ++j) { const unsigned c = xb_ld(&bar[XB_XCNT(j)]); sum += c; cnt += (c > 0u) ? 1u : 0u; mine = (j == x) ? c : mine; }
        if (sum == G) break;
        __builtin_amdgcn_s_sleep(1);
        if ((++sp & 255u) == 0u) { if (xb_ld(&bar[XB_TMO])) break; if (sp > XB_SPIN_CAP) { atomicAdd(&bar[XB_TMO], 1u); break; } }
    }
    nloc = mine > 0u ? mine : 1u; nx = cnt > 0u ? cnt : 1u;
}

__device__ __forceinline__ void xcd_barrier(const XcdBarrier& b) {
    asm volatile("s_waitcnt vmcnt(0)" ::: "memory");
    __syncthreads();
    if (threadIdx.x == 0) {
        unsigned* bar = b.bar;
        __builtin_amdgcn_s_waitcnt(0);
        unsigned nloc = b.st[0], nx = b.st[1];
        if (nloc == 0u) { xcd_barrier_complete(bar, b.x, nloc, nx); b.st[0] = nloc; b.st[1] = nx; }
        const unsigned old = xb_add(&bar[XB_XSUB(b.x)], 1u);
        const unsigned gen = old / nloc;
        if (old + 1u == (gen + 1u) * nloc) {
            __builtin_amdgcn_fence(__ATOMIC_RELEASE, "agent");
            asm volatile("s_waitcnt vmcnt(0)" ::: "memory");
            const unsigned og = xb_add(&bar[XB_TOP], 1u);
            const unsigned tg = og / nx;
            if (og + 1u == (tg + 1u) * nx) xb_add(&bar[XB_TOPGEN], 1u);
            else XB_SPIN(xb_ld(&bar[XB_TOPGEN]) == tg, bar);
            __builtin_amdgcn_fence(__ATOMIC_ACQUIRE, "agent");
            xb_add(&bar[XB_XGEN(b.x)], 1u);
            asm volatile("s_waitcnt vmcnt(0)" ::: "memory");
        } else {
            XB_SPIN(xb_ld(&bar[XB_XGEN(b.x)]) == gen, bar);
            __builtin_amdgcn_fence(__ATOMIC_ACQUIRE, "agent");
            asm volatile("s_waitcnt vmcnt(0)" ::: "memory");
        }
    }
    __syncthreads();
}

typedef float f32x2 __attribute__((ext_vector_type(2)));
typedef float f32x16 __attribute__((ext_vector_type(16)));
typedef short s16x4 __attribute__((ext_vector_type(4)));
__device__ __forceinline__ unsigned cvtpk(float lo, float hi) { unsigned r; asm volatile("v_cvt_pk_bf16_f32 %0, %1, %2" : "=v"(r) : "v"(lo), "v"(hi)); return r; }
__device__ __forceinline__ float bf_lo(unsigned u) { return __builtin_bit_cast(float, u << 16); }
__device__ __forceinline__ float bf_hi(unsigned u) { return __builtin_bit_cast(float, u & 0xffff0000u); }
__device__ __forceinline__ void fmac1(float& acc, float a, float b) { asm("v_fmac_f32 %0, %1, %2" : "+v"(acc) : "v"(a), "v"(b)); }
__device__ __forceinline__ float wave_sum(float v) {
#pragma unroll
    for (int o = 1; o < 64; o <<= 1) v += __shfl_xor(v, o);
    return v;
}

struct P0Item { const float* W; const float* gain; bf16* WT; int K, N, rowmap, k0, n0; };
struct P0Mats { const float *w_in, *g_in, *w_out, *w_up, *g_up, *w_dn; bf16 *Wi, *Wo, *Wu, *Wd; };
constexpr int P0_I_IN = (DM / 64) * (INW / 32), P0_I_OUT = (DM / 64) * (DM / 32), P0_I_UP = (DM / 64) * (FF / 32), P0_I_DN = (FF / 64) * (DM / 32), P0_NITEMS = P0_I_IN + P0_I_OUT + P0_I_UP + P0_I_DN;
__device__ __forceinline__ P0Item p0_item(const P0Mats& Mx, int it) {
    P0Item I; int r = it;
    if (r < P0_I_IN) { I.W = Mx.w_in; I.gain = Mx.g_in; I.WT = Mx.Wi; I.K = DM; I.N = INW; I.rowmap = 1; }
    else if ((r -= P0_I_IN) < P0_I_OUT) { I.W = Mx.w_out; I.gain = nullptr; I.WT = Mx.Wo; I.K = DM; I.N = DM; I.rowmap = 0; }
    else if ((r -= P0_I_OUT) < P0_I_UP) { I.W = Mx.w_up; I.gain = Mx.g_up; I.WT = Mx.Wu; I.K = DM; I.N = FF; I.rowmap = 0; }
    else { r -= P0_I_UP; I.W = Mx.w_dn; I.gain = nullptr; I.WT = Mx.Wd; I.K = FF; I.N = DM; I.rowmap = 0; }
    const int nblk = I.N / 32; I.k0 = 64 * (r / nblk); I.n0 = 32 * (r % nblk); return I;
}
__device__ __forceinline__ void p0_item_issue(const P0Item& I, int lane, f32x4 (&v)[8], float (&g)[8]) {
    const int kr = lane >> 3, nc = lane & 7;
#pragma unroll
    for (int j = 0; j < 8; ++j) { v[j] = *(const f32x4*)(I.W + (size_t)(I.k0 + 8 * j + kr) * I.N + I.n0 + 4 * nc); g[j] = I.gain ? I.gain[I.k0 + 8 * j + kr] : 1.0f; }
}
__device__ __forceinline__ void p0_weights(const P0Mats& Mx, LAS float* scr, int gw, int NGW, int lane) {
    f32x4 v[8]; float g[8];
    int it = gw;
    P0Item I = p0_item(Mx, it < P0_NITEMS ? it : 0);
    if (it < P0_NITEMS) p0_item_issue(I, lane, v, g);
#pragma unroll 1
    for (; it < P0_NITEMS; it += NGW) {
        {   const int kr = lane >> 3, nc = lane & 7;
#pragma unroll
            for (int j = 0; j < 8; ++j) { LAS float* d = scr + (8 * j + kr) * 33 + 4 * nc; d[0] = v[j].x * g[j]; d[1] = v[j].y * g[j]; d[2] = v[j].z * g[j]; d[3] = v[j].w * g[j]; } }
        const P0Item C = I;
        if (it + NGW < P0_NITEMS) { I = p0_item(Mx, it + NGW); p0_item_issue(I, lane, v, g); }
        __builtin_amdgcn_sched_barrier(0);
        LDS_WAIT(); asm volatile("" ::: "memory");
        int nd0 = C.n0;
        if (C.rowmap == 1 && C.n0 >= ZW) { int c = C.n0 - ZW; if (c < CCH) nd0 = ZW + 256 * (c >> 7) + (c & 127); else { c -= CCH; nd0 = ZW + 256 * (c >> 7) + 128 + (c & 127); } }
        const int c = lane & 7;
#pragma unroll
        for (int j = 0; j < 4; ++j) { const int n = (lane >> 3) + 8 * j; const LAS float* s = scr + (8 * c) * 33 + n;
            v4u o; o.x = pk2(s[0 * 33], s[1 * 33]); o.y = pk2(s[2 * 33], s[3 * 33]); o.z = pk2(s[4 * 33], s[5 * 33]); o.w = pk2(s[6 * 33], s[7 * 33]);
            *(GAS v4u*)(C.WT + (size_t)(nd0 + n) * C.K + C.k0 + 8 * c) = o; }
        LDS_WAIT(); asm volatile("" ::: "memory");
    }
}
__device__ __forceinline__ void p0_xrows(const float* xp, const float* xs, bf16* XB, float* rstd1, int gw, int NGW, int lane) {
    f32x4 v[8];
    int m = gw;
    if (m < M) { const GAS f32x4* xr = (const GAS f32x4*)((m < MP) ? xp + (size_t)m * DM : xs + (size_t)(m - MP) * DM) + lane;
#pragma unroll
        for (int j = 0; j < 8; ++j) v[j] = xr[64 * j]; }
#pragma unroll 1
    for (; m < M; m += NGW) {
        float s = 0.f; unsigned long long pk[8];
#pragma unroll
        for (int j = 0; j < 8; ++j) { s += (v[j].x * v[j].x + v[j].y * v[j].y) + (v[j].z * v[j].z + v[j].w * v[j].w); pk[j] = (unsigned long long)cvtpk(v[j].x, v[j].y) | ((unsigned long long)cvtpk(v[j].z, v[j].w) << 32); }
        const int mn = m + NGW;
        if (mn < M) { const GAS f32x4* xr = (const GAS f32x4*)((mn < MP) ? xp + (size_t)mn * DM : xs + (size_t)(mn - MP) * DM) + lane;
#pragma unroll
            for (int j = 0; j < 8; ++j) v[j] = xr[64 * j]; }
        __builtin_amdgcn_sched_barrier(0);
        s = wave_sum(s);
        if (lane == 0) rstd1[m] = 1.0f / sqrtf(s * (1.0f / DM) + EPS);
        GAS unsigned long long* o8 = (GAS unsigned long long*)(XB + (size_t)m * DM) + lane;
#pragma unroll
        for (int j = 0; j < 8; ++j) o8[64 * j] = pk[j];
    }
}

constexpr int KV_RS = 144;
__device__ __forceinline__ int crow(int r, int hi) { return (r & 3) + 8 * (r >> 2) + 4 * hi; }
__device__ __forceinline__ s16x4 vtr(const LAS unsigned char* p) { return __builtin_bit_cast(s16x4, __builtin_amdgcn_ds_read_tr16_b64_v4i16((LAS s16x4*)p)); }

__device__ __forceinline__ void q_issue(const bf16* qrow, int h, v4u (&raw)[4]) {
#pragma unroll
    for (int d0 = 0; d0 < 4; ++d0) raw[d0] = *(const v4u*)(qrow + 16 * d0 + 8 * h);
}
__device__ __forceinline__ void q_finish(const v4u (&raw)[4], int h, const LAS float* gq, bf16x8 (&qf)[4]) {
    float v[4][8]; float ss = 0.f;
#pragma unroll
    for (int d0 = 0; d0 < 4; ++d0)
#pragma unroll
        for (int e = 0; e < 4; ++e) { v[d0][2 * e] = bf_lo(raw[d0][e]); v[d0][2 * e + 1] = bf_hi(raw[d0][e]); ss += v[d0][2 * e] * v[d0][2 * e] + v[d0][2 * e + 1] * v[d0][2 * e + 1]; }
    ss += __shfl_xor(ss, 32);
    const float rs = __builtin_amdgcn_rsqf(ss * (1.0f / HD) + EPS) * QSCALE;
#pragma unroll
    for (int d0 = 0; d0 < 4; ++d0) { const f32x4 g0 = *(const LAS f32x4*)(gq + 16 * d0 + 8 * h), g1 = *(const LAS f32x4*)(gq + 16 * d0 + 8 * h + 4);
        v4u w; w.x = cvtpk(v[d0][0] * rs * g0[0], v[d0][1] * rs * g0[1]); w.y = cvtpk(v[d0][2] * rs * g0[2], v[d0][3] * rs * g0[3]);
        w.z = cvtpk(v[d0][4] * rs * g1[0], v[d0][5] * rs * g1[1]); w.w = cvtpk(v[d0][6] * rs * g1[2], v[d0][7] * rs * g1[3]);
        qf[d0] = __builtin_bit_cast(bf16x8, w); }
}
__device__ __forceinline__ void attn_core(const LAS unsigned char* Kt, const LAS unsigned char* Vt, int tt0, int qrel, int kvmin, const bf16x8 (&qf)[4], float sink2, float cshift, int lane, f32x16 (&o)[2]) {
    const int r32 = lane & 31, h = lane >> 5;
    f32x16 s[5];
#pragma unroll
    for (int i = 0; i < 5; ++i) {
        const LAS unsigned char* kp = Kt + (32 * (tt0 + i) + r32) * KV_RS + h * 16;
        const float nc = -cshift; f32x16 a = {nc, nc, nc, nc, nc, nc, nc, nc, nc, nc, nc, nc, nc, nc, nc, nc};
#pragma unroll
        for (int d0 = 0; d0 < 4; ++d0) { const bf16x8 kf = *(const LAS bf16x8*)(kp + 32 * d0); a = __builtin_amdgcn_mfma_f32_32x32x16_bf16(kf, qf[d0], a, 0, 0, 0); }
        s[i] = a;
    }
    const int qloc = qrel - 32 * tt0, ndead = (kvmin >> 5) - tt0;
    float ls = 0.f;
#pragma unroll
    for (int i = 0; i < 5; ++i)
#pragma unroll
        for (int r = 0; r < 16; ++r) { const int cr = (r & 3) + 8 * (r >> 2); bool ok = (i >= ndead);
            if (i == 0) ok = ok && (cr + 4 * h > qloc);
            if (i == 4) ok = ok && (cr + 4 * h <= qloc);
            const float p = ok ? __builtin_amdgcn_exp2f(s[i][r]) : 0.f; s[i][r] = p; ls += p; }
    ls += __shfl_xor(ls, 32);
    const float inv = __builtin_amdgcn_rcpf(ls + __builtin_amdgcn_exp2f(sink2 - cshift));
    o[0] = (f32x16){0.f, 0.f, 0.f, 0.f, 0.f, 0.f, 0.f, 0.f, 0.f, 0.f, 0.f, 0.f, 0.f, 0.f, 0.f, 0.f}; o[1] = o[0];
    const LAS unsigned char* vb = Vt + (4 * h + ((lane & 15) >> 2)) * KV_RS + ((lane >> 4) & 1) * 32 + (lane & 3) * 8;
#pragma unroll
    for (int i = 0; i < 5; ++i)
#pragma unroll
        for (int st = 0; st < 2; ++st) {
            v4u pw; pw.x = cvtpk(s[i][8 * st + 0], s[i][8 * st + 1]); pw.y = cvtpk(s[i][8 * st + 2], s[i][8 * st + 3]); pw.z = cvtpk(s[i][8 * st + 4], s[i][8 * st + 5]); pw.w = cvtpk(s[i][8 * st + 6], s[i][8 * st + 7]);
            const bf16x8 pf = __builtin_bit_cast(bf16x8, pw);
#pragma unroll
            for (int dt = 0; dt < 2; ++dt) {
                const LAS unsigned char* vp = vb + (32 * (tt0 + i) + 16 * st) * KV_RS + dt * 64;
                const s16x4 lo = vtr(vp), hi = vtr(vp + 8 * KV_RS);
                const bf16x8 vf = (bf16x8){lo[0], lo[1], lo[2], lo[3], hi[0], hi[1], hi[2], hi[3]};
                o[dt] = __builtin_amdgcn_mfma_f32_32x32x16_bf16(vf, pf, o[dt], 0, 0, 0);
            }
        }
#pragma unroll
    for (int dt = 0; dt < 2; ++dt)
#pragma unroll
        for (int r = 0; r < 16; ++r) o[dt][r] *= inv;
}
__device__ __forceinline__ void store_o(bf16* orow, int h, const f32x16 (&o)[2]) {
#pragma unroll
    for (int dt = 0; dt < 2; ++dt)
#pragma unroll
        for (int pr = 0; pr < 2; ++pr) {
            const int ge = 2 * pr, go = 2 * pr + 1;
            const unsigned e0 = cvtpk(o[dt][4 * ge], o[dt][4 * ge + 1]), e1 = cvtpk(o[dt][4 * ge + 2], o[dt][4 * ge + 3]);
            const unsigned o0 = cvtpk(o[dt][4 * go], o[dt][4 * go + 1]), o1 = cvtpk(o[dt][4 * go + 2], o[dt][4 * go + 3]);
            const auto r0 = __builtin_amdgcn_permlane32_swap(e0, o0, false, false), r1 = __builtin_amdgcn_permlane32_swap(e1, o1, false, false);
            const v4u w = (v4u){r0[0], r1[0], r0[1], r1[1]};
            *(v4u*)(orow + 32 * dt + 8 * (2 * pr + h)) = w; }
}
__device__ __forceinline__ void knorm32(const v4u (&raw)[4], const LAS float* gk32, float (&kf)[32]) {
    float ss = 0.f;
#pragma unroll
    for (int i = 0; i < 4; ++i)
#pragma unroll
        for (int e = 0; e < 4; ++e) { kf[8 * i + 2 * e] = bf_lo(raw[i][e]); kf[8 * i + 2 * e + 1] = bf_hi(raw[i][e]); ss += kf[8 * i + 2 * e] * kf[8 * i + 2 * e] + kf[8 * i + 2 * e + 1] * kf[8 * i + 2 * e + 1]; }
    ss += __shfl_xor(ss, 1);
    const float rs = __builtin_amdgcn_rsqf(ss * (1.0f / HD) + EPS);
#pragma unroll
    for (int i = 0; i < 8; ++i) { const f32x4 g = *(const LAS f32x4*)(gk32 + 4 * i);
#pragma unroll
        for (int e = 0; e < 4; ++e) kf[4 * i + e] = kf[4 * i + e] * rs * g[e]; }
}
__device__ __forceinline__ void lds_put32(LAS unsigned char* dst, const float (&f)[32]) {
#pragma unroll
    for (int i = 0; i < 4; ++i) { v4u w; w.x = cvtpk(f[8 * i], f[8 * i + 1]); w.y = cvtpk(f[8 * i + 2], f[8 * i + 3]); w.z = cvtpk(f[8 * i + 4], f[8 * i + 5]); w.w = cvtpk(f[8 * i + 6], f[8 * i + 7]); *(LAS v4u*)(dst + 16 * i) = w; }
}
__device__ __forceinline__ void glb_put32(float* dst, const float (&f)[32]) {
#pragma unroll
    for (int i = 0; i < 8; ++i) *(f32x4*)(dst + 4 * i) = (f32x4){f[4 * i], f[4 * i + 1], f[4 * i + 2], f[4 * i + 3]};
}

struct P2Args { const bf16* Z; const bf16* U; bf16* MIX; const float *ck, *cv, *sc, *gq, *gk, *sinks, *wdw, *bdw, *gln, *bln; float* out; const bf16* zrow; };

__device__ __forceinline__ void kv_issue(const P2Args& A, int au, int tid, v4u (&kr)[4], v4u (&vr)[4]) {
    const int b = au >> 6, qb = (au >> 2) & 15, hk = au & 3, r = tid >> 1, half = tid & 1, t = 128 * (qb - 1) + r, tc = t < 0 ? 0 : t;
    const bf16* zr = A.Z + (size_t)(b * SEQ + tc) * ZW + hk * HD + half * 32;
#pragma unroll
    for (int i = 0; i < 4; ++i) { kr[i] = *(const v4u*)(zr + 1024 + 8 * i); vr[i] = *(const v4u*)(zr + 1280 + 8 * i); }
}
__device__ __forceinline__ void attn_prompt_all(const P2Args& A, LAS unsigned char* lds, const LAS float* gq, const LAS float* gk, int bx, int G, int tid, int lane, int wave) {
    LAS unsigned char* Kt = lds; LAS unsigned char* Vt = lds + 49152;
    constexpr int NU = NB * 16 * NKV;
    const int r32 = lane & 31, h = lane >> 5;
    v4u kr[4], vr[4];
    int au = bx;
    if (au < NU) kv_issue(A, au, tid, kr, vr);
#pragma unroll 1
    for (; au < NU; au += G) {
        const int b = au >> 6, qb = (au >> 2) & 15, hk = au & 3;
        v4u qcur[4];
        { const int wu = wave * 2, g = wu >> 2, q0 = (wu & 3) * 32, head = hk * 4 + g; const size_t row = (size_t)b * SEQ + 128 * qb + q0 + r32; q_issue(A.Z + row * ZW + head * HD, h, qcur); }
        {   const int r = tid >> 1, half = tid & 1, t = 128 * (qb - 1) + r;
            if (t < 0) {
#pragma unroll
                for (int i = 0; i < 4; ++i) { kr[i] = (v4u){0u, 0u, 0u, 0u}; vr[i] = (v4u){0u, 0u, 0u, 0u}; } }
            float kf[32]; knorm32(kr, gk + half * 32, kf);
            lds_put32(Kt + r * KV_RS + half * 64, kf);
#pragma unroll
            for (int i = 0; i < 4; ++i) *(LAS v4u*)(Vt + r * KV_RS + half * 64 + 16 * i) = vr[i];
            if (qb == 15 && r >= 128) {
                const size_t oo = ((size_t)(b * 128 + (r - 128)) * NKV + hk) * HD + half * 32;
                glb_put32(A.out + O_KP + oo, kf);
                float vf[32];
#pragma unroll
                for (int i = 0; i < 4; ++i)
#pragma unroll
                    for (int e = 0; e < 4; ++e) { vf[8 * i + 2 * e] = bf_lo(vr[i][e]); vf[8 * i + 2 * e + 1] = bf_hi(vr[i][e]); }
                glb_put32(A.out + O_VP + oo, vf);
            }
        }
        __syncthreads();
#pragma unroll 1
        for (int w2 = 0; w2 < 2; ++w2) {
            const int wu = wave * 2 + w2, g = wu >> 2, q0 = (wu & 3) * 32, head = hk * 4 + g; const size_t row = (size_t)b * SEQ + 128 * qb + q0 + r32;
            v4u qnext[4];
            if (w2 == 0) q_issue(A.Z + (row + 32) * ZW + (hk * 4 + ((wu + 1) >> 2)) * HD, h, qnext);
            else {
#pragma unroll
                for (int i = 0; i < 4; ++i) qnext[i] = qcur[i]; }
            bf16x8 qf[4]; q_finish(qcur, h, gq, qf);
            if (w2 == 0 && au + G < NU) kv_issue(A, au + G, tid, kr, vr);
            f32x16 o[2];
            attn_core(Kt, Vt, q0 >> 5, q0 + r32, qb == 0 ? 128 : 0, qf, A.sinks[head] * LOG2E, gq[128], lane, o);
            store_o(A.MIX + row * DM + head * HD, h, o);
#pragma unroll
            for (int i = 0; i < 4; ++i) qcur[i] = qnext[i];
        }
        __syncthreads();
    }
}
__device__ __forceinline__ void attn_sample_unit(const P2Args& A, LAS unsigned char* lds, const LAS float* gq, const LAS float* gk, int b, int hp, int tid, int lane, int wave) {
    LAS unsigned char* Kt = lds; LAS unsigned char* Vt = lds + 49152;
#pragma unroll 1
    for (int it = 0; it < 2; ++it) {
        const int task = tid + it * 512;
        if (task < 640) {
            const int hl = task / 320, rem = task % 320, r = rem >> 1, half = rem & 1, hk = 2 * hp + hl;
            LAS unsigned char* kd = Kt + hl * (160 * KV_RS) + r * KV_RS + half * 64; LAS unsigned char* vd = Vt + hl * (160 * KV_RS) + r * KV_RS + half * 64;
            float kf[32], vf[32];
            if (r < 128) {
                const size_t io = ((size_t)(b * 128 + r) * NKV + hk) * HD + half * 32;
#pragma unroll
                for (int i = 0; i < 8; ++i) { const f32x4 a = *(const f32x4*)(A.ck + io + 4 * i), c = *(const f32x4*)(A.cv + io + 4 * i);
                    kf[4 * i] = a[0]; kf[4 * i + 1] = a[1]; kf[4 * i + 2] = a[2]; kf[4 * i + 3] = a[3]; vf[4 * i] = c[0]; vf[4 * i + 1] = c[1]; vf[4 * i + 2] = c[2]; vf[4 * i + 3] = c[3]; }
                if (r >= 4) { const size_t oo = ((size_t)(b * 128 + r - 4) * NKV + hk) * HD + half * 32; glb_put32(A.out + O_KS + oo, kf); glb_put32(A.out + O_VS + oo, vf); }
            } else if (r < 132) {
                const bf16* zr = A.Z + (size_t)(MP + b * DS + (r - 128)) * ZW + hk * HD + half * 32;
                v4u kr[4], vr[4];
#pragma unroll
                for (int i = 0; i < 4; ++i) { kr[i] = *(const v4u*)(zr + 1024 + 8 * i); vr[i] = *(const v4u*)(zr + 1280 + 8 * i); }
                knorm32(kr, gk + half * 32, kf);
#pragma unroll
                for (int i = 0; i < 4; ++i)
#pragma unroll
                    for (int e = 0; e < 4; ++e) { vf[8 * i + 2 * e] = bf_lo(vr[i][e]); vf[8 * i + 2 * e + 1] = bf_hi(vr[i][e]); }
                const size_t oo = ((size_t)(b * 128 + r - 4) * NKV + hk) * HD + half * 32; glb_put32(A.out + O_KS + oo, kf); glb_put32(A.out + O_VS + oo, vf);
            } else {
#pragma unroll
                for (int i = 0; i < 32; ++i) { kf[i] = 0.f; vf[i] = 0.f; }
            }
            lds_put32(kd, kf); lds_put32(vd, vf);
        }
    }
    __syncthreads();
    if (wave < 2) {
        const int hk = 2 * hp + wave, r32 = lane & 31, h = lane >> 5, g = (r32 >> 2) & 3, i = r32 & 3, head = hk * 4 + g;
        const size_t row = (size_t)MP + b * DS + i;
        v4u qraw[4]; q_issue(A.Z + row * ZW + head * HD, h, qraw);
        bf16x8 qf[4]; q_finish(qraw, h, gq, qf);
        f32x16 o[2];
        attn_core(Kt + wave * (160 * KV_RS), Vt + wave * (160 * KV_RS), 0, i, 0, qf, A.sinks[head] * LOG2E, gq[128], lane, o);
        if (r32 < 16) store_o(A.MIX + row * DM + head * HD, h, o);
    }
    __syncthreads();
}

template <int TT>
__device__ __forceinline__ void conv_ln_store(f32x2 (&acc)[TT], f32x2 bdw, f32x2 gln, f32x2 bln, LAS float* red, LAS float* fin, bf16* mixrow0  , int tid) {
#pragma unroll
    for (int tt = 0; tt < TT; ++tt) { const f32x2 y = acc[tt] + bdw; acc[tt] = y; red[(2 * tt) * 512 + tid] = y.x + y.y; red[(2 * tt + 1) * 512 + tid] = y.x * y.x + y.y * y.y; }
    __syncthreads();
    {   constexpr int NV = 2 * TT, PER = 512 / NV;
        const int v = tid / PER, p = tid % PER; float s = 0.f;
#pragma unroll
        for (int k = 0; k < NV; ++k) s += red[v * 512 + k * PER + p];
#pragma unroll
        for (int o = 1; o < PER; o <<= 1) s += __shfl_xor(s, o);
        if constexpr (PER == 16) {
            const float q = __shfl_xor(s, 16);
            if ((tid & 31) == 0) { const float mean = s * (1.0f / CCH), var = q * (1.0f / CCH) - mean * mean; *(LAS f32x2*)(fin + 2 * (tid >> 5)) = (f32x2){mean, __builtin_amdgcn_rsqf(var + EPS)}; }
        } else { if (p == 0) fin[v] = s; } }
    __syncthreads();
#pragma unroll
    for (int tt = 0; tt < TT; ++tt) {
        f32x2 mr = *(const LAS f32x2*)(fin + 2 * tt);
        if constexpr (512 / (2 * TT) != 16) { const float mean = mr.x * (1.0f / CCH), var = mr.y * (1.0f / CCH) - mean * mean; mr = (f32x2){mean, __builtin_amdgcn_rsqf(var + EPS)}; }
        const f32x2 val = (acc[tt] - mr.x) * (gln * mr.y) + bln;
        const float o0 = val.x * __builtin_amdgcn_rcpf(1.0f + __expf(-val.x)), o1 = val.y * __builtin_amdgcn_rcpf(1.0f + __expf(-val.y));
        *(unsigned*)(mixrow0 + (size_t)tt * DM) = cvtpk(o0, o1);
    }
}
constexpr int CTT = 16;
__device__ __forceinline__ void conv_issue(const P2Args& A, int cu, int tid, unsigned (&raw)[CTT + 30]) {
    const int b = cu >> 7, t0 = (cu & 127) * CTT;
#pragma unroll
    for (int rr = 0; rr < CTT + 30; ++rr) { const int t = t0 - 30 + rr;
        const char* rowp = (t >= 0) ? (const char*)(A.U + (size_t)(b * SEQ + t) * CCH) : (const char*)A.zrow;
        raw[rr] = *(const unsigned*)(rowp + (unsigned)(4 * tid)); }
}
__device__ __forceinline__ void conv_prompt_all(const P2Args& A, LAS unsigned char* lds, const f32x2 (&w)[CW], f32x2 bdw, f32x2 gln, f32x2 bln, int first, int G, int NU, int tid) {
    LAS float* red = (LAS float*)lds; LAS float* fin = (LAS float*)(lds + 65536);
    const int c = 2 * tid;
    unsigned raw[CTT + 30];
    int cu = first;
    if (cu < NU) conv_issue(A, cu, tid, raw);
#pragma unroll 1
    for (; cu < NU; cu += G) {
        const int b = cu >> 7, t0 = (cu & 127) * CTT;
        f32x2 acc[CTT];
#pragma unroll
        for (int tt = 0; tt < CTT; ++tt) acc[tt] = (f32x2){0.f, 0.f};
#pragma unroll
        for (int rr = 0; rr < CTT + 30; ++rr) {
            const f32x2 u2 = (f32x2){bf_lo(raw[rr]), bf_hi(raw[rr])};
#pragma unroll
            for (int tt = 0; tt < CTT; ++tt) { const int j = rr - tt; if (j >= 0 && j < CW) acc[tt] += w[j] * u2; }
        }
        if (t0 + CTT > SEQ - 30) {
#pragma unroll
            for (int rr = 30; rr < CTT + 30; ++rr) { const int t = t0 - 30 + rr; if (t >= SEQ - 30) *(f32x2*)(A.out + O_CP + ((size_t)b * 30 + t - (SEQ - 30)) * CCH + c) = (f32x2){bf_lo(raw[rr]), bf_hi(raw[rr])}; }
        }
        if (cu + G < NU) conv_issue(A, cu + G, tid, raw);
        conv_ln_store<CTT>(acc, bdw, gln, bln, red, fin, A.MIX + (size_t)(b * SEQ + t0) * DM + 1024 + c, tid);
    }
}
__device__ __forceinline__ void conv_sample_unit(const P2Args& A, LAS unsigned char* lds, int b, const f32x2 (&w)[CW], f32x2 bdw, f32x2 gln, f32x2 bln, int tid) {
    LAS float* red = (LAS float*)lds; LAS float* fin = (LAS float*)(lds + 65536);
    const int c = 2 * tid;
    f32x2 ue[30 + DS];
#pragma unroll
    for (int rr = 0; rr < 30; ++rr) ue[rr] = *(const f32x2*)(A.sc + ((size_t)b * 30 + rr) * CCH + c);
#pragma unroll
    for (int rr = 0; rr < DS; ++rr) { const unsigned raw = *(const unsigned*)(A.U + (size_t)(MP + b * DS + rr) * CCH + c); ue[30 + rr] = (f32x2){bf_lo(raw), bf_hi(raw)}; }
    f32x2 acc[DS];
#pragma unroll
    for (int tt = 0; tt < DS; ++tt) acc[tt] = (f32x2){0.f, 0.f};
#pragma unroll
    for (int rr = 0; rr < DS + 30; ++rr)
#pragma unroll
        for (int tt = 0; tt < DS; ++tt) { const int j = rr - tt; if (j >= 0 && j < CW) acc[tt] += w[j] * ue[rr]; }
#pragma unroll
    for (int rr = DS; rr < 30 + DS; ++rr) *(f32x2*)(A.out + O_CS + ((size_t)b * 30 + rr - DS) * CCH + c) = ue[rr];
    conv_ln_store<DS>(acc, bdw, gln, bln, red, fin, A.MIX + (size_t)(MP + b * DS) * DM + 1024 + c, tid);
}

__device__ __forceinline__ void run_p2(const P2Args& A, LAS unsigned char* lds, int bx, int G, int tid, int lane, int wave) {
    LAS float* gq = (LAS float*)(lds + 98304); LAS float* gk = gq + 64;
    if (tid < 64) { const float a = A.gq[tid], b = A.gk[tid]; gq[tid] = a; gk[tid] = b;
        float ma = fabsf(a), mb = fabsf(b);
#pragma unroll
        for (int o = 1; o < 64; o <<= 1) { ma = fmaxf(ma, __shfl_xor(ma, o)); mb = fmaxf(mb, __shfl_xor(mb, o)); }
        if (tid == 0) gq[128] = fmaxf(0.f, QSCALE * 64.0f * ma * mb - 64.0f); }
    __syncthreads();
    attn_prompt_all(A, lds, gq, gk, bx, G, tid, lane, wave);
#if PROBE == 4
    attn_prompt_all(A, lds, gq, gk, bx, G, tid, lane, wave);
#endif
    for (int su = bx; su < DB * 2; su += G) attn_sample_unit(A, lds, gq, gk, su >> 1, su & 1, tid, lane, wave);
#if PROBE == 6
    for (int su = bx; su < DB * 2; su += G) attn_sample_unit(A, lds, gq, gk, su >> 1, su & 1, tid, lane, wave);
#endif
    f32x2 w[CW];
#pragma unroll
    for (int j = 0; j < CW; ++j) w[j] = *(const f32x2*)(A.wdw + j * CCH + 2 * tid);
    const f32x2 bdw = *(const f32x2*)(A.bdw + 2 * tid), gln = *(const f32x2*)(A.gln + 2 * tid), bln = *(const f32x2*)(A.bln + 2 * tid);
    conv_prompt_all(A, lds, w, bdw, gln, bln, bx, G, MP / CTT, tid);
#if PROBE == 5
    conv_prompt_all(A, lds, w, bdw, gln, bln, bx, G, MP / CTT, tid);
#endif
    for (int cu = bx; cu < DB; cu += G) conv_sample_unit(A, lds, cu, w, bdw, gln, bln, tid);
#if PROBE == 6
    for (int cu = bx; cu < DB; cu += G) conv_sample_unit(A, lds, cu, w, bdw, gln, bln, tid);
#endif
}

template <int MODE> struct SEpi;
struct SgPtrs { bf16* Z; bf16* U; const float* rstd1; const float* xs; float* out; bf16* XB; float* ssqs; bf16* H; const float* r2; };
__device__ __forceinline__ void sg_store_bf16(bf16* p, float x) { *p = (bf16)f2bf(x); }
template <int MODE>
__device__ __forceinline__ void sg_epilogue(const SgPtrs& P, const float (&v)[2][4], int rs0  , int nblk  , int r) {
#pragma unroll
    for (int e = 0; e < 4; ++e) {
        const int rs = rs0 + e; const size_t row = (size_t)MP + rs;
        if (MODE == 0) { const float s = P.rstd1[row];
#pragma unroll
            for (int cb = 0; cb < 2; ++cb) sg_store_bf16(P.Z + row * ZW + 64 * nblk + 32 * cb + r, v[cb][e] * s); }
        if (MODE == 1) { const float s = P.rstd1[row]; const float a = v[0][e] * s, g = v[1][e] * s; sg_store_bf16(P.U + row * CCH + 32 * nblk + r, a * __builtin_amdgcn_rcpf(1.0f + __expf(-g))); }
        if (MODE == 2) {
#pragma unroll
            for (int cb = 0; cb < 2; ++cb) { const int col = 64 * nblk + 32 * cb + r; const float x1 = P.xs[(size_t)rs * DM + col] + v[cb][e];
                P.out[row * DM + col] = x1; sg_store_bf16(P.XB + row * DM + col, x1);
                float q = x1 * x1;
#pragma unroll
                for (int o = 1; o < 32; o <<= 1) q += __shfl_xor(q, o);
                if (r == 0) P.ssqs[(size_t)rs * 64 + 2 * nblk + cb] = q; } }
        if (MODE == 3) {
#pragma unroll
            for (int cb = 0; cb < 2; ++cb) { const float a = fmaxf(v[cb][e], 0.f); sg_store_bf16(P.H + row * FF + 64 * nblk + 32 * cb + r, a * a); } }
        if (MODE == 4) { const float s = P.r2[row];
#pragma unroll
            for (int cb = 0; cb < 2; ++cb) { float* o = P.out + row * DM + 64 * nblk + 32 * cb + r; *o = *o + s * v[cb][e]; } }
    }
}
#define SG_MMA(a0, a1, b0, b1) do { _Pragma("unroll") for (int j_ = 0; j_ < 4; ++j_) { \
        acc[0][0] = __builtin_amdgcn_mfma_f32_32x32x16_bf16(a0[j_], b0[j_], acc[0][0], 0, 0, 0); \
        acc[0][1] = __builtin_amdgcn_mfma_f32_32x32x16_bf16(a0[j_], b1[j_], acc[0][1], 0, 0, 0); \
        acc[1][0] = __builtin_amdgcn_mfma_f32_32x32x16_bf16(a1[j_], b0[j_], acc[1][0], 0, 0, 0); \
        acc[1][1] = __builtin_amdgcn_mfma_f32_32x32x16_bf16(a1[j_], b1[j_], acc[1][1], 0, 0, 0); } } while (0)
template <int MODE>
__device__ __forceinline__ void sgemm_tile(LAS unsigned char* lds, const SgPtrs& P, const bf16* A0  , const bf16* Bb0, const bf16* Bb1, int K, int mi, int nblk, int lane_, int wave) {
    int lane = lane_; asm volatile("" : "+v"(lane));
    const int r = lane & 31, h = lane >> 5, kw = K >> 3, ns = kw >> 6, lr = lane >> 3, lc = lane & 7;
    const unsigned goff = (unsigned)(lr * K + wave * kw) * 2u + (unsigned)lc * 16u, gp = (unsigned)(8 * K) * 2u;
    LAS unsigned char* wb = lds + wave * 16384;
    const int wofs0 = lr * 128 + ((lc ^ lr) * 16), wofs1 = lr * 128 + ((lc ^ lr ^ 1) * 16);
    const int rm = (r & 7) ^ ((r >> 3) & 1);
    __syncthreads();
    f32x16 acc[2][2];
#pragma unroll
    for (int i = 0; i < 2; ++i)
#pragma unroll
        for (int j = 0; j < 2; ++j) acc[i][j] = (f32x16){0.f, 0.f, 0.f, 0.f, 0.f, 0.f, 0.f, 0.f, 0.f, 0.f, 0.f, 0.f, 0.f, 0.f, 0.f, 0.f};
    v4u g[4][4];
#define SG_ISSUE(kb) do { _Pragma("unroll") for (int p_ = 0; p_ < 4; ++p_) { \
        g[0][p_] = *(const v4u*)((const char*)A0 + (goff + p_ * gp + (kb))); g[1][p_] = *(const v4u*)((const char*)A0 + (goff + (p_ + 4) * gp + (kb))); \
        g[2][p_] = *(const v4u*)((const char*)Bb0 + (goff + p_ * gp + (kb))); g[3][p_] = *(const v4u*)((const char*)Bb1 + (goff + p_ * gp + (kb))); } } while (0)
#define SG_WRITE() do { _Pragma("unroll") for (int b_ = 0; b_ < 4; ++b_) _Pragma("unroll") for (int p_ = 0; p_ < 4; ++p_) \
        *(LAS v4u*)(wb + b_ * 4096 + p_ * 1024 + ((p_ & 1) ? wofs1 : wofs0)) = g[b_][p_]; } while (0)
    SG_ISSUE(0u);
    SG_WRITE();
#pragma unroll 1
    for (int s = 0; s < ns; ++s) {
        const bool more = (s + 1 < ns);
        if (more) SG_ISSUE(128u * (unsigned)(s + 1));
        __builtin_amdgcn_sched_barrier(0);
        bf16x8 a0[4], a1[4], b0[4], b1[4];
#pragma unroll
        for (int j = 0; j < 4; ++j) { const int co = r * 128 + (((2 * j + h) ^ rm) * 16);
            a0[j] = *(const LAS bf16x8*)(wb + co); a1[j] = *(const LAS bf16x8*)(wb + 4096 + co); b0[j] = *(const LAS bf16x8*)(wb + 8192 + co); b1[j] = *(const LAS bf16x8*)(wb + 12288 + co); }
        SG_MMA(a0, a1, b0, b1);
        __builtin_amdgcn_sched_barrier(0);
        if (more) SG_WRITE();
    }
#undef SG_ISSUE
#undef SG_WRITE
    LAS float* red = (LAS float*)lds;
    __syncthreads();
#pragma unroll
    for (int rb = 0; rb < 2; ++rb)
#pragma unroll
        for (int cb = 0; cb < 2; ++cb)
#pragma unroll
            for (int g2 = 0; g2 < 16; ++g2) red[(wave * 64 + rb * 32 + cb * 16 + g2) * 64 + lane] = acc[rb][cb][g2];
    __syncthreads();
    const int rb = wave >> 2, q = wave & 3;
    float v[2][4];
#pragma unroll
    for (int cb = 0; cb < 2; ++cb)
#pragma unroll
        for (int e2 = 0; e2 < 4; ++e2) { float sm = 0.f;
#pragma unroll
            for (int ww = 0; ww < 8; ++ww) sm += red[(ww * 64 + rb * 32 + cb * 16 + 4 * q + e2) * 64 + lane];
            v[cb][e2] = sm; }
    sg_epilogue<MODE>(P, v, 64 * mi + 32 * rb + 8 * q + 4 * h, nblk, r);
}
#undef SG_MMA

struct Args { const float* in[18]; float* out; unsigned char* ws; };
__global__ void __launch_bounds__(NWAVES * 64, 2) fwd_kernel(Args args) {
    extern __shared__ __attribute__((aligned(16))) unsigned char lds_raw[];
    LAS unsigned char* lds = (LAS unsigned char*)lds_raw;
    volatile LAS unsigned* MISC = (volatile LAS unsigned*)(lds + MISC_OFF);
    const int tid = threadIdx.x, lane = tid & 63, wave = __builtin_amdgcn_readfirstlane(tid >> 6);
    const int G = gridDim.x, bx = blockIdx.x;
    unsigned char* ws = args.ws;
    unsigned* ctl = (unsigned*)(ws + WS_CTL);
    const float* xp = args.in[0]; const float* xs = args.in[1];
    bf16* Wi = (bf16*)(ws + WS_WIN); bf16* Wo = (bf16*)(ws + WS_WOUT); bf16* Wu = (bf16*)(ws + WS_WUP); bf16* Wd = (bf16*)(ws + WS_WDN);
    float* rstd1 = (float*)(ws + WS_RSTD1); float* r2 = (float*)(ws + WS_R2); float* ssq = (float*)(ws + WS_SSQ); float* ssqs = (float*)(ws + WS_SSQS);
    bf16* XB = (bf16*)(ws + WS_XB); bf16* Z = (bf16*)(ws + WS_Z); bf16* U = (bf16*)(ws + WS_U); bf16* MIX = (bf16*)(ws + WS_MIX); bf16* H = (bf16*)(ws + WS_H);
    float* out = args.out;
    const SgPtrs SP{Z, U, rstd1, xs, out, XB, ssqs, H, r2};
    const int SG_XCD = bx & 7, SG_MI = (bx >> 3) >> 2, SG_NS = (bx >> 3) & 3;
    for (int u = tid; u < (LDS_BYTES - RING_BYTES) / 4; u += NWAVES * 64) ((LAS unsigned*)(lds + RING_BYTES))[u] = 0u;
    __syncthreads();
    XcdBarrier bar = xcd_barrier_post(ctl + CW_BAR, MISC + 8);

    for (int rep_ = 0; rep_ < (PROBE == 1 ? 2 : 1); ++rep_) {
        LAS float* scr = (LAS float*)(lds + wave * 16384);
        const int gw = bx * NWAVES + wave, NGW = G * NWAVES;
        const P0Mats Mx{args.in[6], args.in[5], args.in[14], args.in[16], args.in[15], args.in[17], Wi, Wo, Wu, Wd};
        p0_weights(Mx, scr, gw, NGW, lane);
        p0_xrows(xp, xs, XB, rstd1, gw, NGW, lane);
    }
    xcd_barrier(bar);

    {
#define SGR_IN(lo, hi) for (int rd = (lo); rd < (hi); ++rd) { const int mi = SG_MI, ni = (rd * 8 + SG_XCD) * 4 + SG_NS; \
            if (ni < 24) sgemm_tile<0>(lds, SP, XB + (size_t)(MP + 64 * mi) * DM, Wi + (size_t)(64 * ni) * DM, Wi + (size_t)(64 * ni + 32) * DM, DM, mi, ni, lane, wave); \
            else if (ni < 56) { const int ci = ni - 24, ch = 32 * ci; const bf16* b0 = Wi + (size_t)(ZW + 256 * (ch >> 7) + (ch & 127)) * DM; \
                sgemm_tile<1>(lds, SP, XB + (size_t)(MP + 64 * mi) * DM, b0, b0 + (size_t)128 * DM, DM, mi, ci, lane, wave); } }
        const int nf = (SG_NS * 2) / 3;
        SGR_IN(0, nf);
        __syncthreads();
        pg8::Gemm g{XB, Wi, MP, INW, DM}; pg8::StaticOrder S; S.init(MP, INW, G, bx);
        pg8::EpiIn E{Z, U, rstd1};
        pg8::gemm_phase<pg8::EpiIn, pg8::StaticOrder, true, true>(lds, g, S, E);
        SGR_IN(nf, 2);
#undef SGR_IN
    }
    xcd_barrier(bar);

    {
        P2Args A{Z, U, MIX, args.in[2], args.in[3], args.in[4], args.in[7], args.in[8], args.in[9], args.in[10], args.in[11], args.in[12], args.in[13], out, (const bf16*)(ws + WS_ZROW)};
        run_p2(A, lds, bx, G, tid, lane, wave);
#if PROBE == 2
        run_p2(A, lds, bx, G, tid, lane, wave);
#endif
    }
    xcd_barrier(bar);

    for (int rep_ = 0; rep_ < (PROBE == 3 ? 2 : 1); ++rep_) {
#define SGR_OUT(lo, hi) for (int rd = (lo); rd < (hi); ++rd) { const int mi = SG_MI, ni = SG_XCD * 4 + SG_NS; sgemm_tile<2>(lds, SP, MIX + (size_t)(MP + 64 * mi) * DM, Wo + (size_t)(64 * ni) * DM, Wo + (size_t)(64 * ni + 32) * DM, DM, mi, ni, lane, wave); }
        const int nf = SG_NS & 1;
        SGR_OUT(0, nf);
        __syncthreads();
        pg8::Gemm g{MIX, Wo, MP, DM, DM}; pg8::StaticOrder S; S.init(MP, DM, G, bx, 4);
        pg8::EpiOut E{xp, xs, out, XB, ssq};
        pg8::gemm_phase<pg8::EpiOut, pg8::StaticOrder, true, true>(lds, g, S, E);
        SGR_OUT(nf, 1);
#undef SGR_OUT
    }
    xcd_barrier(bar);

    {
        for (int row = bx * (NWAVES * 64) + tid; row < M; row += G * NWAVES * 64) {
            float s = 0.f;
            if (row < MP) { const f32x4* p = (const f32x4*)(ssq + (size_t)row * 32);
#pragma unroll
                for (int i = 0; i < 8; ++i) { const f32x4 v = p[i]; s += (v.x + v.y) + (v.z + v.w); } }
            else { const f32x4* p = (const f32x4*)(ssqs + (size_t)(row - MP) * 64);
#pragma unroll
                for (int i = 0; i < 16; ++i) { const f32x4 v = p[i]; s += (v.x + v.y) + (v.z + v.w); } }
            r2[row] = 1.0f / (s * (1.0f / DM) + EPS);
        }
#define SGR_UP(lo, hi) for (int rd = (lo); rd < (hi); ++rd) { const int mi = SG_MI, ni = (rd * 8 + SG_XCD) * 4 + SG_NS; sgemm_tile<3>(lds, SP, XB + (size_t)(MP + 64 * mi) * DM, Wu + (size_t)(64 * ni) * DM, Wu + (size_t)(64 * ni + 32) * DM, DM, mi, ni, lane, wave); }
        const int nf = SG_NS;
        SGR_UP(0, nf);
        __syncthreads();
        pg8::Gemm g{XB, Wu, MP, FF, DM}; pg8::StaticOrder S; S.init(MP, FF, G, bx);
        pg8::EpiUp E{H};
        pg8::gemm_phase<pg8::EpiUp, pg8::StaticOrder, true, true>(lds, g, S, E);
        SGR_UP(nf, 4);
#undef SGR_UP
    }
    xcd_barrier(bar);

    {
#define SGR_DN(lo, hi) for (int rd = (lo); rd < (hi); ++rd) { const int mi = SG_MI, ni = SG_XCD * 4 + SG_NS; sgemm_tile<4>(lds, SP, H + (size_t)(MP + 64 * mi) * FF, Wd + (size_t)(64 * ni) * FF, Wd + (size_t)(64 * ni + 32) * FF, FF, mi, ni, lane, wave); }
        const int nf = SG_NS & 1;
        SGR_DN(0, nf);
        __syncthreads();
        pg8::Gemm g{H, Wd, MP, DM, FF}; pg8::StaticOrder S; S.init(MP, DM, G, bx, 4);
        pg8::EpiDown E{out, r2, XB};
        pg8::gemm_phase<pg8::EpiDown, pg8::StaticOrder, true, true>(lds, g, S, E);
        SGR_DN(nf, 1);
#undef SGR_DN
    }
}

extern "C" void kernel_launch(void* const* d_in, const int* in_sizes, int n_in, void* d_out, int out_size, void* d_ws, size_t ws_size, hipStream_t stream) {
    static int grid = 0;
    if (grid == 0) {
        if (n_in != 18 || (size_t)out_size != O_END || ws_size < WS_END) { fprintf(stderr, "kernel_launch: unexpected shapes (n_in %d, out %d, ws %zu); nothing launched\n", n_in, out_size, ws_size); grid = -1; return; }
        int dev = 0, cus = 0, per_cu = 0;
        if (hipGetDevice(&dev) != hipSuccess || hipDeviceGetAttribute(&cus, hipDeviceAttributeMultiprocessorCount, dev) != hipSuccess) { grid = -1; return; }
        if (hipFuncSetAttribute((const void*)fwd_kernel, hipFuncAttributeMaxDynamicSharedMemorySize, LDS_BYTES) != hipSuccess) { fprintf(stderr, "kernel_launch: hipFuncSetAttribute failed\n"); grid = -1; return; }
        if (hipOccupancyMaxActiveBlocksPerMultiprocessor(&per_cu, (const void*)fwd_kernel, NWAVES * 64, LDS_BYTES) != hipSuccess || per_cu < 1) { fprintf(stderr, "kernel_launch: occupancy query reports %d\n", per_cu); }
        (void)hipGetLastError();
        if (cus < 256) { fprintf(stderr, "kernel_launch: built for a 256-CU device (got %d CUs); nothing launched\n", cus); grid = -1; return; }
        grid = 256;
    }
    if (grid < 0) return;
    if (hipMemsetAsync((char*)d_ws + WS_CTL, 0, CTL_ZERO_BYTES, stream) != hipSuccess) return;
    Args a{};
    for (int i = 0; i < 18; ++i) a.in[i] = (const float*)d_in[i];
    a.out = (float*)d_out; a.ws = (unsigned char*)d_ws;
    hipLaunchKernelGGL(fwd_kernel, dim3(grid), dim3(NWAVES * 64), LDS_BYTES, stream, a);
}
```

```cpp
#include <hip/hip_runtime.h>
#include <cstdio>
#include <cstdint>
#ifndef RES_BF16
#define RES_BF16 1
#endif
#ifndef PROBE
#define PROBE 0
#endif
namespace pg8 {
#define PG8_LAS __attribute__((address_space(3)))
typedef unsigned short bf16_t;
typedef short bf16x8 __attribute__((ext_vector_type(8)));
typedef float f32x4 __attribute__((ext_vector_type(4)));
typedef unsigned u32x4 __attribute__((ext_vector_type(4)));
constexpr int BM = 256, BK = 64, HALF = 128, HTB = HALF * BK * 2  , STAGE_BYTES = 8 * HTB, NXCD = 8, WGM = 8;

__host__ __device__ __forceinline__ int lds_byte(int r, int c) { const int st = (r >> 4) * 2 + (c >> 5), rr = r & 15, cc = c & 31, ob = rr * 64 + cc * 2; return st * 1024 + (ob ^ (((ob >> 9) & 1) << 5)); }
__host__ __device__ __forceinline__ void stage_rc(int b, int& R, int& C) { const int st = b / 1024, sb = b % 1024, swz = sb ^ (((sb >> 9) & 1) << 5); R = (st >> 1) * 16 + swz / 64; C = (st & 1) * 32 + (swz % 64) / 2; }
__host__ __device__ __forceinline__ int perm32(int rho) { const int n = rho >> 4, i = rho & 15; return 8 * (i >> 2) + 4 * n + (i & 3); }

struct Unit { int pm, pn; };
struct Gemm { const bf16_t* A; const bf16_t* Bt; int M, N, K; };

struct StaticOrder {
    int nM, nN, nwg, G, c, wgm;
    __host__ __device__ void init(int M, int N, int G_, int c_, int wgm_ = WGM) { nM = M / BM; nN = N / BM; nwg = nM * nN; G = G_; c = c_; wgm = wgm_; }
    __host__ __device__ bool next(int i, Unit& u) const {
        const long L = (long)i * G + c; if (L >= nwg) return false;
        int wgid = (int)L; { const int q = nwg / NXCD, r = nwg % NXCD, xcd = wgid % NXCD, off = wgid / NXCD; wgid = (xcd < r ? xcd * (q + 1) : r * (q + 1) + (xcd - r) * q) + off; }
        const int nig = wgm * nN, gid = wgid / nig, fm = gid * wgm, gsz = (nM - fm) < wgm ? (nM - fm) : wgm;
        u.pm = fm + ((wgid % nig) % gsz); u.pn = (wgid % nig) / gsz; return true;
    }
    __device__ __forceinline__ void a_ready(const Unit&) const {}
    __device__ __forceinline__ void done(const Unit&) const {}
};

__device__ __forceinline__ unsigned cvt_pk_bf16(float lo, float hi) { unsigned r; asm volatile("v_cvt_pk_bf16_f32 %0, %1, %2" : "=v"(r) : "v"(lo), "v"(hi)); return r; }
typedef float f32x2 __attribute__((ext_vector_type(2)));
struct EpiIn {
    static constexpr bool PERM = true, AFTER_DRAIN = false;
    bf16_t* Z; bf16_t* U; const float* rstd;
    __device__ __forceinline__ void operator()(const f32x4 (&acc)[2][2][4][2], const Unit& u, int wr, int wc, int fr, int fq) const {
        const int row0 = u.pm * BM + wr * 64 + fr;
        if (u.pn < 6) {
            const int col0 = u.pn * BM + wc * 32 + 8 * fq;
#pragma unroll
            for (int ai = 0; ai < 2; ++ai)
#pragma unroll
                for (int m = 0; m < 4; ++m) { const int row = row0 + ai * HALF + m * 16; const float rs = rstd[row]; bf16_t* rowp = Z + (size_t)row * 1536 + col0;
#pragma unroll
                    for (int bj = 0; bj < 2; ++bj) { const f32x4 v0 = acc[ai][bj][m][0] * rs, v1 = acc[ai][bj][m][1] * rs;
                        u32x4 w; w.x = cvt_pk_bf16(v0[0], v0[1]); w.y = cvt_pk_bf16(v0[2], v0[3]); w.z = cvt_pk_bf16(v1[0], v1[1]); w.w = cvt_pk_bf16(v1[2], v1[3]);
                        *(u32x4*)(rowp + bj * HALF) = w; } }
        } else {
            const int c0 = (u.pn - 6) * HALF + wc * 32 + 8 * fq;
#pragma unroll
            for (int ai = 0; ai < 2; ++ai)
#pragma unroll
                for (int m = 0; m < 4; ++m) { const int row = row0 + ai * HALF + m * 16; const float rs = rstd[row];
                    float o[8];
#pragma unroll
                    for (int n = 0; n < 2; ++n)
#pragma unroll
                        for (int e = 0; e < 4; ++e) { const float a = acc[ai][0][m][n][e] * rs, g = acc[ai][1][m][n][e] * rs; o[n * 4 + e] = a * __builtin_amdgcn_rcpf(1.0f + __expf(-g)); }
                    u32x4 w; w.x = cvt_pk_bf16(o[0], o[1]); w.y = cvt_pk_bf16(o[2], o[3]); w.z = cvt_pk_bf16(o[4], o[5]); w.w = cvt_pk_bf16(o[6], o[7]);
                    *(u32x4*)(U + (size_t)row * 1024 + c0) = w; }
        }
    }
};
struct EpiOut {
#if RES_BF16
    static constexpr bool PERM = true, AFTER_DRAIN = false;
    const float* xp; const float* xs; float* out; bf16_t* XB; float* ssq;
    __device__ __forceinline__ void operator()(const f32x4 (&acc)[2][2][4][2], const Unit& u, int wr, int wc, int fr, int fq) const {
        const int row0 = u.pm * BM + wr * 64 + fr, col0 = u.pn * BM + wc * 32 + 8 * fq;
#pragma unroll
        for (int ai = 0; ai < 2; ++ai) {
            u32x4 xr[4][2];
#pragma unroll
            for (int m = 0; m < 4; ++m) { const size_t ro = (size_t)(row0 + ai * HALF + m * 16) * 2048 + col0;
#pragma unroll
                for (int bj = 0; bj < 2; ++bj) xr[m][bj] = *(const u32x4*)(XB + ro + bj * HALF); }
            __builtin_amdgcn_sched_barrier(0);
#pragma unroll
            for (int m = 0; m < 4; ++m) { const int row = row0 + ai * HALF + m * 16; const size_t ro = (size_t)row * 2048 + col0; float q = 0.f;
#pragma unroll
                for (int bj = 0; bj < 2; ++bj) { const u32x4 xw = xr[m][bj];
                    const f32x4 x0 = (f32x4){__builtin_bit_cast(float, xw.x << 16), __builtin_bit_cast(float, xw.x & 0xffff0000u), __builtin_bit_cast(float, xw.y << 16), __builtin_bit_cast(float, xw.y & 0xffff0000u)};
                    const f32x4 x1 = (f32x4){__builtin_bit_cast(float, xw.z << 16), __builtin_bit_cast(float, xw.z & 0xffff0000u), __builtin_bit_cast(float, xw.w << 16), __builtin_bit_cast(float, xw.w & 0xffff0000u)};
                    const f32x4 v0 = acc[ai][bj][m][0] + x0, v1 = acc[ai][bj][m][1] + x1;
                    u32x4 w; w.x = cvt_pk_bf16(v0[0], v0[1]); w.y = cvt_pk_bf16(v0[2], v0[3]); w.z = cvt_pk_bf16(v1[0], v1[1]); w.w = cvt_pk_bf16(v1[2], v1[3]);
                    *(u32x4*)(XB + ro + bj * HALF) = w;
                    q += (v0[0] * v0[0] + v0[1] * v0[1]) + (v0[2] * v0[2] + v0[3] * v0[3]) + (v1[0] * v1[0] + v1[1] * v1[1]) + (v1[2] * v1[2] + v1[3] * v1[3]); }
                q += __shfl_xor(q, 16); q += __shfl_xor(q, 32);
                if (fq == 0) ssq[(size_t)row * 32 + u.pn * 4 + wc] = q; }
            __builtin_amdgcn_sched_barrier(0);
        }
    }
#else
    static constexpr bool PERM = false, AFTER_DRAIN = false;
    const float* xp; const float* xs; float* out; bf16_t* XB; float* ssq;
    __device__ __forceinline__ void operator()(const f32x4 (&acc)[2][2][4][2], const Unit& u, int wr, int wc, int fr, int fq) const {
        typedef unsigned u32x2 __attribute__((ext_vector_type(2)));
        const int row0 = u.pm * BM + wr * 64 + fr, col0 = u.pn * BM + wc * 32 + 4 * fq;
        const float* xb = (u.pm < 128) ? xp : (xs - (size_t)32768 * 2048);
#pragma unroll
        for (int ai = 0; ai < 2; ++ai) {
            f32x4 xr[4][2][2];
#pragma unroll
            for (int m = 0; m < 4; ++m) { const size_t ro = (size_t)(row0 + ai * HALF + m * 16) * 2048 + col0;
#pragma unroll
                for (int bj = 0; bj < 2; ++bj) { xr[m][bj][0] = *(const f32x4*)(xb + ro + bj * HALF); xr[m][bj][1] = *(const f32x4*)(xb + ro + bj * HALF + 16); } }
            __builtin_amdgcn_sched_barrier(0);
#pragma unroll
            for (int m = 0; m < 4; ++m) { const int row = row0 + ai * HALF + m * 16; const size_t ro = (size_t)row * 2048 + col0; float q = 0.f;
#pragma unroll
                for (int bj = 0; bj < 2; ++bj)
#pragma unroll
                    for (int n = 0; n < 2; ++n) { const f32x4 v = acc[ai][bj][m][n] + xr[m][bj][n];
                        *(f32x4*)(out + ro + bj * HALF + n * 16) = v;
                        u32x2 w; w.x = cvt_pk_bf16(v[0], v[1]); w.y = cvt_pk_bf16(v[2], v[3]);
                        *(u32x2*)(XB + ro + bj * HALF + n * 16) = w;
                        q += (v[0] * v[0] + v[1] * v[1]) + (v[2] * v[2] + v[3] * v[3]); }
                q += __shfl_xor(q, 16); q += __shfl_xor(q, 32);
                if (fq == 0) ssq[(size_t)row * 32 + u.pn * 4 + wc] = q; }
            __builtin_amdgcn_sched_barrier(0);
        }
    }
#endif
};
struct EpiUp {
    static constexpr bool PERM = true, AFTER_DRAIN = false;
    bf16_t* H;
    __device__ __forceinline__ void operator()(const f32x4 (&acc)[2][2][4][2], const Unit& u, int wr, int wc, int fr, int fq) const {
        const int row0 = u.pm * BM + wr * 64 + fr, col0 = u.pn * BM + wc * 32 + 8 * fq;
#pragma unroll
        for (int ai = 0; ai < 2; ++ai)
#pragma unroll
            for (int m = 0; m < 4; ++m) { bf16_t* rowp = H + (size_t)(row0 + ai * HALF + m * 16) * 8192 + col0;
#pragma unroll
                for (int bj = 0; bj < 2; ++bj) { f32x4 v0 = acc[ai][bj][m][0], v1 = acc[ai][bj][m][1];
#pragma unroll
                    for (int e = 0; e < 4; ++e) { const float a = fmaxf(v0[e], 0.f), b = fmaxf(v1[e], 0.f); v0[e] = a * a; v1[e] = b * b; }
                    u32x4 w; w.x = cvt_pk_bf16(v0[0], v0[1]); w.y = cvt_pk_bf16(v0[2], v0[3]); w.z = cvt_pk_bf16(v1[0], v1[1]); w.w = cvt_pk_bf16(v1[2], v1[3]);
                    *(u32x4*)(rowp + bj * HALF) = w; } }
    }
};
struct EpiDown {
    static constexpr bool PERM = false, AFTER_DRAIN = false;
    float* out; const float* r2; const bf16_t* XB;
    __device__ __forceinline__ void operator()(const f32x4 (&acc)[2][2][4][2], const Unit& u, int wr, int wc, int fr, int fq) const {
        typedef unsigned u32x2 __attribute__((ext_vector_type(2)));
        const int row0 = u.pm * BM + wr * 64 + fr, col0 = u.pn * BM + wc * 32 + 4 * fq;
#pragma unroll
        for (int ai = 0; ai < 2; ++ai) {
#if RES_BF16
            u32x2 xr[4][2][2]; float sc[4];
#pragma unroll
            for (int m = 0; m < 4; ++m) { const int row = row0 + ai * HALF + m * 16; const bf16_t* rowp = XB + (size_t)row * 2048 + col0; sc[m] = r2[row];
#pragma unroll
                for (int bj = 0; bj < 2; ++bj) { xr[m][bj][0] = *(const u32x2*)(rowp + bj * HALF); xr[m][bj][1] = *(const u32x2*)(rowp + bj * HALF + 16); } }
            __builtin_amdgcn_sched_barrier(0);
#pragma unroll
            for (int m = 0; m < 4; ++m) { float* rowp = out + (size_t)(row0 + ai * HALF + m * 16) * 2048 + col0;
#pragma unroll
                for (int bj = 0; bj < 2; ++bj)
#pragma unroll
                    for (int n = 0; n < 2; ++n) { const u32x2 w = xr[m][bj][n];
                        const f32x4 x = (f32x4){__builtin_bit_cast(float, w.x << 16), __builtin_bit_cast(float, w.x & 0xffff0000u), __builtin_bit_cast(float, w.y << 16), __builtin_bit_cast(float, w.y & 0xffff0000u)};
                        *(f32x4*)(rowp + bj * HALF + n * 16) = x + acc[ai][bj][m][n] * sc[m]; } }
            __builtin_amdgcn_sched_barrier(0);
#else
            f32x4 xr[4][2][2]; float sc[4];
#pragma unroll
            for (int m = 0; m < 4; ++m) { const int row = row0 + ai * HALF + m * 16; const float* rowp = out + (size_t)row * 2048 + col0; sc[m] = r2[row];
#pragma unroll
                for (int bj = 0; bj < 2; ++bj) { xr[m][bj][0] = *(const f32x4*)(rowp + bj * HALF); xr[m][bj][1] = *(const f32x4*)(rowp + bj * HALF + 16); } }
            __builtin_amdgcn_sched_barrier(0);
#pragma unroll
            for (int m = 0; m < 4; ++m) { float* rowp = out + (size_t)(row0 + ai * HALF + m * 16) * 2048 + col0;
#pragma unroll
                for (int bj = 0; bj < 2; ++bj) { *(f32x4*)(rowp + bj * HALF) = xr[m][bj][0] + acc[ai][bj][m][0] * sc[m]; *(f32x4*)(rowp + bj * HALF + 16) = xr[m][bj][1] + acc[ai][bj][m][1] * sc[m]; } }
            __builtin_amdgcn_sched_barrier(0);
#endif
        }
    }
};

template <class Epi, class Sched, bool ALIGN_EPI = false, bool SP2 = false>
__device__ __forceinline__ void gemm_phase(PG8_LAS unsigned char* lds, const Gemm g, const Sched& S, const Epi& E) {
    int tid_ = threadIdx.x; asm volatile("" : "+v"(tid_));
    const int tid = tid_, wid = __builtin_amdgcn_readfirstlane(tid >> 6), lane = tid & 63, wr = wid >> 2, wc = wid & 3, fr = lane & 15, fq = lane >> 4;
    const int K = g.K, nt = K / BK;
    unsigned voffA[2], voffB[2];
#pragma unroll
    for (int i = 0; i < 2; ++i) { int R, C; stage_rc(tid * 16 + i * 8192, R, C); const int Rb = Epi::PERM ? ((R & ~31) + perm32(R & 31)) : R;
        voffA[i] = (unsigned)(R * K + C) * 2u; voffB[i] = (unsigned)(Rb * K + C) * 2u; }
    const size_t kstep = (size_t)(BK * 2);
    const size_t hstep = (size_t)HALF * K * 2;
    const size_t tstep = 2 * hstep;
    const unsigned ldsw = (unsigned)wid * 1024u;
    const int aoff = lds_byte(wr * 64 + fr, fq * 8), boff = lds_byte(wc * 32 + fr, fq * 8);
#define PG8_SA(b, h) (((b) * 2 + (h)) * HTB)
#define PG8_SB(b, h) ((4 + (b) * 2 + (h)) * HTB)
#define PG8_STAGE(bufoff, gbase, voff) do { _Pragma("unroll") for (int _i = 0; _i < 2; ++_i) \
        __builtin_amdgcn_global_load_lds((const unsigned*)((const char*)(gbase) + (voff)[_i]), (PG8_LAS unsigned*)(lds + (bufoff) + ldsw + _i * 8192), 16, 0, 0); } while (0)
#define PG8_LDA(dst, b, h) do { _Pragma("unroll") for (int m = 0; m < 4; ++m) _Pragma("unroll") for (int k = 0; k < 2; ++k) dst[m][k] = *(const PG8_LAS bf16x8*)(lds + PG8_SA(b, h) + aoff + m * 2048 + k * 1024); } while (0)
#define PG8_LDB(dst, b, h) do { _Pragma("unroll") for (int n = 0; n < 2; ++n) _Pragma("unroll") for (int k = 0; k < 2; ++k) dst[n][k] = *(const PG8_LAS bf16x8*)(lds + PG8_SB(b, h) + boff + n * 2048 + k * 1024); } while (0)
#define PG8_MMA(ai, bj, At, Bt) do { __builtin_amdgcn_s_setprio(1); _Pragma("unroll") for (int m = 0; m < 4; ++m) _Pragma("unroll") for (int n = 0; n < 2; ++n) _Pragma("unroll") for (int k = 0; k < 2; ++k) \
        acc[ai][bj][m][n] = __builtin_amdgcn_mfma_f32_16x16x32_bf16(Bt[n][k], At[m][k], acc[ai][bj][m][n], 0, 0, 0); __builtin_amdgcn_s_setprio(0); } while (0)
#define PG8_WAIT_V(n) asm volatile("s_waitcnt vmcnt(" #n ")" ::: "memory")
#define PG8_WAIT_L(n) asm volatile("s_waitcnt lgkmcnt(" #n ")" ::: "memory")
#define PG8_BAR __builtin_amdgcn_s_barrier()
#define PG8_SCHED __builtin_amdgcn_sched_barrier(0)
    Unit cur, nxt; int ui = 0;
    if (!S.next(0, cur)) return;
    f32x4 acc[2][2][4][2];
#pragma unroll
    for (int a = 0; a < 2; ++a)
#pragma unroll
        for (int b = 0; b < 2; ++b)
#pragma unroll
            for (int m = 0; m < 4; ++m)
#pragma unroll
                for (int n = 0; n < 2; ++n) acc[a][b][m][n] = (f32x4){0.f, 0.f, 0.f, 0.f};
    bf16x8 At[4][2], B0[2][2], B1[2][2];
    const char* cA = (const char*)g.A + (size_t)cur.pm * tstep; const char* cB = (const char*)g.Bt + (size_t)cur.pn * tstep;
    S.a_ready(cur);
    if constexpr (SP2) {
        PG8_STAGE(PG8_SB(0, 0), cB, voffB); PG8_STAGE(PG8_SB(0, 1), cB + hstep, voffB); PG8_STAGE(PG8_SA(0, 0), cA, voffA); PG8_STAGE(PG8_SA(0, 1), cA + hstep, voffA);
        if (wr == 1) PG8_BAR;
        PG8_WAIT_V(2); PG8_BAR;
        PG8_STAGE(PG8_SB(1, 0), cB + kstep, voffB); PG8_STAGE(PG8_SA(1, 0), cA + kstep, voffA); PG8_STAGE(PG8_SB(1, 1), cB + hstep + kstep, voffB);
        PG8_WAIT_V(6); PG8_BAR;
    } else {
        PG8_STAGE(PG8_SB(0, 0), cB, voffB); PG8_STAGE(PG8_SA(0, 0), cA, voffA); PG8_STAGE(PG8_SB(0, 1), cB + hstep, voffB); PG8_STAGE(PG8_SA(0, 1), cA + hstep, voffA);
        if (wr == 1) PG8_BAR;
        PG8_WAIT_V(4); PG8_BAR;
        PG8_STAGE(PG8_SB(1, 0), cB + kstep, voffB); PG8_STAGE(PG8_SA(1, 0), cA + kstep, voffA); PG8_STAGE(PG8_SB(1, 1), cB + hstep + kstep, voffB);
        PG8_WAIT_V(6); PG8_BAR;
    }
    for (;;) {
        const bool has_next = S.next(ui + 1, nxt);
        const char* nA = has_next ? (const char*)g.A + (size_t)nxt.pm * tstep : cA; const char* nB = has_next ? (const char*)g.Bt + (size_t)nxt.pn * tstep : cB;
        for (int t = 0; t < nt; t += 2) {
            const bool last = (t == nt - 2);
            const char* a1 = cA + (size_t)(t + 1) * kstep;
            const char* a2 = last ? nA : cA + (size_t)(t + 2) * kstep; const char* b2 = last ? nB : cB + (size_t)(t + 2) * kstep;
            const char* a3 = a2 + kstep; const char* b3 = b2 + kstep;
            if (last && has_next) S.a_ready(nxt);
            if constexpr (SP2) {
            PG8_LDB(B0, 0, 0); PG8_LDB(B1, 0, 1); PG8_SCHED; PG8_LDA(At, 0, 0); PG8_STAGE(PG8_SA(1, 1), a1 + hstep, voffA);
            PG8_WAIT_V(8); PG8_WAIT_L(0); PG8_BAR; PG8_MMA(0, 0, At, B0); PG8_MMA(0, 1, At, B1); PG8_BAR; PG8_SCHED;
            PG8_LDA(At, 0, 1); PG8_STAGE(PG8_SB(0, 0), b2, voffB); PG8_STAGE(PG8_SB(0, 1), b2 + hstep, voffB); PG8_STAGE(PG8_SA(0, 0), a2, voffA);
            PG8_WAIT_V(8); PG8_WAIT_L(0); PG8_BAR; PG8_MMA(1, 0, At, B0); PG8_MMA(1, 1, At, B1); PG8_BAR; PG8_SCHED;
            PG8_LDB(B0, 1, 0); PG8_LDB(B1, 1, 1); PG8_SCHED; PG8_LDA(At, 1, 0); PG8_STAGE(PG8_SA(0, 1), a2 + hstep, voffA);
            PG8_WAIT_V(8); PG8_WAIT_L(0); PG8_BAR; PG8_MMA(0, 0, At, B0); PG8_MMA(0, 1, At, B1); PG8_BAR; PG8_SCHED;
            PG8_LDA(At, 1, 1); PG8_STAGE(PG8_SB(1, 0), b3, voffB); PG8_STAGE(PG8_SB(1, 1), b3 + hstep, voffB); PG8_STAGE(PG8_SA(1, 0), a3, voffA);
            PG8_WAIT_V(8); PG8_WAIT_L(0); PG8_BAR; PG8_MMA(1, 0, At, B0); PG8_MMA(1, 1, At, B1); PG8_BAR; PG8_SCHED;
            } else {
            PG8_LDB(B0, 0, 0); PG8_SCHED; PG8_LDA(At, 0, 0); PG8_STAGE(PG8_SA(1, 1), a1 + hstep, voffA);
            PG8_WAIT_L(8); PG8_BAR; PG8_WAIT_L(0); PG8_MMA(0, 0, At, B0); PG8_BAR; PG8_SCHED;
            PG8_LDB(B1, 0, 1); PG8_STAGE(PG8_SB(0, 0), b2, voffB);
            PG8_BAR; PG8_WAIT_L(0); PG8_MMA(0, 1, At, B1); PG8_BAR;
            PG8_LDA(At, 0, 1); PG8_STAGE(PG8_SA(0, 0), a2, voffA);
            PG8_BAR; PG8_WAIT_L(0); PG8_MMA(1, 0, At, B0); PG8_BAR; PG8_SCHED;
            PG8_STAGE(PG8_SB(0, 1), b2 + hstep, voffB);
            PG8_WAIT_V(6); PG8_BAR; PG8_MMA(1, 1, At, B1); PG8_BAR;
            PG8_LDB(B0, 1, 0); PG8_SCHED; PG8_LDA(At, 1, 0); PG8_STAGE(PG8_SA(0, 1), a2 + hstep, voffA);
            PG8_WAIT_L(8); PG8_BAR; PG8_WAIT_L(0); PG8_MMA(0, 0, At, B0); PG8_BAR; PG8_SCHED;
            PG8_LDB(B1, 1, 1); PG8_STAGE(PG8_SB(1, 0), b3, voffB);
            PG8_BAR; PG8_WAIT_L(0); PG8_MMA(0, 1, At, B1); PG8_BAR;
            PG8_LDA(At, 1, 1); PG8_STAGE(PG8_SA(1, 0), a3, voffA);
            PG8_BAR; PG8_WAIT_L(0); PG8_MMA(1, 0, At, B0); PG8_BAR; PG8_SCHED;
            PG8_STAGE(PG8_SB(1, 1), b3 + hstep, voffB);
            PG8_WAIT_V(6); PG8_BAR; PG8_MMA(1, 1, At, B1); PG8_BAR;
            }
        }
        if constexpr (ALIGN_EPI) { if (wr == 0) PG8_BAR; }
        if constexpr (!Epi::AFTER_DRAIN) { E(acc, cur, wr, wc, fr, fq); S.done(cur); }
        if (!has_next) break;
#pragma unroll
        for (int a = 0; a < 2; ++a)
#pragma unroll
            for (int b = 0; b < 2; ++b)
#pragma unroll
                for (int m = 0; m < 4; ++m)
#pragma unroll
                    for (int n = 0; n < 2; ++n) acc[a][b][m][n] = (f32x4){0.f, 0.f, 0.f, 0.f};
        cur = nxt; cA = nA; cB = nB; ++ui;
        if constexpr (ALIGN_EPI) { if (wr == 1) PG8_BAR; }
    }
    PG8_WAIT_V(0);
    if constexpr (!ALIGN_EPI) { if (wr == 0) PG8_BAR; }
    PG8_BAR;
    if constexpr (Epi::AFTER_DRAIN) { E.fused(acc, cur, wr, wc, fr, fq, lds, wid, lane); S.done(cur); }
#undef PG8_SA
#undef PG8_SB
#undef PG8_STAGE
#undef PG8_LDA
#undef PG8_LDB
#undef PG8_MMA
#undef PG8_WAIT_V
#undef PG8_WAIT_L
#undef PG8_BAR
#undef PG8_SCHED
}
}

constexpr int NWAVES = 8;
constexpr int DM = 2048, NB = 16, SEQ = 2048, DB = 128, DS = 4, HD = 64, NH = 16, NKV = 4, CCH = 1024, CW = 31, FF = 8192;
constexpr int MP = NB * SEQ, MS = DB * DS, M = MP + MS;
constexpr int INW = 3584, ZW = 1536;
constexpr float EPS = 1e-6f;
constexpr float QSCALE = 0.125f * 1.4426950408889634f;
constexpr float LOG2E = 1.4426950408889634f;
constexpr size_t O_Y = 0, O_KP = (size_t)M * DM, O_VP = O_KP + (size_t)NB * 128 * 256, O_CP = O_VP + (size_t)NB * 128 * 256,
                 O_KS = O_CP + (size_t)NB * 30 * CCH, O_VS = O_KS + (size_t)DB * 128 * 256, O_CS = O_VS + (size_t)DB * 128 * 256, O_END = O_CS + (size_t)DB * 30 * CCH;
constexpr size_t MiB = 1u << 20;
constexpr size_t WS_CTL = 0, CTL_ZERO_BYTES = 64 * 1024, WS_ZROW = 48 * 1024;
constexpr size_t WS_WIN = 1 * MiB, WS_WOUT = 15 * MiB, WS_WUP = 23 * MiB, WS_WDN = 55 * MiB;
constexpr size_t WS_RSTD1 = 87 * MiB, WS_R2 = 88 * MiB, WS_SSQS = 88 * MiB + 512 * 1024, WS_SSQ = 89 * MiB;
constexpr size_t WS_XB = 94 * MiB;
constexpr size_t WS_Z = 224 * MiB, WS_U = 322 * MiB, WS_MIX = 387 * MiB;
constexpr size_t WS_H = 224 * MiB, WS_END = 744 * MiB;
static_assert(WS_Z + (size_t)M * ZW * 2 <= WS_U && WS_U + (size_t)M * CCH * 2 <= WS_MIX && WS_MIX + (size_t)M * DM * 2 <= WS_END && WS_H + (size_t)M * FF * 2 <= WS_END, "d_ws map");
static_assert(WS_XB + (size_t)M * DM * 2 <= WS_Z && WS_SSQ + (size_t)M * 32 * 4 <= WS_XB && WS_WIN + (size_t)INW * DM * 2 <= WS_WOUT, "d_ws map");
constexpr int CW_BAR = 4096;
constexpr int RING_BYTES = 131072, MISC_OFF = RING_BYTES + 320, LDS_BYTES = 147456;
#define GAS __attribute__((address_space(1)))
#define LAS __attribute__((address_space(3)))
typedef unsigned short bf16;
typedef unsigned v4u __attribute__((ext_vector_type(4)));
typedef float f32x4 __attribute__((ext_vector_type(4)));
typedef short bf16x8 __attribute__((ext_vector_type(8)));
typedef GAS unsigned gu32;
typedef GAS unsigned long long gu64;
#define RLX_AGENT __ATOMIC_RELAXED, __HIP_MEMORY_SCOPE_AGENT
#define LDS_WAIT() asm volatile("s_waitcnt lgkmcnt(0)" ::: "memory")
#define VM_WAIT() asm volatile("s_waitcnt vmcnt(0)" ::: "memory")
__device__ __forceinline__ unsigned long long rt() { return __builtin_amdgcn_s_memrealtime(); }
__device__ __forceinline__ unsigned f2bf(float f) { unsigned u = __builtin_bit_cast(unsigned, f); return (u + 0x7fffu + ((u >> 16) & 1u)) >> 16; }
__device__ __forceinline__ unsigned pk2(float lo, float hi) { return f2bf(lo) | (f2bf(hi) << 16); }

#define XB_TMO      128
#define XB_XCNT(j)  (256  + 64 * (j))
#define XB_XSUB(j)  (1280 + 64 * (j))
#define XB_XGEN(j)  (2304 + 64 * (j))
#define XB_TOP      3328
#define XB_TOPGEN   3392
#define XCD_BAR_WORDS 3456
#define XB_SPIN_CAP (1u << 18)

__device__ __forceinline__ unsigned xb_ld(unsigned* p)              { return __hip_atomic_load(p, __ATOMIC_RELAXED, __HIP_MEMORY_SCOPE_AGENT); }
__device__ __forceinline__ unsigned xb_add(unsigned* p, unsigned v) { return __hip_atomic_fetch_add(p, v, __ATOMIC_RELAXED, __HIP_MEMORY_SCOPE_AGENT); }
__device__ __forceinline__ unsigned xb_xcc_id() { return (unsigned)__builtin_amdgcn_s_getreg((3 << 11) | 20) & 0xFu; }
#define XB_SPIN(cond, bar) do { unsigned _sp = 0; while (cond) { __builtin_amdgcn_s_sleep(1); \
    if ((++_sp & 255u) == 0u) { if (xb_ld(&(bar)[XB_TMO])) break; if (_sp > XB_SPIN_CAP) { atomicAdd(&(bar)[XB_TMO], 1u); break; } } } } while (0)

struct XcdBarrier {
    unsigned* bar; unsigned x;
    volatile LAS unsigned* st;
};

__device__ __forceinline__ XcdBarrier xcd_barrier_post(unsigned* bar, volatile LAS unsigned* st) {
    XcdBarrier b; b.bar = bar; b.x = xb_xcc_id(); b.st = st;
    if (threadIdx.x == 0) (void)xb_add(&bar[XB_XCNT(b.x)], 1u);
    return b;
}
__device__ __forceinline__ void xcd_barrier_complete(unsigned* bar, unsigned x, unsigned& nloc, unsigned& nx) {
    const unsigned G = gridDim.x * gridDim.y * gridDim.z;
    unsigned sum, cnt, mine, sp = 0u;
    for (;;) {
        sum = 0u; cnt = 0u; mine = 0u;
#pragma unroll
        for (unsigned j = 0; j < 16; ++j) { const unsigned c = xb_ld(&bar[XB_XCNT(j)]); sum += c; cnt += (c > 0u) ? 1u : 0u; mine = (j == x) ? c : mine; }
        if (sum == G) break;
        __builtin_amdgcn_s_sleep(1);
        if ((++sp & 255u) == 0u) { if (xb_ld(&bar[XB_TMO])) break; if (sp > XB_SPIN_CAP) { atomicAdd(&bar[XB_TMO], 1u); break; } }
    }
    nloc = mine > 0u ? mine : 1u; nx = cnt > 0u ? cnt : 1u;
}

__device__ __forceinline__ void xcd_barrier(const XcdBarrier& b) {
    asm volatile("s_waitcnt vmcnt(0)" ::: "memory");
    __syncthreads();
    if (threadIdx.x == 0) {
        unsigned* bar = b.bar;
        __builtin_amdgcn_s_waitcnt(0);
        unsigned nloc = b.st[0], nx = b.st[1];
        if (nloc == 0u) { xcd_barrier_complete(bar, b.x, nloc, nx); b.st[0] = nloc; b.st[1] = nx; }
        const unsigned old = xb_add(&bar[XB_XSUB(b.x)], 1u);
        const unsigned gen = old / nloc;
        if (old + 1u == (gen + 1u) * nloc) {
            __builtin_amdgcn_fence(__ATOMIC_RELEASE, "agent");
            asm volatile("s_waitcnt vmcnt(0)" ::: "memory");
            const unsigned og = xb_add(&bar[XB_TOP], 1u);
            const unsigned tg = og / nx;
            if (og + 1u == (tg + 1u) * nx) xb_add(&bar[XB_TOPGEN], 1u);
            else XB_SPIN(xb_ld(&bar[XB_TOPGEN]) == tg, bar);
            __builtin_amdgcn_fence(__ATOMIC_ACQUIRE, "agent");
            xb_add(&bar[XB_XGEN(b.x)], 1u);
            asm volatile("s_waitcnt vmcnt(0)" ::: "memory");
        } else {
            XB_SPIN(xb_ld(&bar[XB_XGEN(b.x)]) == gen, bar);
            __builtin_amdgcn_fence(__ATOMIC_ACQUIRE, "agent");
            asm volatile("s_waitcnt vmcnt(0)" ::: "memory");
        }
    }
    __syncthreads();
}

typedef float f32x2 __attribute__((ext_vector_type(2)));
typedef float f32x16 __attribute__((ext_vector_type(16)));
typedef short s16x4 __attribute__((ext_vector_type(4)));
__device__ __forceinline__ unsigned cvtpk(float lo, float hi) { unsigned r; asm volatile("v_cvt_pk_bf16_f32 %0, %1, %2" : "=v"(r) : "v"(lo), "v"(hi)); return r; }
__device__ __forceinline__ float bf_lo(unsigned u) { return __builtin_bit_cast(float, u << 16); }
__device__ __forceinline__ float bf_hi(unsigned u) { return __builtin_bit_cast(float, u & 0xffff0000u); }
__device__ __forceinline__ void fmac1(float& acc, float a, float b) { asm("v_fmac_f32 %0, %1, %2" : "+v"(acc) : "v"(a), "v"(b)); }
__device__ __forceinline__ float wave_sum(float v) {
#pragma unroll
    for (int o = 1; o < 64; o <<= 1) v += __shfl_xor(v, o);
    return v;
}

struct P0Item { const float* W; const float* gain; bf16* WT; int K, N, rowmap, k0, n0; };
struct P0Mats { const float *w_in, *g_in, *w_out, *w_up, *g_up, *w_dn; bf16 *Wi, *Wo, *Wu, *Wd; };
constexpr int P0_I_IN = (DM / 64) * (INW / 32), P0_I_OUT = (DM / 64) * (DM / 32), P0_I_UP = (DM / 64) * (FF / 32), P0_I_DN = (FF / 64) * (DM / 32), P0_NITEMS = P0_I_IN + P0_I_OUT + P0_I_UP + P0_I_DN;
__device__ __forceinline__ P0Item p0_item(const P0Mats& Mx, int it) {
    P0Item I; int r = it;
    if (r < P0_I_IN) { I.W = Mx.w_in; I.gain = Mx.g_in; I.WT = Mx.Wi; I.K = DM; I.N = INW; I.rowmap = 1; }
    else if ((r -= P0_I_IN) < P0_I_OUT) { I.W = Mx.w_out; I.gain = nullptr; I.WT = Mx.Wo; I.K = DM; I.N = DM; I.rowmap = 0; }
    else if ((r -= P0_I_OUT) < P0_I_UP) { I.W = Mx.w_up; I.gain = Mx.g_up; I.WT = Mx.Wu; I.K = DM; I.N = FF; I.rowmap = 0; }
    else { r -= P0_I_UP; I.W = Mx.w_dn; I.gain = nullptr; I.WT = Mx.Wd; I.K = FF; I.N = DM; I.rowmap = 0; }
    const int nblk = I.N / 32; I.k0 = 64 * (r / nblk); I.n0 = 32 * (r % nblk); return I;
}
__device__ __forceinline__ void p0_item_issue(const P0Item& I, int lane, f32x4 (&v)[8], float (&g)[8]) {
    const int kr = lane >> 3, nc = lane & 7;
#pragma unroll
    for (int j = 0; j < 8; ++j) { v[j] = *(const f32x4*)(I.W + (size_t)(I.k0 + 8 * j + kr) * I.N + I.n0 + 4 * nc); g[j] = I.gain ? I.gain[I.k0 + 8 * j + kr] : 1.0f; }
}
__device__ __forceinline__ void p0_weights(const P0Mats& Mx, LAS float* scr, int gw, int NGW, int lane_, int lo, int hi) {
    int lane = lane_; asm volatile("" : "+v"(lane));
    f32x4 v[8]; float g[8];
    int it = lo + gw;
    P0Item I = p0_item(Mx, it < hi ? it : lo);
    if (it < hi) p0_item_issue(I, lane, v, g);
#pragma unroll 1
    for (; it < hi; it += NGW) {
        {   const int kr = lane >> 3, nc = lane & 7;
#pragma unroll
            for (int j = 0; j < 8; ++j) { LAS float* d = scr + (8 * j + kr) * 33 + 4 * nc; d[0] = v[j].x * g[j]; d[1] = v[j].y * g[j]; d[2] = v[j].z * g[j]; d[3] = v[j].w * g[j]; } }
        const P0Item C = I;
        if (it + NGW < hi) { I = p0_item(Mx, it + NGW); p0_item_issue(I, lane, v, g); }
        __builtin_amdgcn_sched_barrier(0);
        LDS_WAIT(); asm volatile("" ::: "memory");
        int nd0 = C.n0;
        if (C.rowmap == 1 && C.n0 >= ZW) { int c = C.n0 - ZW; if (c < CCH) nd0 = ZW + 256 * (c >> 7) + (c & 127); else { c -= CCH; nd0 = ZW + 256 * (c >> 7) + 128 + (c & 127); } }
        const int c = lane & 7;
#pragma unroll
        for (int j = 0; j < 4; ++j) { const int n = (lane >> 3) + 8 * j; const LAS float* s = scr + (8 * c) * 33 + n;
            v4u o; o.x = pk2(s[0 * 33], s[1 * 33]); o.y = pk2(s[2 * 33], s[3 * 33]); o.z = pk2(s[4 * 33], s[5 * 33]); o.w = pk2(s[6 * 33], s[7 * 33]);
            *(GAS v4u*)(C.WT + (size_t)(nd0 + n) * C.K + C.k0 + 8 * c) = o; }
        LDS_WAIT(); asm volatile("" ::: "memory");
    }
}
__device__ __forceinline__ void p0_xrows(const float* xp, const float* xs, bf16* XB, float* rstd1, int gw, int NGW, int lane) {
    f32x4 v[8];
    int m = gw;
    if (m < M) { const GAS f32x4* xr = (const GAS f32x4*)((m < MP) ? xp + (size_t)m * DM : xs + (size_t)(m - MP) * DM) + lane;
#pragma unroll
        for (int j = 0; j < 8; ++j) v[j] = xr[64 * j]; }
#pragma unroll 1
    for (; m < M; m += NGW) {
        float s = 0.f; unsigned long long pk[8];
#pragma unroll
        for (int j = 0; j < 8; ++j) { s += (v[j].x * v[j].x + v[j].y * v[j].y) + (v[j].z * v[j].z + v[j].w * v[j].w); pk[j] = (unsigned long long)cvtpk(v[j].x, v[j].y) | ((unsigned long long)cvtpk(v[j].z, v[j].w) << 32); }
        const int mn = m + NGW;
        if (mn < M) { const GAS f32x4* xr = (const GAS f32x4*)((mn < MP) ? xp + (size_t)mn * DM : xs + (size_t)(mn - MP) * DM) + lane;
#pragma unroll
            for (int j = 0; j < 8; ++j) v[j] = xr[64 * j]; }
        __builtin_amdgcn_sched_barrier(0);
        s = wave_sum(s);
        if (lane == 0) rstd1[m] = 1.0f / sqrtf(s * (1.0f / DM) + EPS);
        GAS unsigned long long* o8 = (GAS unsigned long long*)(XB + (size_t)m * DM) + lane;
#pragma unroll
        for (int j = 0; j < 8; ++j) o8[64 * j] = pk[j];
    }
}

constexpr int KV_RS = 144;
__device__ __forceinline__ int crow(int r, int hi) { return (r & 3) + 8 * (r >> 2) + 4 * hi; }
__device__ __forceinline__ s16x4 vtr(const LAS unsigned char* p) { return __builtin_bit_cast(s16x4, __builtin_amdgcn_ds_read_tr16_b64_v4i16((LAS s16x4*)p)); }

__device__ __forceinline__ void q_issue(const bf16* qrow, int h, v4u (&raw)[4]) {
#pragma unroll
    for (int d0 = 0; d0 < 4; ++d0) raw[d0] = *(const v4u*)(qrow + 16 * d0 + 8 * h);
}
__device__ __forceinline__ void q_finish(const v4u (&raw)[4], int h, const LAS float* gq, bf16x8 (&qf)[4]) {
    float v[4][8]; float ss = 0.f;
#pragma unroll
    for (int d0 = 0; d0 < 4; ++d0)
#pragma unroll
        for (int e = 0; e < 4; ++e) { v[d0][2 * e] = bf_lo(raw[d0][e]); v[d0][2 * e + 1] = bf_hi(raw[d0][e]); ss += v[d0][2 * e] * v[d0][2 * e] + v[d0][2 * e + 1] * v[d0][2 * e + 1]; }
    ss += __shfl_xor(ss, 32);
    const float rs = __builtin_amdgcn_rsqf(ss * (1.0f / HD) + EPS) * QSCALE;
#pragma unroll
    for (int d0 = 0; d0 < 4; ++d0) { const f32x4 g0 = *(const LAS f32x4*)(gq + 16 * d0 + 8 * h), g1 = *(const LAS f32x4*)(gq + 16 * d0 + 8 * h + 4);
        v4u w; w.x = cvtpk(v[d0][0] * rs * g0[0], v[d0][1] * rs * g0[1]); w.y = cvtpk(v[d0][2] * rs * g0[2], v[d0][3] * rs * g0[3]);
        w.z = cvtpk(v[d0][4] * rs * g1[0], v[d0][5] * rs * g1[1]); w.w = cvtpk(v[d0][6] * rs * g1[2], v[d0][7] * rs * g1[3]);
        qf[d0] = __builtin_bit_cast(bf16x8, w); }
}
__device__ __forceinline__ void attn_core(const LAS unsigned char* Kt, const LAS unsigned char* Vt, int tt0, int qrel, int kvmin, const bf16x8 (&qf)[4], float sink2, float cshift, int lane, f32x16 (&o)[2]) {
    const int r32 = lane & 31, h = lane >> 5;
    f32x16 s[5];
#pragma unroll
    for (int i = 0; i < 5; ++i) {
        const LAS unsigned char* kp = Kt + (32 * (tt0 + i) + r32) * KV_RS + h * 16;
        const float nc = -cshift; f32x16 a = {nc, nc, nc, nc, nc, nc, nc, nc, nc, nc, nc, nc, nc, nc, nc, nc};
#pragma unroll
        for (int d0 = 0; d0 < 4; ++d0) { const bf16x8 kf = *(const LAS bf16x8*)(kp + 32 * d0); a = __builtin_amdgcn_mfma_f32_32x32x16_bf16(kf, qf[d0], a, 0, 0, 0); }
        s[i] = a;
    }
    const int qloc = qrel - 32 * tt0, ndead = (kvmin >> 5) - tt0;
    float ls = 0.f;
#pragma unroll
    for (int i = 0; i < 5; ++i)
#pragma unroll
        for (int r = 0; r < 16; ++r) { const int cr = (r & 3) + 8 * (r >> 2); bool ok = (i >= ndead);
            if (i == 0) ok = ok && (cr + 4 * h > qloc);
            if (i == 4) ok = ok && (cr + 4 * h <= qloc);
            const float p = ok ? __builtin_amdgcn_exp2f(s[i][r]) : 0.f; s[i][r] = p; ls += p; }
    ls += __shfl_xor(ls, 32);
    const float inv = __builtin_amdgcn_rcpf(ls + __builtin_amdgcn_exp2f(sink2 - cshift));
    o[0] = (f32x16){0.f, 0.f, 0.f, 0.f, 0.f, 0.f, 0.f, 0.f, 0.f, 0.f, 0.f, 0.f, 0.f, 0.f, 0.f, 0.f}; o[1] = o[0];
    const LAS unsigned char* vb = Vt + (4 * h + ((lane & 15) >> 2)) * KV_RS + ((lane >> 4) & 1) * 32 + (lane & 3) * 8;
#pragma unroll
    for (int i = 0; i < 5; ++i)
#pragma unroll
        for (int st = 0; st < 2; ++st) {
            v4u pw; pw.x = cvtpk(s[i][8 * st + 0], s[i][8 * st + 1]); pw.y = cvtpk(s[i][8 * st + 2], s[i][8 * st + 3]); pw.z = cvtpk(s[i][8 * st + 4], s[i][8 * st + 5]); pw.w = cvtpk(s[i][8 * st + 6], s[i][8 * st + 7]);
            const bf16x8 pf = __builtin_bit_cast(bf16x8, pw);
#pragma unroll
            for (int dt = 0; dt < 2; ++dt) {
                const LAS unsigned char* vp = vb + (32 * (tt0 + i) + 16 * st) * KV_RS + dt * 64;
                const s16x4 lo = vtr(vp), hi = vtr(vp + 8 * KV_RS);
                const bf16x8 vf = (bf16x8){lo[0], lo[1], lo[2], lo[3], hi[0], hi[1], hi[2], hi[3]};
                o[dt] = __builtin_amdgcn_mfma_f32_32x32x16_bf16(vf, pf, o[dt], 0, 0, 0);
            }
        }
#pragma unroll
    for (int dt = 0; dt < 2; ++dt)
#pragma unroll
        for (int r = 0; r < 16; ++r) o[dt][r] *= inv;
}
__device__ __forceinline__ void store_o(bf16* orow, int h, const f32x16 (&o)[2]) {
#pragma unroll
    for (int dt = 0; dt < 2; ++dt)
#pragma unroll
        for (int pr = 0; pr < 2; ++pr) {
            const int ge = 2 * pr, go = 2 * pr + 1;
            const unsigned e0 = cvtpk(o[dt][4 * ge], o[dt][4 * ge + 1]), e1 = cvtpk(o[dt][4 * ge + 2], o[dt][4 * ge + 3]);
            const unsigned o0 = cvtpk(o[dt][4 * go], o[dt][4 * go + 1]), o1 = cvtpk(o[dt][4 * go + 2], o[dt][4 * go + 3]);
            const auto r0 = __builtin_amdgcn_permlane32_swap(e0, o0, false, false), r1 = __builtin_amdgcn_permlane32_swap(e1, o1, false, false);
            const v4u w = (v4u){r0[0], r1[0], r0[1], r1[1]};
            *(v4u*)(orow + 32 * dt + 8 * (2 * pr + h)) = w; }
}
__device__ __forceinline__ void knorm32(const v4u (&raw)[4], const LAS float* gk32, float (&kf)[32]) {
    float ss = 0.f;
#pragma unroll
    for (int i = 0; i < 4; ++i)
#pragma unroll
        for (int e = 0; e < 4; ++e) { kf[8 * i + 2 * e] = bf_lo(raw[i][e]); kf[8 * i + 2 * e + 1] = bf_hi(raw[i][e]); ss += kf[8 * i + 2 * e] * kf[8 * i + 2 * e] + kf[8 * i + 2 * e + 1] * kf[8 * i + 2 * e + 1]; }
    ss += __shfl_xor(ss, 1);
    const float rs = __builtin_amdgcn_rsqf(ss * (1.0f / HD) + EPS);
#pragma unroll
    for (int i = 0; i < 8; ++i) { const f32x4 g = *(const LAS f32x4*)(gk32 + 4 * i);
#pragma unroll
        for (int e = 0; e < 4; ++e) kf[4 * i + e] = kf[4 * i + e] * rs * g[e]; }
}
__device__ __forceinline__ void lds_put32(LAS unsigned char* dst, const float (&f)[32]) {
#pragma unroll
    for (int i = 0; i < 4; ++i) { v4u w; w.x = cvtpk(f[8 * i], f[8 * i + 1]); w.y = cvtpk(f[8 * i + 2], f[8 * i + 3]); w.z = cvtpk(f[8 * i + 4], f[8 * i + 5]); w.w = cvtpk(f[8 * i + 6], f[8 * i + 7]); *(LAS v4u*)(dst + 16 * i) = w; }
}
__device__ __forceinline__ void glb_put32(float* dst, const float (&f)[32]) {
#pragma unroll
    for (int i = 0; i < 8; ++i) *(f32x4*)(dst + 4 * i) = (f32x4){f[4 * i], f[4 * i + 1], f[4 * i + 2], f[4 * i + 3]};
}

struct P2Args { const bf16* Z; const bf16* U; bf16* MIX; const float *ck, *cv, *sc, *gq, *gk, *sinks, *wdw, *bdw, *gln, *bln; float* out; const bf16* zrow; };

__device__ __forceinline__ void kv_issue(const P2Args& A, int au, int tid, v4u (&kr)[4], v4u (&vr)[4]) {
    const int b = au >> 6, qb = (au >> 2) & 15, hk = au & 3, r = tid >> 1, half = tid & 1, t = 128 * (qb - 1) + r, tc = t < 0 ? 0 : t;
    const bf16* zr = A.Z + (size_t)(b * SEQ + tc) * ZW + hk * HD + half * 32;
#pragma unroll
    for (int i = 0; i < 4; ++i) { kr[i] = *(const v4u*)(zr + 1024 + 8 * i); vr[i] = *(const v4u*)(zr + 1280 + 8 * i); }
}
__device__ __forceinline__ void attn_prompt_all(const P2Args& A, LAS unsigned char* lds, const LAS float* gq, const LAS float* gk, int bx, int G, int tid, int lane, int wave) {
    LAS unsigned char* Kt = lds; LAS unsigned char* Vt = lds + 49152;
    constexpr int NU = NB * 16 * NKV;
    const int r32 = lane & 31, h = lane >> 5;
    v4u kr[4], vr[4];
    int au = bx;
    if (au < NU) kv_issue(A, au, tid, kr, vr);
#pragma unroll 1
    for (; au < NU; au += G) {
        const int b = au >> 6, qb = (au >> 2) & 15, hk = au & 3;
        v4u qcur[4];
        { const int wu = wave * 2, g = wu >> 2, q0 = (wu & 3) * 32, head = hk * 4 + g; const size_t row = (size_t)b * SEQ + 128 * qb + q0 + r32; q_issue(A.Z + row * ZW + head * HD, h, qcur); }
        {   const int r = tid >> 1, half = tid & 1, t = 128 * (qb - 1) + r;
            if (t < 0) {
#pragma unroll
                for (int i = 0; i < 4; ++i) { kr[i] = (v4u){0u, 0u, 0u, 0u}; vr[i] = (v4u){0u, 0u, 0u, 0u}; } }
            float kf[32]; knorm32(kr, gk + half * 32, kf);
            lds_put32(Kt + r * KV_RS + half * 64, kf);
#pragma unroll
            for (int i = 0; i < 4; ++i) *(LAS v4u*)(Vt + r * KV_RS + half * 64 + 16 * i) = vr[i];
            if (qb == 15 && r >= 128) {
                const size_t oo = ((size_t)(b * 128 + (r - 128)) * NKV + hk) * HD + half * 32;
                glb_put32(A.out + O_KP + oo, kf);
                float vf[32];
#pragma unroll
                for (int i = 0; i < 4; ++i)
#pragma unroll
                    for (int e = 0; e < 4; ++e) { vf[8 * i + 2 * e] = bf_lo(vr[i][e]); vf[8 * i + 2 * e + 1] = bf_hi(vr[i][e]); }
                glb_put32(A.out + O_VP + oo, vf);
            }
        }
        __syncthreads();
#pragma unroll 1
        for (int w2 = 0; w2 < 2; ++w2) {
            const int wu = wave * 2 + w2, g = wu >> 2, q0 = (wu & 3) * 32, head = hk * 4 + g; const size_t row = (size_t)b * SEQ + 128 * qb + q0 + r32;
            v4u qnext[4];
            if (w2 == 0) q_issue(A.Z + (row + 32) * ZW + (hk * 4 + ((wu + 1) >> 2)) * HD, h, qnext);
            else {
#pragma unroll
                for (int i = 0; i < 4; ++i) qnext[i] = qcur[i]; }
            bf16x8 qf[4]; q_finish(qcur, h, gq, qf);
            if (w2 == 0 && au + G < NU) kv_issue(A, au + G, tid, kr, vr);
            f32x16 o[2];
            attn_core(Kt, Vt, q0 >> 5, q0 + r32, qb == 0 ? 128 : 0, qf, A.sinks[head] * LOG2E, gq[128], lane, o);
            store_o(A.MIX + row * DM + head * HD, h, o);
#pragma unroll
            for (int i = 0; i < 4; ++i) qcur[i] = qnext[i];
        }
        __syncthreads();
    }
}
__device__ __forceinline__ void attn_sample_unit(const P2Args& A, LAS unsigned char* lds, const LAS float* gq, const LAS float* gk, int b, int hp, int tid, int lane, int wave) {
    LAS unsigned char* Kt = lds; LAS unsigned char* Vt = lds + 49152;
#pragma unroll 1
    for (int it = 0; it < 2; ++it) {
        const int task = tid + it * 512;
        if (task < 640) {
            const int hl = task / 320, rem = task % 320, r = rem >> 1, half = rem & 1, hk = 2 * hp + hl;
            LAS unsigned char* kd = Kt + hl * (160 * KV_RS) + r * KV_RS + half * 64; LAS unsigned char* vd = Vt + hl * (160 * KV_RS) + r * KV_RS + half * 64;
            float kf[32], vf[32];
            if (r < 128) {
                const size_t io = ((size_t)(b * 128 + r) * NKV + hk) * HD + half * 32;
#pragma unroll
                for (int i = 0; i < 8; ++i) { const f32x4 a = *(const f32x4*)(A.ck + io + 4 * i), c = *(const f32x4*)(A.cv + io + 4 * i);
                    kf[4 * i] = a[0]; kf[4 * i + 1] = a[1]; kf[4 * i + 2] = a[2]; kf[4 * i + 3] = a[3]; vf[4 * i] = c[0]; vf[4 * i + 1] = c[1]; vf[4 * i + 2] = c[2]; vf[4 * i + 3] = c[3]; }
                if (r >= 4) { const size_t oo = ((size_t)(b * 128 + r - 4) * NKV + hk) * HD + half * 32; glb_put32(A.out + O_KS + oo, kf); glb_put32(A.out + O_VS + oo, vf); }
            } else if (r < 132) {
                const bf16* zr = A.Z + (size_t)(MP + b * DS + (r - 128)) * ZW + hk * HD + half * 32;
                v4u kr[4], vr[4];
#pragma unroll
                for (int i = 0; i < 4; ++i) { kr[i] = *(const v4u*)(zr + 1024 + 8 * i); vr[i] = *(const v4u*)(zr + 1280 + 8 * i); }
                knorm32(kr, gk + half * 32, kf);
#pragma unroll
                for (int i = 0; i < 4; ++i)
#pragma unroll
                    for (int e = 0; e < 4; ++e) { vf[8 * i + 2 * e] = bf_lo(vr[i][e]); vf[8 * i + 2 * e + 1] = bf_hi(vr[i][e]); }
                const size_t oo = ((size_t)(b * 128 + r - 4) * NKV + hk) * HD + half * 32; glb_put32(A.out + O_KS + oo, kf); glb_put32(A.out + O_VS + oo, vf);
            } else {
#pragma unroll
                for (int i = 0; i < 32; ++i) { kf[i] = 0.f; vf[i] = 0.f; }
            }
            lds_put32(kd, kf); lds_put32(vd, vf);
        }
    }
    __syncthreads();
    if (wave < 2) {
        const int hk = 2 * hp + wave, r32 = lane & 31, h = lane >> 5, g = (r32 >> 2) & 3, i = r32 & 3, head = hk * 4 + g;
        const size_t row = (size_t)MP + b * DS + i;
        v4u qraw[4]; q_issue(A.Z + row * ZW + head * HD, h, qraw);
        bf16x8 qf[4]; q_finish(qraw, h, gq, qf);
        f32x16 o[2];
        attn_core(Kt + wave * (160 * KV_RS), Vt + wave * (160 * KV_RS), 0, i, 0, qf, A.sinks[head] * LOG2E, gq[128], lane, o);
        if (r32 < 16) store_o(A.MIX + row * DM + head * HD, h, o);
    }
    __syncthreads();
}

template <int TT>
__device__ __forceinline__ void conv_ln_store(f32x2 (&acc)[TT], f32x2 bdw, f32x2 gln, f32x2 bln, LAS float* red, LAS float* fin, bf16* mixrow0  , int tid) {
#pragma unroll
    for (int tt = 0; tt < TT; ++tt) { const f32x2 y = acc[tt] + bdw; acc[tt] = y; red[(2 * tt) * 512 + tid] = y.x + y.y; red[(2 * tt + 1) * 512 + tid] = y.x * y.x + y.y * y.y; }
    __syncthreads();
    {   constexpr int NV = 2 * TT, PER = 512 / NV;
        const int v = tid / PER, p = tid % PER; float s = 0.f;
#pragma unroll
        for (int k = 0; k < NV; ++k) s += red[v * 512 + k * PER + p];
#pragma unroll
        for (int o = 1; o < PER; o <<= 1) s += __shfl_xor(s, o);
        if constexpr (PER == 16) {
            const float q = __shfl_xor(s, 16);
            if ((tid & 31) == 0) { const float mean = s * (1.0f / CCH), var = q * (1.0f / CCH) - mean * mean; *(LAS f32x2*)(fin + 2 * (tid >> 5)) = (f32x2){mean, __builtin_amdgcn_rsqf(var + EPS)}; }
        } else { if (p == 0) fin[v] = s; } }
    __syncthreads();
#pragma unroll
    for (int tt = 0; tt < TT; ++tt) {
        f32x2 mr = *(const LAS f32x2*)(fin + 2 * tt);
        if constexpr (512 / (2 * TT) != 16) { const float mean = mr.x * (1.0f / CCH), var = mr.y * (1.0f / CCH) - mean * mean; mr = (f32x2){mean, __builtin_amdgcn_rsqf(var + EPS)}; }
        const f32x2 val = (acc[tt] - mr.x) * (gln * mr.y) + bln;
        const float o0 = val.x * __builtin_amdgcn_rcpf(1.0f + __expf(-val.x)), o1 = val.y * __builtin_amdgcn_rcpf(1.0f + __expf(-val.y));
        *(unsigned*)(mixrow0 + (size_t)tt * DM) = cvtpk(o0, o1);
    }
}
constexpr int CTT = 16;
__device__ __forceinline__ void conv_issue(const P2Args& A, int cu, int tid, unsigned (&raw)[CTT + 30]) {
    const int b = cu >> 7, t0 = (cu & 127) * CTT;
#pragma unroll
    for (int rr = 0; rr < CTT + 30; ++rr) { const int t = t0 - 30 + rr;
        const char* rowp = (t >= 0) ? (const char*)(A.U + (size_t)(b * SEQ + t) * CCH) : (const char*)A.zrow;
        raw[rr] = *(const unsigned*)(rowp + (unsigned)(4 * tid)); }
}
__device__ __forceinline__ void conv_prompt_all(const P2Args& A, LAS unsigned char* lds, const f32x2 (&w)[CW], f32x2 bdw, f32x2 gln, f32x2 bln, int first, int G, int NU, int tid) {
    LAS float* red = (LAS float*)lds; LAS float* fin = (LAS float*)(lds + 65536);
    const int c = 2 * tid;
    unsigned raw[CTT + 30];
    int cu = first;
    if (cu < NU) conv_issue(A, cu, tid, raw);
#pragma unroll 1
    for (; cu < NU; cu += G) {
        const int b = cu >> 7, t0 = (cu & 127) * CTT;
        f32x2 acc[CTT];
#pragma unroll
        for (int tt = 0; tt < CTT; ++tt) acc[tt] = (f32x2){0.f, 0.f};
#pragma unroll
        for (int rr = 0; rr < CTT + 30; ++rr) {
            const f32x2 u2 = (f32x2){bf_lo(raw[rr]), bf_hi(raw[rr])};
#pragma unroll
            for (int tt = 0; tt < CTT; ++tt) { const int j = rr - tt; if (j >= 0 && j < CW) acc[tt] += w[j] * u2; }
        }
        if (t0 + CTT > SEQ - 30) {
#pragma unroll
            for (int rr = 30; rr < CTT + 30; ++rr) { const int t = t0 - 30 + rr; if (t >= SEQ - 30) *(f32x2*)(A.out + O_CP + ((size_t)b * 30 + t - (SEQ - 30)) * CCH + c) = (f32x2){bf_lo(raw[rr]), bf_hi(raw[rr])}; }
        }
        if (cu + G < NU) conv_issue(A, cu + G, tid, raw);
        conv_ln_store<CTT>(acc, bdw, gln, bln, red, fin, A.MIX + (size_t)(b * SEQ + t0) * DM + 1024 + c, tid);
    }
}
__device__ __forceinline__ void conv_sample_unit(const P2Args& A, LAS unsigned char* lds, int b, const f32x2 (&w)[CW], f32x2 bdw, f32x2 gln, f32x2 bln, int tid) {
    LAS float* red = (LAS float*)lds; LAS float* fin = (LAS float*)(lds + 65536);
    const int c = 2 * tid;
    f32x2 ue[30 + DS];
#pragma unroll
    for (int rr = 0; rr < 30; ++rr) ue[rr] = *(const f32x2*)(A.sc + ((size_t)b * 30 + rr) * CCH + c);
#pragma unroll
    for (int rr = 0; rr < DS; ++rr) { const unsigned raw = *(const unsigned*)(A.U + (size_t)(MP + b * DS + rr) * CCH + c); ue[30 + rr] = (f32x2){bf_lo(raw), bf_hi(raw)}; }
    f32x2 acc[DS];
#pragma unroll
    for (int tt = 0; tt < DS; ++tt) acc[tt] = (f32x2){0.f, 0.f};
#pragma unroll
    for (int rr = 0; rr < DS + 30; ++rr)
#pragma unroll
        for (int tt = 0; tt < DS; ++tt) { const int j = rr - tt; if (j >= 0 && j < CW) acc[tt] += w[j] * ue[rr]; }
#pragma unroll
    for (int rr = DS; rr < 30 + DS; ++rr) *(f32x2*)(A.out + O_CS + ((size_t)b * 30 + rr - DS) * CCH + c) = ue[rr];
    conv_ln_store<DS>(acc, bdw, gln, bln, red, fin, A.MIX + (size_t)(MP + b * DS) * DM + 1024 + c, tid);
}

__device__ __forceinline__ void run_p2(const P2Args& A, LAS unsigned char* lds, int bx, int G, int tid, int lane, int wave) {
    LAS float* gq = (LAS float*)(lds + 98304); LAS float* gk = gq + 64;
    if (tid < 64) { const float a = A.gq[tid], b = A.gk[tid]; gq[tid] = a; gk[tid] = b;
        float ma = fabsf(a), mb = fabsf(b);
#pragma unroll
        for (int o = 1; o < 64; o <<= 1) { ma = fmaxf(ma, __shfl_xor(ma, o)); mb = fmaxf(mb, __shfl_xor(mb, o)); }
        if (tid == 0) gq[128] = fmaxf(0.f, QSCALE * 64.0f * ma * mb - 64.0f); }
    __syncthreads();
    attn_prompt_all(A, lds, gq, gk, bx, G, tid, lane, wave);
#if PROBE == 4
    attn_prompt_all(A, lds, gq, gk, bx, G, tid, lane, wave);
#endif
    for (int su = bx; su < DB * 2; su += G) attn_sample_unit(A, lds, gq, gk, su >> 1, su & 1, tid, lane, wave);
#if PROBE == 6
    for (int su = bx; su < DB * 2; su += G) attn_sample_unit(A, lds, gq, gk, su >> 1, su & 1, tid, lane, wave);
#endif
    f32x2 w[CW];
#pragma unroll
    for (int j = 0; j < CW; ++j) w[j] = *(const f32x2*)(A.wdw + j * CCH + 2 * tid);
    const f32x2 bdw = *(const f32x2*)(A.bdw + 2 * tid), gln = *(const f32x2*)(A.gln + 2 * tid), bln = *(const f32x2*)(A.bln + 2 * tid);
    conv_prompt_all(A, lds, w, bdw, gln, bln, bx, G, MP / CTT, tid);
#if PROBE == 5
    conv_prompt_all(A, lds, w, bdw, gln, bln, bx, G, MP / CTT, tid);
#endif
    for (int cu = bx; cu < DB; cu += G) conv_sample_unit(A, lds, cu, w, bdw, gln, bln, tid);
#if PROBE == 6
    for (int cu = bx; cu < DB; cu += G) conv_sample_unit(A, lds, cu, w, bdw, gln, bln, tid);
#endif
}

template <int MODE> struct SEpi;
struct SgPtrs { bf16* Z; bf16* U; const float* rstd1; const float* xs; float* out; bf16* XB; float* ssqs; bf16* H; const float* r2; };
__device__ __forceinline__ void sg_store_bf16(bf16* p, float x) { *p = (bf16)f2bf(x); }
template <int MODE>
__device__ __forceinline__ void sg_epilogue(const SgPtrs& P, const float (&v)[2][4], int rs0  , int nblk  , int r) {
#pragma unroll
    for (int e = 0; e < 4; ++e) {
        const int rs = rs0 + e; const size_t row = (size_t)MP + rs;
        if (MODE == 0) { const float s = P.rstd1[row];
#pragma unroll
            for (int cb = 0; cb < 2; ++cb) sg_store_bf16(P.Z + row * ZW + 64 * nblk + 32 * cb + r, v[cb][e] * s); }
        if (MODE == 1) { const float s = P.rstd1[row]; const float a = v[0][e] * s, g = v[1][e] * s; sg_store_bf16(P.U + row * CCH + 32 * nblk + r, a * __builtin_amdgcn_rcpf(1.0f + __expf(-g))); }
        if (MODE == 2) {
#pragma unroll
            for (int cb = 0; cb < 2; ++cb) { const int col = 64 * nblk + 32 * cb + r; const float x1 = P.xs[(size_t)rs * DM + col] + v[cb][e];
                P.out[row * DM + col] = x1; sg_store_bf16(P.XB + row * DM + col, x1);
                float q = x1 * x1;
#pragma unroll
                for (int o = 1; o < 32; o <<= 1) q += __shfl_xor(q, o);
                if (r == 0) P.ssqs[(size_t)rs * 64 + 2 * nblk + cb] = q; } }
        if (MODE == 3) {
#pragma unroll
            for (int cb = 0; cb < 2; ++cb) { const float a = fmaxf(v[cb][e], 0.f); sg_store_bf16(P.H + row * FF + 64 * nblk + 32 * cb + r, a * a); } }
        if (MODE == 4) { const float s = P.r2[row];
#pragma unroll
            for (int cb = 0; cb < 2; ++cb) { float* o = P.out + row * DM + 64 * nblk + 32 * cb + r; *o = *o + s * v[cb][e]; } }
    }
}
#define SG_MMA(a0, a1, b0, b1) do { _Pragma("unroll") for (int j_ = 0; j_ < 4; ++j_) { \
        acc[0][0] = __builtin_amdgcn_mfma_f32_32x32x16_bf16(a0[j_], b0[j_], acc[0][0], 0, 0, 0); \
        acc[0][1] = __builtin_amdgcn_mfma_f32_32x32x16_bf16(a0[j_], b1[j_], acc[0][1], 0, 0, 0); \
        acc[1][0] = __builtin_amdgcn_mfma_f32_32x32x16_bf16(a1[j_], b0[j_], acc[1][0], 0, 0, 0); \
        acc[1][1] = __builtin_amdgcn_mfma_f32_32x32x16_bf16(a1[j_], b1[j_], acc[1][1], 0, 0, 0); } } while (0)
template <int MODE>
__device__ __forceinline__ void sgemm_tile(LAS unsigned char* lds, const SgPtrs& P, const bf16* A0  , const bf16* Bb0, const bf16* Bb1, int K, int mi, int nblk, int lane_, int wave) {
    int lane = lane_; asm volatile("" : "+v"(lane));
    const int r = lane & 31, h = lane >> 5, kw = K >> 3, ns = kw >> 6, lr = lane >> 3, lc = lane & 7;
    const unsigned goff = (unsigned)(lr * K + wave * kw) * 2u + (unsigned)lc * 16u, gp = (unsigned)(8 * K) * 2u;
    LAS unsigned char* wb = lds + wave * 16384;
    const int wofs0 = lr * 128 + ((lc ^ lr) * 16), wofs1 = lr * 128 + ((lc ^ lr ^ 1) * 16);
    const int rm = (r & 7) ^ ((r >> 3) & 1);
    __syncthreads();
    f32x16 acc[2][2];
#pragma unroll
    for (int i = 0; i < 2; ++i)
#pragma unroll
        for (int j = 0; j < 2; ++j) acc[i][j] = (f32x16){0.f, 0.f, 0.f, 0.f, 0.f, 0.f, 0.f, 0.f, 0.f, 0.f, 0.f, 0.f, 0.f, 0.f, 0.f, 0.f};
    v4u g[4][4];
#define SG_ISSUE(kb) do { _Pragma("unroll") for (int p_ = 0; p_ < 4; ++p_) { \
        g[0][p_] = *(const v4u*)((const char*)A0 + (goff + p_ * gp + (kb))); g[1][p_] = *(const v4u*)((const char*)A0 + (goff + (p_ + 4) * gp + (kb))); \
        g[2][p_] = *(const v4u*)((const char*)Bb0 + (goff + p_ * gp + (kb))); g[3][p_] = *(const v4u*)((const char*)Bb1 + (goff + p_ * gp + (kb))); } } while (0)
#define SG_WRITE() do { _Pragma("unroll") for (int b_ = 0; b_ < 4; ++b_) _Pragma("unroll") for (int p_ = 0; p_ < 4; ++p_) \
        *(LAS v4u*)(wb + b_ * 4096 + p_ * 1024 + ((p_ & 1) ? wofs1 : wofs0)) = g[b_][p_]; } while (0)
    SG_ISSUE(0u);
    SG_WRITE();
#pragma unroll 1
    for (int s = 0; s < ns; ++s) {
        const bool more = (s + 1 < ns);
        if (more) SG_ISSUE(128u * (unsigned)(s + 1));
        __builtin_amdgcn_sched_barrier(0);
        bf16x8 a0[4], a1[4], b0[4], b1[4];
#pragma unroll
        for (int j = 0; j < 4; ++j) { const int co = r * 128 + (((2 * j + h) ^ rm) * 16);
            a0[j] = *(const LAS bf16x8*)(wb + co); a1[j] = *(const LAS bf16x8*)(wb + 4096 + co); b0[j] = *(const LAS bf16x8*)(wb + 8192 + co); b1[j] = *(const LAS bf16x8*)(wb + 12288 + co); }
        SG_MMA(a0, a1, b0, b1);
        __builtin_amdgcn_sched_barrier(0);
        if (more) SG_WRITE();
    }
#undef SG_ISSUE
#undef SG_WRITE
    LAS float* red = (LAS float*)lds;
    __syncthreads();
#pragma unroll
    for (int rb = 0; rb < 2; ++rb)
#pragma unroll
        for (int cb = 0; cb < 2; ++cb)
#pragma unroll
            for (int g2 = 0; g2 < 16; ++g2) red[(wave * 64 + rb * 32 + cb * 16 + g2) * 64 + lane] = acc[rb][cb][g2];
    __syncthreads();
    const int rb = wave >> 2, q = wave & 3;
    float v[2][4];
#pragma unroll
    for (int cb = 0; cb < 2; ++cb)
#pragma unroll
        for (int e2 = 0; e2 < 4; ++e2) { float sm = 0.f;
#pragma unroll
            for (int ww = 0; ww < 8; ++ww) sm += red[(ww * 64 + rb * 32 + cb * 16 + 4 * q + e2) * 64 + lane];
            v[cb][e2] = sm; }
    sg_epilogue<MODE>(P, v, 64 * mi + 32 * rb + 8 * q + 4 * h, nblk, r);
}
#undef SG_MMA

struct Args { const float* in[18]; float* out; unsigned char* ws; };
__global__ void __launch_bounds__(NWAVES * 64, 2) fwd_kernel(Args args) {
    extern __shared__ __attribute__((aligned(16))) unsigned char lds_raw[];
    LAS unsigned char* lds = (LAS unsigned char*)lds_raw;
    volatile LAS unsigned* MISC = (volatile LAS unsigned*)(lds + MISC_OFF);
    const int tid = threadIdx.x, lane = tid & 63, wave = __builtin_amdgcn_readfirstlane(tid >> 6);
    const int G = gridDim.x, bx = blockIdx.x;
    unsigned char* ws = args.ws;
    unsigned* ctl = (unsigned*)(ws + WS_CTL);
    const float* xp = args.in[0]; const float* xs = args.in[1];
    bf16* Wi = (bf16*)(ws + WS_WIN); bf16* Wo = (bf16*)(ws + WS_WOUT); bf16* Wu = (bf16*)(ws + WS_WUP); bf16* Wd = (bf16*)(ws + WS_WDN);
    float* rstd1 = (float*)(ws + WS_RSTD1); float* r2 = (float*)(ws + WS_R2); float* ssq = (float*)(ws + WS_SSQ); float* ssqs = (float*)(ws + WS_SSQS);
    bf16* XB = (bf16*)(ws + WS_XB); bf16* Z = (bf16*)(ws + WS_Z); bf16* U = (bf16*)(ws + WS_U); bf16* MIX = (bf16*)(ws + WS_MIX); bf16* H = (bf16*)(ws + WS_H);
    float* out = args.out;
    const SgPtrs SP{Z, U, rstd1, xs, out, XB, ssqs, H, r2};
    const int SG_XCD = bx & 7, SG_MI = (bx >> 3) >> 2, SG_NS = (bx >> 3) & 3;
    for (int u = tid; u < (LDS_BYTES - RING_BYTES) / 4; u += NWAVES * 64) ((LAS unsigned*)(lds + RING_BYTES))[u] = 0u;
    __syncthreads();
    XcdBarrier bar = xcd_barrier_post(ctl + CW_BAR, MISC + 8);

    for (int rep_ = 0; rep_ < (PROBE == 1 ? 2 : 1); ++rep_) {
        LAS float* scr = (LAS float*)(lds + wave * 16384);
        const int gw = bx * NWAVES + wave, NGW = G * NWAVES;
        const P0Mats Mx{args.in[6], args.in[5], args.in[14], args.in[16], args.in[15], args.in[17], Wi, Wo, Wu, Wd};
        p0_weights(Mx, scr, gw, NGW, lane, 0, P0_I_IN);
        p0_xrows(xp, xs, XB, rstd1, gw, NGW, lane);
    }
    xcd_barrier(bar);

    {
#define SGR_IN(lo, hi) for (int rd = (lo); rd < (hi); ++rd) { const int mi = SG_MI, ni = (rd * 8 + SG_XCD) * 4 + SG_NS; \
            if (ni < 24) sgemm_tile<0>(lds, SP, XB + (size_t)(MP + 64 * mi) * DM, Wi + (size_t)(64 * ni) * DM, Wi + (size_t)(64 * ni + 32) * DM, DM, mi, ni, lane, wave); \
            else if (ni < 56) { const int ci = ni - 24, ch = 32 * ci; const bf16* b0 = Wi + (size_t)(ZW + 256 * (ch >> 7) + (ch & 127)) * DM; \
                sgemm_tile<1>(lds, SP, XB + (size_t)(MP + 64 * mi) * DM, b0, b0 + (size_t)128 * DM, DM, mi, ci, lane, wave); } }
        const int nf = (SG_NS * 2) / 3;
        SGR_IN(0, nf);
        __syncthreads();
        pg8::Gemm g{XB, Wi, MP, INW, DM}; pg8::StaticOrder S; S.init(MP, INW, G, bx);
        pg8::EpiIn E{Z, U, rstd1};
        pg8::gemm_phase<pg8::EpiIn, pg8::StaticOrder, true, true>(lds, g, S, E);
        SGR_IN(nf, 2);
#undef SGR_IN
    }
    xcd_barrier(bar);

    {
        P2Args A{Z, U, MIX, args.in[2], args.in[3], args.in[4], args.in[7], args.in[8], args.in[9], args.in[10], args.in[11], args.in[12], args.in[13], out, (const bf16*)(ws + WS_ZROW)};
        {
            const P0Mats Mx{args.in[6], args.in[5], args.in[14], args.in[16], args.in[15], args.in[17], Wi, Wo, Wu, Wd};
            p0_weights(Mx, (LAS float*)(lds + wave * 16384), bx * NWAVES + wave, G * NWAVES, lane, P0_I_IN, P0_NITEMS);
            __syncthreads();
        }
        run_p2(A, lds, bx, G, tid, lane, wave);
#if PROBE == 2
        run_p2(A, lds, bx, G, tid, lane, wave);
#endif
    }
    xcd_barrier(bar);

    for (int rep_ = 0; rep_ < (PROBE == 3 ? 2 : 1); ++rep_) {
#define SGR_OUT(lo, hi) for (int rd = (lo); rd < (hi); ++rd) { const int mi = SG_MI, ni = SG_XCD * 4 + SG_NS; sgemm_tile<2>(lds, SP, MIX + (size_t)(MP + 64 * mi) * DM, Wo + (size_t)(64 * ni) * DM, Wo + (size_t)(64 * ni + 32) * DM, DM, mi, ni, lane, wave); }
        const int nf = SG_NS & 1;
        SGR_OUT(0, nf);
        __syncthreads();
        pg8::Gemm g{MIX, Wo, MP, DM, DM}; pg8::StaticOrder S; S.init(MP, DM, G, bx, 4);
        pg8::EpiOut E{xp, xs, out, XB, ssq};
        pg8::gemm_phase<pg8::EpiOut, pg8::StaticOrder, true, true>(lds, g, S, E);
        SGR_OUT(nf, 1);
#undef SGR_OUT
    }
    xcd_barrier(bar);

    {
        for (int row = bx * (NWAVES * 64) + tid; row < M; row += G * NWAVES * 64) {
            float s = 0.f;
            if (row < MP) { const f32x4* p = (const f32x4*)(ssq + (size_t)row * 32);
#pragma unroll
                for (int i = 0; i < 8; ++i) { const f32x4 v = p[i]; s += (v.x + v.y) + (v.z + v.w); } }
            else { const f32x4* p = (const f32x4*)(ssqs + (size_t)(row - MP) * 64);
#pragma unroll
                for (int i = 0; i < 16; ++i) { const f32x4 v = p[i]; s += (v.x + v.y) + (v.z + v.w); } }
            r2[row] = 1.0f / (s * (1.0f / DM) + EPS);
        }
#define SGR_UP(lo, hi) for (int rd = (lo); rd < (hi); ++rd) { const int mi = SG_MI, ni = (rd * 8 + SG_XCD) * 4 + SG_NS; sgemm_tile<3>(lds, SP, XB + (size_t)(MP + 64 * mi) * DM, Wu + (size_t)(64 * ni) * DM, Wu + (size_t)(64 * ni + 32) * DM, DM, mi, ni, lane, wave); }
        const int nf = SG_NS;
        SGR_UP(0, nf);
        __syncthreads();
        pg8::Gemm g{XB, Wu, MP, FF, DM}; pg8::StaticOrder S; S.init(MP, FF, G, bx);
        pg8::EpiUp E{H};
        pg8::gemm_phase<pg8::EpiUp, pg8::StaticOrder, true, true>(lds, g, S, E);
        SGR_UP(nf, 4);
#undef SGR_UP
    }
    xcd_barrier(bar);

    {
#define SGR_DN(lo, hi) for (int rd = (lo); rd < (hi); ++rd) { const int mi = SG_MI, ni = SG_XCD * 4 + SG_NS; sgemm_tile<4>(lds, SP, H + (size_t)(MP + 64 * mi) * FF, Wd + (size_t)(64 * ni) * FF, Wd + (size_t)(64 * ni + 32) * FF, FF, mi, ni, lane, wave); }
        const int nf = SG_NS & 1;
        SGR_DN(0, nf);
        __syncthreads();
        pg8::Gemm g{H, Wd, MP, DM, FF}; pg8::StaticOrder S; S.init(MP, DM, G, bx, 4);
        pg8::EpiDown E{out, r2, XB};
        pg8::gemm_phase<pg8::EpiDown, pg8::StaticOrder, true, true>(lds, g, S, E);
        SGR_DN(nf, 1);
#undef SGR_DN
    }
}

extern "C" void kernel_launch(void* const* d_in, const int* in_sizes, int n_in, void* d_out, int out_size, void* d_ws, size_t ws_size, hipStream_t stream) {
    static int grid = 0;
    if (grid == 0) {
        if (n_in != 18 || (size_t)out_size != O_END || ws_size < WS_END) { fprintf(stderr, "kernel_launch: unexpected shapes (n_in %d, out %d, ws %zu); nothing launched\n", n_in, out_size, ws_size); grid = -1; return; }
        int dev = 0, cus = 0, per_cu = 0;
        if (hipGetDevice(&dev) != hipSuccess || hipDeviceGetAttribute(&cus, hipDeviceAttributeMultiprocessorCount, dev) != hipSuccess) { grid = -1; return; }
        if (hipFuncSetAttribute((const void*)fwd_kernel, hipFuncAttributeMaxDynamicSharedMemorySize, LDS_BYTES) != hipSuccess) { fprintf(stderr, "kernel_launch: hipFuncSetAttribute failed\n"); grid = -1; return; }
        if (hipOccupancyMaxActiveBlocksPerMultiprocessor(&per_cu, (const void*)fwd_kernel, NWAVES * 64, LDS_BYTES) != hipSuccess || per_cu < 1) { fprintf(stderr, "kernel_launch: occupancy query reports %d\n", per_cu); }
        (void)hipGetLastError();
        if (cus < 256) { fprintf(stderr, "kernel_launch: built for a 256-CU device (got %d CUs); nothing launched\n", cus); grid = -1; return; }
        grid = 256;
    }
    if (grid < 0) return;
    if (hipMemsetAsync((char*)d_ws + WS_CTL, 0, CTL_ZERO_BYTES, stream) != hipSuccess) return;
    Args a{};
    for (int i = 0; i < 18; ++i) a.in[i] = (const float*)d_in[i];
    a.out = (float*)d_out; a.ws = (unsigned char*)d_ws;
    hipLaunchKernelGGL(fwd_kernel, dim3(grid), dim3(NWAVES * 64), LDS_BYTES, stream, a);
}
```

```cpp
#include <hip/hip_runtime.h>
#include <cstdio>
#include <cstdint>
#ifndef RES_BF16
#define RES_BF16 1
#endif
#ifndef PROBE
#define PROBE 0
#endif
namespace pg8 {
#define PG8_LAS __attribute__((address_space(3)))
typedef unsigned short bf16_t;
typedef short bf16x8 __attribute__((ext_vector_type(8)));
typedef float f32x4 __attribute__((ext_vector_type(4)));
typedef unsigned u32x4 __attribute__((ext_vector_type(4)));
constexpr int BM = 256, BK = 64, HALF = 128, HTB = HALF * BK * 2  , STAGE_BYTES = 8 * HTB, NXCD = 8, WGM = 8;

__host__ __device__ __forceinline__ int lds_byte(int r, int c) { const int st = (r >> 4) * 2 + (c >> 5), rr = r & 15, cc = c & 31, ob = rr * 64 + cc * 2; return st * 1024 + (ob ^ (((ob >> 9) & 1) << 5)); }
__host__ __device__ __forceinline__ void stage_rc(int b, int& R, int& C) { const int st = b / 1024, sb = b % 1024, swz = sb ^ (((sb >> 9) & 1) << 5); R = (st >> 1) * 16 + swz / 64; C = (st & 1) * 32 + (swz % 64) / 2; }
__host__ __device__ __forceinline__ int perm32(int rho) { const int n = rho >> 4, i = rho & 15; return 8 * (i >> 2) + 4 * n + (i & 3); }

struct Unit { int pm, pn; };
struct Gemm { const bf16_t* A; const bf16_t* Bt; int M, N, K; };

struct StaticOrder {
    int nM, nN, nwg, G, c, wgm;
    __host__ __device__ void init(int M, int N, int G_, int c_, int wgm_ = WGM) { nM = M / BM; nN = N / BM; nwg = nM * nN; G = G_; c = c_; wgm = wgm_; }
    __host__ __device__ bool next(int i, Unit& u) const {
        const long L = (long)i * G + c; if (L >= nwg) return false;
        int wgid = (int)L; { const int q = nwg / NXCD, r = nwg % NXCD, xcd = wgid % NXCD, off = wgid / NXCD; wgid = (xcd < r ? xcd * (q + 1) : r * (q + 1) + (xcd - r) * q) + off; }
        const int nig = wgm * nN, gid = wgid / nig, fm = gid * wgm, gsz = (nM - fm) < wgm ? (nM - fm) : wgm;
        u.pm = fm + ((wgid % nig) % gsz); u.pn = (wgid % nig) / gsz; return true;
    }
    __device__ __forceinline__ void a_ready(const Unit&) const {}
    __device__ __forceinline__ void done(const Unit&) const {}
};

__device__ __forceinline__ unsigned cvt_pk_bf16(float lo, float hi) { unsigned r; asm volatile("v_cvt_pk_bf16_f32 %0, %1, %2" : "=v"(r) : "v"(lo), "v"(hi)); return r; }
typedef float f32x2 __attribute__((ext_vector_type(2)));
struct EpiIn {
    static constexpr bool PERM = true, AFTER_DRAIN = false;
    bf16_t* Z; bf16_t* U; const float* rstd;
    __device__ __forceinline__ void operator()(const f32x4 (&acc)[2][2][4][2], const Unit& u, int wr, int wc, int fr, int fq) const {
        const int row0 = u.pm * BM + wr * 64 + fr;
        if (u.pn < 6) {
            const int col0 = u.pn * BM + wc * 32 + 8 * fq;
#pragma unroll
            for (int ai = 0; ai < 2; ++ai)
#pragma unroll
                for (int m = 0; m < 4; ++m) { const int row = row0 + ai * HALF + m * 16; const float rs = rstd[row]; bf16_t* rowp = Z + (size_t)row * 1536 + col0;
#pragma unroll
                    for (int bj = 0; bj < 2; ++bj) { const f32x4 v0 = acc[ai][bj][m][0] * rs, v1 = acc[ai][bj][m][1] * rs;
                        u32x4 w; w.x = cvt_pk_bf16(v0[0], v0[1]); w.y = cvt_pk_bf16(v0[2], v0[3]); w.z = cvt_pk_bf16(v1[0], v1[1]); w.w = cvt_pk_bf16(v1[2], v1[3]);
                        *(u32x4*)(rowp + bj * HALF) = w; } }
        } else {
            const int c0 = (u.pn - 6) * HALF + wc * 32 + 8 * fq;
#pragma unroll
            for (int ai = 0; ai < 2; ++ai)
#pragma unroll
                for (int m = 0; m < 4; ++m) { const int row = row0 + ai * HALF + m * 16; const float rs = rstd[row];
                    float o[8];
#pragma unroll
                    for (int n = 0; n < 2; ++n)
#pragma unroll
                        for (int e = 0; e < 4; ++e) { const float a = acc[ai][0][m][n][e] * rs, g = acc[ai][1][m][n][e] * rs; o[n * 4 + e] = a * __builtin_amdgcn_rcpf(1.0f + __expf(-g)); }
                    u32x4 w; w.x = cvt_pk_bf16(o[0], o[1]); w.y = cvt_pk_bf16(o[2], o[3]); w.z = cvt_pk_bf16(o[4], o[5]); w.w = cvt_pk_bf16(o[6], o[7]);
                    *(u32x4*)(U + (size_t)row * 1024 + c0) = w; }
        }
    }
};
struct EpiOut {
#if RES_BF16
    static constexpr bool PERM = true, AFTER_DRAIN = false;
    const float* xp; const float* xs; float* out; bf16_t* XB; float* ssq;
    __device__ __forceinline__ void operator()(const f32x4 (&acc)[2][2][4][2], const Unit& u, int wr, int wc, int fr, int fq) const {
        const int row0 = u.pm * BM + wr * 64 + fr, col0 = u.pn * BM + wc * 32 + 8 * fq;
#pragma unroll
        for (int ai = 0; ai < 2; ++ai) {
            u32x4 xr[4][2];
#pragma unroll
            for (int m = 0; m < 4; ++m) { const size_t ro = (size_t)(row0 + ai * HALF + m * 16) * 2048 + col0;
#pragma unroll
                for (int bj = 0; bj < 2; ++bj) xr[m][bj] = *(const u32x4*)(XB + ro + bj * HALF); }
            __builtin_amdgcn_sched_barrier(0);
#pragma unroll
            for (int m = 0; m < 4; ++m) { const int row = row0 + ai * HALF + m * 16; const size_t ro = (size_t)row * 2048 + col0; float q = 0.f;
#pragma unroll
                for (int bj = 0; bj < 2; ++bj) { const u32x4 xw = xr[m][bj];
                    const f32x4 x0 = (f32x4){__builtin_bit_cast(float, xw.x << 16), __builtin_bit_cast(float, xw.x & 0xffff0000u), __builtin_bit_cast(float, xw.y << 16), __builtin_bit_cast(float, xw.y & 0xffff0000u)};
                    const f32x4 x1 = (f32x4){__builtin_bit_cast(float, xw.z << 16), __builtin_bit_cast(float, xw.z & 0xffff0000u), __builtin_bit_cast(float, xw.w << 16), __builtin_bit_cast(float, xw.w & 0xffff0000u)};
                    const f32x4 v0 = acc[ai][bj][m][0] + x0, v1 = acc[ai][bj][m][1] + x1;
                    u32x4 w; w.x = cvt_pk_bf16(v0[0], v0[1]); w.y = cvt_pk_bf16(v0[2], v0[3]); w.z = cvt_pk_bf16(v1[0], v1[1]); w.w = cvt_pk_bf16(v1[2], v1[3]);
                    *(u32x4*)(XB + ro + bj * HALF) = w;
                    q += (v0[0] * v0[0] + v0[1] * v0[1]) + (v0[2] * v0[2] + v0[3] * v0[3]) + (v1[0] * v1[0] + v1[1] * v1[1]) + (v1[2] * v1[2] + v1[3] * v1[3]); }
                q += __shfl_xor(q, 16); q += __shfl_xor(q, 32);
                if (fq == 0) ssq[(size_t)row * 32 + u.pn * 4 + wc] = q; }
            __builtin_amdgcn_sched_barrier(0);
        }
    }
#else
    static constexpr bool PERM = false, AFTER_DRAIN = false;
    const float* xp; const float* xs; float* out; bf16_t* XB; float* ssq;
    __device__ __forceinline__ void operator()(const f32x4 (&acc)[2][2][4][2], const Unit& u, int wr, int wc, int fr, int fq) const {
        typedef unsigned u32x2 __attribute__((ext_vector_type(2)));
        const int row0 = u.pm * BM + wr * 64 + fr, col0 = u.pn * BM + wc * 32 + 4 * fq;
        const float* xb = (u.pm < 128) ? xp : (xs - (size_t)32768 * 2048);
#pragma unroll
        for (int ai = 0; ai < 2; ++ai) {
            f32x4 xr[4][2][2];
#pragma unroll
            for (int m = 0; m < 4; ++m) { const size_t ro = (size_t)(row0 + ai * HALF + m * 16) * 2048 + col0;
#pragma unroll
                for (int bj = 0; bj < 2; ++bj) { xr[m][bj][0] = *(const f32x4*)(xb + ro + bj * HALF); xr[m][bj][1] = *(const f32x4*)(xb + ro + bj * HALF + 16); } }
            __builtin_amdgcn_sched_barrier(0);
#pragma unroll
            for (int m = 0; m < 4; ++m) { const int row = row0 + ai * HALF + m * 16; const size_t ro = (size_t)row * 2048 + col0; float q = 0.f;
#pragma unroll
                for (int bj = 0; bj < 2; ++bj)
#pragma unroll
                    for (int n = 0; n < 2; ++n) { const f32x4 v = acc[ai][bj][m][n] + xr[m][bj][n];
                        *(f32x4*)(out + ro + bj * HALF + n * 16) = v;
                        u32x2 w; w.x = cvt_pk_bf16(v[0], v[1]); w.y = cvt_pk_bf16(v[2], v[3]);
                        *(u32x2*)(XB + ro + bj * HALF + n * 16) = w;
                        q += (v[0] * v[0] + v[1] * v[1]) + (v[2] * v[2] + v[3] * v[3]); }
                q += __shfl_xor(q, 16); q += __shfl_xor(q, 32);
                if (fq == 0) ssq[(size_t)row * 32 + u.pn * 4 + wc] = q; }
            __builtin_amdgcn_sched_barrier(0);
        }
    }
#endif
};
struct EpiUp {
    static constexpr bool PERM = true, AFTER_DRAIN = false;
    bf16_t* H;
    __device__ __forceinline__ void operator()(const f32x4 (&acc)[2][2][4][2], const Unit& u, int wr, int wc, int fr, int fq) const {
        const int row0 = u.pm * BM + wr * 64 + fr, col0 = u.pn * BM + wc * 32 + 8 * fq;
#pragma unroll
        for (int ai = 0; ai < 2; ++ai)
#pragma unroll
            for (int m = 0; m < 4; ++m) { bf16_t* rowp = H + (size_t)(row0 + ai * HALF + m * 16) * 8192 + col0;
#pragma unroll
                for (int bj = 0; bj < 2; ++bj) { f32x4 v0 = acc[ai][bj][m][0], v1 = acc[ai][bj][m][1];
#pragma unroll
                    for (int e = 0; e < 4; ++e) { const float a = fmaxf(v0[e], 0.f), b = fmaxf(v1[e], 0.f); v0[e] = a * a; v1[e] = b * b; }
                    u32x4 w; w.x = cvt_pk_bf16(v0[0], v0[1]); w.y = cvt_pk_bf16(v0[2], v0[3]); w.z = cvt_pk_bf16(v1[0], v1[1]); w.w = cvt_pk_bf16(v1[2], v1[3]);
                    *(u32x4*)(rowp + bj * HALF) = w; } }
    }
};
struct EpiDown {
    static constexpr bool PERM = false, AFTER_DRAIN = false;
    float* out; const float* r2; const bf16_t* XB;
    __device__ __forceinline__ void operator()(const f32x4 (&acc)[2][2][4][2], const Unit& u, int wr, int wc, int fr, int fq) const {
        typedef unsigned u32x2 __attribute__((ext_vector_type(2)));
        const int row0 = u.pm * BM + wr * 64 + fr, col0 = u.pn * BM + wc * 32 + 4 * fq;
#pragma unroll
        for (int ai = 0; ai < 2; ++ai) {
#if RES_BF16
            u32x2 xr[4][2][2]; float sc[4];
#pragma unroll
            for (int m = 0; m < 4; ++m) { const int row = row0 + ai * HALF + m * 16; const bf16_t* rowp = XB + (size_t)row * 2048 + col0; sc[m] = r2[row];
#pragma unroll
                for (int bj = 0; bj < 2; ++bj) { xr[m][bj][0] = *(const u32x2*)(rowp + bj * HALF); xr[m][bj][1] = *(const u32x2*)(rowp + bj * HALF + 16); } }
            __builtin_amdgcn_sched_barrier(0);
#pragma unroll
            for (int m = 0; m < 4; ++m) { float* rowp = out + (size_t)(row0 + ai * HALF + m * 16) * 2048 + col0;
#pragma unroll
                for (int bj = 0; bj < 2; ++bj)
#pragma unroll
                    for (int n = 0; n < 2; ++n) { const u32x2 w = xr[m][bj][n];
                        const f32x4 x = (f32x4){__builtin_bit_cast(float, w.x << 16), __builtin_bit_cast(float, w.x & 0xffff0000u), __builtin_bit_cast(float, w.y << 16), __builtin_bit_cast(float, w.y & 0xffff0000u)};
                        *(f32x4*)(rowp + bj * HALF + n * 16) = x + acc[ai][bj][m][n] * sc[m]; } }
            __builtin_amdgcn_sched_barrier(0);
#else
            f32x4 xr[4][2][2]; float sc[4];
#pragma unroll
            for (int m = 0; m < 4; ++m) { const int row = row0 + ai * HALF + m * 16; const float* rowp = out + (size_t)row * 2048 + col0; sc[m] = r2[row];
#pragma unroll
                for (int bj = 0; bj < 2; ++bj) { xr[m][bj][0] = *(const f32x4*)(rowp + bj * HALF); xr[m][bj][1] = *(const f32x4*)(rowp + bj * HALF + 16); } }
            __builtin_amdgcn_sched_barrier(0);
#pragma unroll
            for (int m = 0; m < 4; ++m) { float* rowp = out + (size_t)(row0 + ai * HALF + m * 16) * 2048 + col0;
#pragma unroll
                for (int bj = 0; bj < 2; ++bj) { *(f32x4*)(rowp + bj * HALF) = xr[m][bj][0] + acc[ai][bj][m][0] * sc[m]; *(f32x4*)(rowp + bj * HALF + 16) = xr[m][bj][1] + acc[ai][bj][m][1] * sc[m]; } }
            __builtin_amdgcn_sched_barrier(0);
#endif
        }
    }
};

template <class Epi, class Sched, bool ALIGN_EPI = false, bool SP2 = false>
__device__ __forceinline__ void gemm_phase(PG8_LAS unsigned char* lds, const Gemm g, const Sched& S, const Epi& E) {
    int tid_ = threadIdx.x; asm volatile("" : "+v"(tid_));
    const int tid = tid_, wid = __builtin_amdgcn_readfirstlane(tid >> 6), lane = tid & 63, wr = wid >> 2, wc = wid & 3, fr = lane & 15, fq = lane >> 4;
    const int K = g.K, nt = K / BK;
    unsigned voffA[2], voffB[2];
#pragma unroll
    for (int i = 0; i < 2; ++i) { int R, C; stage_rc(tid * 16 + i * 8192, R, C); const int Rb = Epi::PERM ? ((R & ~31) + perm32(R & 31)) : R;
        voffA[i] = (unsigned)(R * K + C) * 2u; voffB[i] = (unsigned)(Rb * K + C) * 2u; }
    const size_t kstep = (size_t)(BK * 2);
    const size_t hstep = (size_t)HALF * K * 2;
    const size_t tstep = 2 * hstep;
    const unsigned ldsw = (unsigned)wid * 1024u;
    const int aoff = lds_byte(wr * 64 + fr, fq * 8), boff = lds_byte(wc * 32 + fr, fq * 8);
#define PG8_SA(b, h) (((b) * 2 + (h)) * HTB)
#define PG8_SB(b, h) ((4 + (b) * 2 + (h)) * HTB)
#define PG8_STAGE(bufoff, gbase, voff) do { _Pragma("unroll") for (int _i = 0; _i < 2; ++_i) \
        __builtin_amdgcn_global_load_lds((const unsigned*)((const char*)(gbase) + (voff)[_i]), (PG8_LAS unsigned*)(lds + (bufoff) + ldsw + _i * 8192), 16, 0, 0); } while (0)
#define PG8_LDA(dst, b, h) do { _Pragma("unroll") for (int m = 0; m < 4; ++m) _Pragma("unroll") for (int k = 0; k < 2; ++k) dst[m][k] = *(const PG8_LAS bf16x8*)(lds + PG8_SA(b, h) + aoff + m * 2048 + k * 1024); } while (0)
#define PG8_LDB(dst, b, h) do { _Pragma("unroll") for (int n = 0; n < 2; ++n) _Pragma("unroll") for (int k = 0; k < 2; ++k) dst[n][k] = *(const PG8_LAS bf16x8*)(lds + PG8_SB(b, h) + boff + n * 2048 + k * 1024); } while (0)
#define PG8_MMA(ai, bj, At, Bt) do { __builtin_amdgcn_s_setprio(1); _Pragma("unroll") for (int m = 0; m < 4; ++m) _Pragma("unroll") for (int n = 0; n < 2; ++n) _Pragma("unroll") for (int k = 0; k < 2; ++k) \
        acc[ai][bj][m][n] = __builtin_amdgcn_mfma_f32_16x16x32_bf16(Bt[n][k], At[m][k], acc[ai][bj][m][n], 0, 0, 0); __builtin_amdgcn_s_setprio(0); } while (0)
#define PG8_WAIT_V(n) asm volatile("s_waitcnt vmcnt(" #n ")" ::: "memory")
#define PG8_WAIT_L(n) asm volatile("s_waitcnt lgkmcnt(" #n ")" ::: "memory")
#define PG8_BAR __builtin_amdgcn_s_barrier()
#define PG8_SCHED __builtin_amdgcn_sched_barrier(0)
    Unit cur, nxt; int ui = 0;
    if (!S.next(0, cur)) return;
    f32x4 acc[2][2][4][2];
#pragma unroll
    for (int a = 0; a < 2; ++a)
#pragma unroll
        for (int b = 0; b < 2; ++b)
#pragma unroll
            for (int m = 0; m < 4; ++m)
#pragma unroll
                for (int n = 0; n < 2; ++n) acc[a][b][m][n] = (f32x4){0.f, 0.f, 0.f, 0.f};
    bf16x8 At[4][2], B0[2][2], B1[2][2];
    const char* cA = (const char*)g.A + (size_t)cur.pm * tstep; const char* cB = (const char*)g.Bt + (size_t)cur.pn * tstep;
    S.a_ready(cur);
    if constexpr (SP2) {
        PG8_STAGE(PG8_SB(0, 0), cB, voffB); PG8_STAGE(PG8_SB(0, 1), cB + hstep, voffB); PG8_STAGE(PG8_SA(0, 0), cA, voffA); PG8_STAGE(PG8_SA(0, 1), cA + hstep, voffA);
        if (wr == 1) PG8_BAR;
        PG8_WAIT_V(2); PG8_BAR;
        PG8_STAGE(PG8_SB(1, 0), cB + kstep, voffB); PG8_STAGE(PG8_SA(1, 0), cA + kstep, voffA); PG8_STAGE(PG8_SB(1, 1), cB + hstep + kstep, voffB);
        PG8_WAIT_V(6); PG8_BAR;
    } else {
        PG8_STAGE(PG8_SB(0, 0), cB, voffB); PG8_STAGE(PG8_SA(0, 0), cA, voffA); PG8_STAGE(PG8_SB(0, 1), cB + hstep, voffB); PG8_STAGE(PG8_SA(0, 1), cA + hstep, voffA);
        if (wr == 1) PG8_BAR;
        PG8_WAIT_V(4); PG8_BAR;
        PG8_STAGE(PG8_SB(1, 0), cB + kstep, voffB); PG8_STAGE(PG8_SA(1, 0), cA + kstep, voffA); PG8_STAGE(PG8_SB(1, 1), cB + hstep + kstep, voffB);
        PG8_WAIT_V(6); PG8_BAR;
    }
    for (;;) {
        const bool has_next = S.next(ui + 1, nxt);
        const char* nA = has_next ? (const char*)g.A + (size_t)nxt.pm * tstep : cA; const char* nB = has_next ? (const char*)g.Bt + (size_t)nxt.pn * tstep : cB;
        for (int t = 0; t < nt; t += 2) {
            const bool last = (t == nt - 2);
            const char* a1 = cA + (size_t)(t + 1) * kstep;
            const char* a2 = last ? nA : cA + (size_t)(t + 2) * kstep; const char* b2 = last ? nB : cB + (size_t)(t + 2) * kstep;
            const char* a3 = a2 + kstep; const char* b3 = b2 + kstep;
            if (last && has_next) S.a_ready(nxt);
            if constexpr (SP2) {
            PG8_LDB(B0, 0, 0); PG8_LDB(B1, 0, 1); PG8_SCHED; PG8_LDA(At, 0, 0); PG8_STAGE(PG8_SA(1, 1), a1 + hstep, voffA);
            PG8_WAIT_V(8); PG8_WAIT_L(0); PG8_BAR; PG8_MMA(0, 0, At, B0); PG8_MMA(0, 1, At, B1); PG8_BAR; PG8_SCHED;
            PG8_LDA(At, 0, 1); PG8_STAGE(PG8_SB(0, 0), b2, voffB); PG8_STAGE(PG8_SB(0, 1), b2 + hstep, voffB); PG8_STAGE(PG8_SA(0, 0), a2, voffA);
            PG8_WAIT_V(8); PG8_WAIT_L(0); PG8_BAR; PG8_MMA(1, 0, At, B0); PG8_MMA(1, 1, At, B1); PG8_BAR; PG8_SCHED;
            PG8_LDB(B0, 1, 0); PG8_LDB(B1, 1, 1); PG8_SCHED; PG8_LDA(At, 1, 0); PG8_STAGE(PG8_SA(0, 1), a2 + hstep, voffA);
            PG8_WAIT_V(8); PG8_WAIT_L(0); PG8_BAR; PG8_MMA(0, 0, At, B0); PG8_MMA(0, 1, At, B1); PG8_BAR; PG8_SCHED;
            PG8_LDA(At, 1, 1); PG8_STAGE(PG8_SB(1, 0), b3, voffB); PG8_STAGE(PG8_SB(1, 1), b3 + hstep, voffB); PG8_STAGE(PG8_SA(1, 0), a3, voffA);
            PG8_WAIT_V(8); PG8_WAIT_L(0); PG8_BAR; PG8_MMA(1, 0, At, B0); PG8_MMA(1, 1, At, B1); PG8_BAR; PG8_SCHED;
            } else {
            PG8_LDB(B0, 0, 0); PG8_SCHED; PG8_LDA(At, 0, 0); PG8_STAGE(PG8_SA(1, 1), a1 + hstep, voffA);
            PG8_WAIT_L(8); PG8_BAR; PG8_WAIT_L(0); PG8_MMA(0, 0, At, B0); PG8_BAR; PG8_SCHED;
            PG8_LDB(B1, 0, 1); PG8_STAGE(PG8_SB(0, 0), b2, voffB);
            PG8_BAR; PG8_WAIT_L(0); PG8_MMA(0, 1, At, B1); PG8_BAR;
            PG8_LDA(At, 0, 1); PG8_STAGE(PG8_SA(0, 0), a2, voffA);
            PG8_BAR; PG8_WAIT_L(0); PG8_MMA(1, 0, At, B0); PG8_BAR; PG8_SCHED;
            PG8_STAGE(PG8_SB(0, 1), b2 + hstep, voffB);
            PG8_WAIT_V(6); PG8_BAR; PG8_MMA(1, 1, At, B1); PG8_BAR;
            PG8_LDB(B0, 1, 0); PG8_SCHED; PG8_LDA(At, 1, 0); PG8_STAGE(PG8_SA(0, 1), a2 + hstep, voffA);
            PG8_WAIT_L(8); PG8_BAR; PG8_WAIT_L(0); PG8_MMA(0, 0, At, B0); PG8_BAR; PG8_SCHED;
            PG8_LDB(B1, 1, 1); PG8_STAGE(PG8_SB(1, 0), b3, voffB);
            PG8_BAR; PG8_WAIT_L(0); PG8_MMA(0, 1, At, B1); PG8_BAR;
            PG8_LDA(At, 1, 1); PG8_STAGE(PG8_SA(1, 0), a3, voffA);
            PG8_BAR; PG8_WAIT_L(0); PG8_MMA(1, 0, At, B0); PG8_BAR; PG8_SCHED;
            PG8_STAGE(PG8_SB(1, 1), b3 + hstep, voffB);
            PG8_WAIT_V(6); PG8_BAR; PG8_MMA(1, 1, At, B1); PG8_BAR;
            }
        }
        if constexpr (ALIGN_EPI) { if (wr == 0) PG8_BAR; }
        if constexpr (!Epi::AFTER_DRAIN) { E(acc, cur, wr, wc, fr, fq); S.done(cur); }
        if (!has_next) break;
#pragma unroll
        for (int a = 0; a < 2; ++a)
#pragma unroll
            for (int b = 0; b < 2; ++b)
#pragma unroll
                for (int m = 0; m < 4; ++m)
#pragma unroll
                    for (int n = 0; n < 2; ++n) acc[a][b][m][n] = (f32x4){0.f, 0.f, 0.f, 0.f};
        cur = nxt; cA = nA; cB = nB; ++ui;
        if constexpr (ALIGN_EPI) { if (wr == 1) PG8_BAR; }
    }
    PG8_WAIT_V(0);
    if constexpr (!ALIGN_EPI) { if (wr == 0) PG8_BAR; }
    PG8_BAR;
    if constexpr (Epi::AFTER_DRAIN) { E.fused(acc, cur, wr, wc, fr, fq, lds, wid, lane); S.done(cur); }
#undef PG8_SA
#undef PG8_SB
#undef PG8_STAGE
#undef PG8_LDA
#undef PG8_LDB
#undef PG8_MMA
#undef PG8_WAIT_V
#undef PG8_WAIT_L
#undef PG8_BAR
#undef PG8_SCHED
}
}

constexpr int NWAVES = 8;
constexpr int DM = 2048, NB = 16, SEQ = 2048, DB = 128, DS = 4, HD = 64, NH = 16, NKV = 4, CCH = 1024, CW = 31, FF = 8192;
constexpr int MP = NB * SEQ, MS = DB * DS, M = MP + MS;
constexpr int INW = 3584, ZW = 1536;
constexpr float EPS = 1e-6f;
constexpr float QSCALE = 0.125f * 1.4426950408889634f;
constexpr float LOG2E = 1.4426950408889634f;
constexpr size_t O_Y = 0, O_KP = (size_t)M * DM, O_VP = O_KP + (size_t)NB * 128 * 256, O_CP = O_VP + (size_t)NB * 128 * 256,
                 O_KS = O_CP + (size_t)NB * 30 * CCH, O_VS = O_KS + (size_t)DB * 128 * 256, O_CS = O_VS + (size_t)DB * 128 * 256, O_END = O_CS + (size_t)DB * 30 * CCH;
constexpr size_t MiB = 1u << 20;
constexpr size_t WS_CTL = 0, CTL_ZERO_BYTES = 64 * 1024, WS_ZROW = 48 * 1024;
constexpr size_t WS_WIN = 1 * MiB, WS_WOUT = 15 * MiB, WS_WUP = 23 * MiB, WS_WDN = 55 * MiB;
constexpr size_t WS_RSTD1 = 87 * MiB, WS_R2 = 88 * MiB, WS_SSQS = 88 * MiB + 512 * 1024, WS_SSQ = 89 * MiB;
constexpr size_t WS_XB = 94 * MiB;
constexpr size_t WS_Z = 224 * MiB, WS_U = 322 * MiB, WS_MIX = 387 * MiB;
constexpr size_t WS_H = 224 * MiB, WS_END = 744 * MiB;
static_assert(WS_Z + (size_t)M * ZW * 2 <= WS_U && WS_U + (size_t)M * CCH * 2 <= WS_MIX && WS_MIX + (size_t)M * DM * 2 <= WS_END && WS_H + (size_t)M * FF * 2 <= WS_END, "d_ws map");
static_assert(WS_XB + (size_t)M * DM * 2 <= WS_Z && WS_SSQ + (size_t)M * 32 * 4 <= WS_XB && WS_WIN + (size_t)INW * DM * 2 <= WS_WOUT, "d_ws map");
constexpr int CW_BAR = 4096;
constexpr int RING_BYTES = 131072, MISC_OFF = RING_BYTES + 320, LDS_BYTES = 147456;
#define GAS __attribute__((address_space(1)))
#define LAS __attribute__((address_space(3)))
typedef unsigned short bf16;
typedef unsigned v4u __attribute__((ext_vector_type(4)));
typedef float f32x4 __attribute__((ext_vector_type(4)));
typedef short bf16x8 __attribute__((ext_vector_type(8)));
typedef GAS unsigned gu32;
typedef GAS unsigned long long gu64;
#define RLX_AGENT __ATOMIC_RELAXED, __HIP_MEMORY_SCOPE_AGENT
#define LDS_WAIT() asm volatile("s_waitcnt lgkmcnt(0)" ::: "memory")
#define VM_WAIT() asm volatile("s_waitcnt vmcnt(0)" ::: "memory")
__device__ __forceinline__ unsigned long long rt() { return __builtin_amdgcn_s_memrealtime(); }
__device__ __forceinline__ unsigned f2bf(float f) { unsigned u = __builtin_bit_cast(unsigned, f); return (u + 0x7fffu + ((u >> 16) & 1u)) >> 16; }
__device__ __forceinline__ unsigned pk2(float lo, float hi) { return f2bf(lo) | (f2bf(hi) << 16); }

#define XB_TMO      128
#define XB_XCNT(j)  (256  + 64 * (j))
#define XB_XSUB(j)  (1280 + 64 * (j))
#define XB_XGEN(j)  (2304 + 64 * (j))
#define XB_TOP      3328
#define XB_TOPGEN   3392
#define XCD_BAR_WORDS 3456
#define XB_SPIN_CAP (1u << 18)

__device__ __forceinline__ unsigned xb_ld(unsigned* p)              { return __hip_atomic_load(p, __ATOMIC_RELAXED, __HIP_MEMORY_SCOPE_AGENT); }
__device__ __forceinline__ unsigned xb_add(unsigned* p, unsigned v) { return __hip_atomic_fetch_add(p, v, __ATOMIC_RELAXED, __HIP_MEMORY_SCOPE_AGENT); }
__device__ __forceinline__ unsigned xb_xcc_id() { return (unsigned)__builtin_amdgcn_s_getreg((3 << 11) | 20) & 0xFu; }
#define XB_SPIN(cond, bar) do { unsigned _sp = 0; while (cond) { __builtin_amdgcn_s_sleep(1); \
    if ((++_sp & 255u) == 0u) { if (xb_ld(&(bar)[XB_TMO])) break; if (_sp > XB_SPIN_CAP) { atomicAdd(&(bar)[XB_TMO], 1u); break; } } } } while (0)

struct XcdBarrier {
    unsigned* bar; unsigned x;
    volatile LAS unsigned* st;
};

__device__ __forceinline__ XcdBarrier xcd_barrier_post(unsigned* bar, volatile LAS unsigned* st) {
    XcdBarrier b; b.bar = bar; b.x = xb_xcc_id(); b.st = st;
    if (threadIdx.x == 0) (void)xb_add(&bar[XB_XCNT(b.x)], 1u);
    return b;
}
__device__ __forceinline__ void xcd_barrier_complete(unsigned* bar, unsigned x, unsigned& nloc, unsigned& nx) {
    const unsigned G = gridDim.x * gridDim.y * gridDim.z;
    unsigned sum, cnt, mine, sp = 0u;
    for (;;) {
        sum = 0u; cnt = 0u; mine = 0u;
#pragma unroll
        for (unsigned j = 0; j < 16; ++j) { const unsigned c = xb_ld(&bar[XB_XCNT(j)]); sum += c; cnt += (c > 0u) ? 1u : 0u; mine = (j == x) ? c : mine; }
        if (sum == G) break;
        __builtin_amdgcn_s_sleep(1);
        if ((++sp & 255u) == 0u) { if (xb_ld(&bar[XB_TMO])) break; if (sp > XB_SPIN_CAP) { atomicAdd(&bar[XB_TMO], 1u); break; } }
    }
    nloc = mine > 0u ? mine : 1u; nx = cnt > 0u ? cnt : 1u;
}

__device__ __forceinline__ void xcd_barrier(const XcdBarrier& b) {
    asm volatile("s_waitcnt vmcnt(0)" ::: "memory");
    __syncthreads();
    if (threadIdx.x == 0) {
        unsigned* bar = b.bar;
        __builtin_amdgcn_s_waitcnt(0);
        unsigned nloc = b.st[0], nx = b.st[1];
        if (nloc == 0u) { xcd_barrier_complete(bar, b.x, nloc, nx); b.st[0] = nloc; b.st[1] = nx; }
        const unsigned old = xb_add(&bar[XB_XSUB(b.x)], 1u);
        const unsigned gen = old / nloc;
        if (old + 1u == (gen + 1u) * nloc) {
            __builtin_amdgcn_fence(__ATOMIC_RELEASE, "agent");
            asm volatile("s_waitcnt vmcnt(0)" ::: "memory");
            const unsigned og = xb_add(&bar[XB_TOP], 1u);
            const unsigned tg = og / nx;
            if (og + 1u == (tg + 1u) * nx) xb_add(&bar[XB_TOPGEN], 1u);
            else XB_SPIN(xb_ld(&bar[XB_TOPGEN]) == tg, bar);
            __builtin_amdgcn_fence(__ATOMIC_ACQUIRE, "agent");
            xb_add(&bar[XB_XGEN(b.x)], 1u);
            asm volatile("s_waitcnt vmcnt(0)" ::: "memory");
        } else {
            XB_SPIN(xb_ld(&bar[XB_XGEN(b.x)]) == gen, bar);
            __builtin_amdgcn_fence(__ATOMIC_ACQUIRE, "agent");
            asm volatile("s_waitcnt vmcnt(0)" ::: "memory");
        }
    }
    __syncthreads();
}

typedef float f32x2 __attribute__((ext_vector_type(2)));
typedef float f32x16 __attribute__((ext_vector_type(16)));
typedef short s16x4 __attribute__((ext_vector_type(4)));
__device__ __forceinline__ unsigned cvtpk(float lo, float hi) { unsigned r; asm volatile("v_cvt_pk_bf16_f32 %0, %1, %2" : "=v"(r) : "v"(lo), "v"(hi)); return r; }
__device__ __forceinline__ float bf_lo(unsigned u) { return __builtin_bit_cast(float, u << 16); }
__device__ __forceinline__ float bf_hi(unsigned u) { return __builtin_bit_cast(float, u & 0xffff0000u); }
__device__ __forceinline__ void fmac1(float& acc, float a, float b) { asm("v_fmac_f32 %0, %1, %2" : "+v"(acc) : "v"(a), "v"(b)); }
__device__ __forceinline__ float wave_sum(float v) {
#pragma unroll
    for (int o = 1; o < 64; o <<= 1) v += __shfl_xor(v, o);
    return v;
}

struct P0Item { const float* W; const float* gain; bf16* WT; int K, N, rowmap, k0, n0; };
struct P0Mats { const float *w_in, *g_in, *w_out, *w_up, *g_up, *w_dn; bf16 *Wi, *Wo, *Wu, *Wd; };
constexpr int P0_I_IN = (DM / 64) * (INW / 32), P0_I_OUT = (DM / 64) * (DM / 32), P0_I_UP = (DM / 64) * (FF / 32), P0_I_DN = (FF / 64) * (DM / 32), P0_NITEMS = P0_I_IN + P0_I_OUT + P0_I_UP + P0_I_DN;
__device__ __forceinline__ P0Item p0_item(const P0Mats& Mx, int it) {
    P0Item I; int r = it;
    if (r < P0_I_IN) { I.W = Mx.w_in; I.gain = Mx.g_in; I.WT = Mx.Wi; I.K = DM; I.N = INW; I.rowmap = 1; }
    else if ((r -= P0_I_IN) < P0_I_OUT) { I.W = Mx.w_out; I.gain = nullptr; I.WT = Mx.Wo; I.K = DM; I.N = DM; I.rowmap = 0; }
    else if ((r -= P0_I_OUT) < P0_I_UP) { I.W = Mx.w_up; I.gain = Mx.g_up; I.WT = Mx.Wu; I.K = DM; I.N = FF; I.rowmap = 0; }
    else { r -= P0_I_UP; I.W = Mx.w_dn; I.gain = nullptr; I.WT = Mx.Wd; I.K = FF; I.N = DM; I.rowmap = 0; }
    const int nblk = I.N / 32; I.k0 = 64 * (r / nblk); I.n0 = 32 * (r % nblk); return I;
}
__device__ __forceinline__ void p0_item_issue(const P0Item& I, int lane, f32x4 (&v)[8], float (&g)[8]) {
    const int kr = lane >> 3, nc = lane & 7;
#pragma unroll
    for (int j = 0; j < 8; ++j) { v[j] = *(const f32x4*)(I.W + (size_t)(I.k0 + 8 * j + kr) * I.N + I.n0 + 4 * nc); g[j] = I.gain ? I.gain[I.k0 + 8 * j + kr] : 1.0f; }
}
__device__ __forceinline__ void p0_weights(const P0Mats& Mx, LAS float* scr, int gw, int NGW, int lane_, int lo, int hi) {
    int lane = lane_; asm volatile("" : "+v"(lane));
    f32x4 v[8]; float g[8];
    int it = lo + gw;
    P0Item I = p0_item(Mx, it < hi ? it : lo);
    if (it < hi) p0_item_issue(I, lane, v, g);
#pragma unroll 1
    for (; it < hi; it += NGW) {
        {   const int kr = lane >> 3, nc = lane & 7;
#pragma unroll
            for (int j = 0; j < 8; ++j) { LAS float* d = scr + (8 * j + kr) * 33 + 4 * nc; d[0] = v[j].x * g[j]; d[1] = v[j].y * g[j]; d[2] = v[j].z * g[j]; d[3] = v[j].w * g[j]; } }
        const P0Item C = I;
        if (it + NGW < hi) { I = p0_item(Mx, it + NGW); p0_item_issue(I, lane, v, g); }
        __builtin_amdgcn_sched_barrier(0);
        LDS_WAIT(); asm volatile("" ::: "memory");
        int nd0 = C.n0;
        if (C.rowmap == 1 && C.n0 >= ZW) { int c = C.n0 - ZW; if (c < CCH) nd0 = ZW + 256 * (c >> 7) + (c & 127); else { c -= CCH; nd0 = ZW + 256 * (c >> 7) + 128 + (c & 127); } }
        const int c = lane & 7;
#pragma unroll
        for (int j = 0; j < 4; ++j) { const int n = (lane >> 3) + 8 * j; const LAS float* s = scr + (8 * c) * 33 + n;
            v4u o; o.x = pk2(s[0 * 33], s[1 * 33]); o.y = pk2(s[2 * 33], s[3 * 33]); o.z = pk2(s[4 * 33], s[5 * 33]); o.w = pk2(s[6 * 33], s[7 * 33]);
            *(GAS v4u*)(C.WT + (size_t)(nd0 + n) * C.K + C.k0 + 8 * c) = o; }
        LDS_WAIT(); asm volatile("" ::: "memory");
    }
}
__device__ __forceinline__ void p0_xrows(const float* xp, const float* xs, bf16* XB, float* rstd1, int gw, int NGW, int lane) {
    f32x4 v[8];
    int m = gw;
    if (m < M) { const GAS f32x4* xr = (const GAS f32x4*)((m < MP) ? xp + (size_t)m * DM : xs + (size_t)(m - MP) * DM) + lane;
#pragma unroll
        for (int j = 0; j < 8; ++j) v[j] = xr[64 * j]; }
#pragma unroll 1
    for (; m < M; m += NGW) {
        float s = 0.f; unsigned long long pk[8];
#pragma unroll
        for (int j = 0; j < 8; ++j) { s += (v[j].x * v[j].x + v[j].y * v[j].y) + (v[j].z * v[j].z + v[j].w * v[j].w); pk[j] = (unsigned long long)cvtpk(v[j].x, v[j].y) | ((unsigned long long)cvtpk(v[j].z, v[j].w) << 32); }
        const int mn = m + NGW;
        if (mn < M) { const GAS f32x4* xr = (const GAS f32x4*)((mn < MP) ? xp + (size_t)mn * DM : xs + (size_t)(mn - MP) * DM) + lane;
#pragma unroll
            for (int j = 0; j < 8; ++j) v[j] = xr[64 * j]; }
        __builtin_amdgcn_sched_barrier(0);
        s = wave_sum(s);
        if (lane == 0) rstd1[m] = 1.0f / sqrtf(s * (1.0f / DM) + EPS);
        GAS unsigned long long* o8 = (GAS unsigned long long*)(XB + (size_t)m * DM) + lane;
#pragma unroll
        for (int j = 0; j < 8; ++j) o8[64 * j] = pk[j];
    }
}

constexpr int KV_RS = 144;
__device__ __forceinline__ int crow(int r, int hi) { return (r & 3) + 8 * (r >> 2) + 4 * hi; }
__device__ __forceinline__ s16x4 vtr(const LAS unsigned char* p) { return __builtin_bit_cast(s16x4, __builtin_amdgcn_ds_read_tr16_b64_v4i16((LAS s16x4*)p)); }

__device__ __forceinline__ void q_issue(const bf16* qrow, int h, v4u (&raw)[4]) {
#pragma unroll
    for (int d0 = 0; d0 < 4; ++d0) raw[d0] = *(const v4u*)(qrow + 16 * d0 + 8 * h);
}
__device__ __forceinline__ void q_finish(const v4u (&raw)[4], int h, const LAS float* gq, bf16x8 (&qf)[4]) {
    float v[4][8]; float ss = 0.f;
#pragma unroll
    for (int d0 = 0; d0 < 4; ++d0)
#pragma unroll
        for (int e = 0; e < 4; ++e) { v[d0][2 * e] = bf_lo(raw[d0][e]); v[d0][2 * e + 1] = bf_hi(raw[d0][e]); ss += v[d0][2 * e] * v[d0][2 * e] + v[d0][2 * e + 1] * v[d0][2 * e + 1]; }
    ss += __shfl_xor(ss, 32);
    const float rs = __builtin_amdgcn_rsqf(ss * (1.0f / HD) + EPS) * QSCALE;
#pragma unroll
    for (int d0 = 0; d0 < 4; ++d0) { const f32x4 g0 = *(const LAS f32x4*)(gq + 16 * d0 + 8 * h), g1 = *(const LAS f32x4*)(gq + 16 * d0 + 8 * h + 4);
        v4u w; w.x = cvtpk(v[d0][0] * rs * g0[0], v[d0][1] * rs * g0[1]); w.y = cvtpk(v[d0][2] * rs * g0[2], v[d0][3] * rs * g0[3]);
        w.z = cvtpk(v[d0][4] * rs * g1[0], v[d0][5] * rs * g1[1]); w.w = cvtpk(v[d0][6] * rs * g1[2], v[d0][7] * rs * g1[3]);
        qf[d0] = __builtin_bit_cast(bf16x8, w); }
}
__device__ __forceinline__ void attn_core(const LAS unsigned char* Kt, const LAS unsigned char* Vt, int tt0, int qrel, int kvmin, const bf16x8 (&qf)[4], float sink2, float cshift, int lane, f32x16 (&o)[2]) {
    const int r32 = lane & 31, h = lane >> 5;
    f32x16 s[5];
#pragma unroll
    for (int i = 0; i < 5; ++i) {
        const LAS unsigned char* kp = Kt + (32 * (tt0 + i) + r32) * KV_RS + h * 16;
        const float nc = -cshift; f32x16 a = {nc, nc, nc, nc, nc, nc, nc, nc, nc, nc, nc, nc, nc, nc, nc, nc};
#pragma unroll
        for (int d0 = 0; d0 < 4; ++d0) { const bf16x8 kf = *(const LAS bf16x8*)(kp + 32 * d0); a = __builtin_amdgcn_mfma_f32_32x32x16_bf16(kf, qf[d0], a, 0, 0, 0); }
        s[i] = a;
    }
    const int qloc = qrel - 32 * tt0, ndead = (kvmin >> 5) - tt0;
    float ls = 0.f;
#pragma unroll
    for (int i = 0; i < 5; ++i)
#pragma unroll
        for (int r = 0; r < 16; ++r) { const int cr = (r & 3) + 8 * (r >> 2); bool ok = (i >= ndead);
            if (i == 0) ok = ok && (cr + 4 * h > qloc);
            if (i == 4) ok = ok && (cr + 4 * h <= qloc);
            const float p = ok ? __builtin_amdgcn_exp2f(s[i][r]) : 0.f; s[i][r] = p; ls += p; }
    ls += __shfl_xor(ls, 32);
    const float inv = __builtin_amdgcn_rcpf(ls + __builtin_amdgcn_exp2f(sink2 - cshift));
    o[0] = (f32x16){0.f, 0.f, 0.f, 0.f, 0.f, 0.f, 0.f, 0.f, 0.f, 0.f, 0.f, 0.f, 0.f, 0.f, 0.f, 0.f}; o[1] = o[0];
    const LAS unsigned char* vb = Vt + (4 * h + ((lane & 15) >> 2)) * KV_RS + ((lane >> 4) & 1) * 32 + (lane & 3) * 8;
#pragma unroll
    for (int i = 0; i < 5; ++i)
#pragma unroll
        for (int st = 0; st < 2; ++st) {
            v4u pw; pw.x = cvtpk(s[i][8 * st + 0], s[i][8 * st + 1]); pw.y = cvtpk(s[i][8 * st + 2], s[i][8 * st + 3]); pw.z = cvtpk(s[i][8 * st + 4], s[i][8 * st + 5]); pw.w = cvtpk(s[i][8 * st + 6], s[i][8 * st + 7]);
            const bf16x8 pf = __builtin_bit_cast(bf16x8, pw);
#pragma unroll
            for (int dt = 0; dt < 2; ++dt) {
                const LAS unsigned char* vp = vb + (32 * (tt0 + i) + 16 * st) * KV_RS + dt * 64;
                const s16x4 lo = vtr(vp), hi = vtr(vp + 8 * KV_RS);
                const bf16x8 vf = (bf16x8){lo[0], lo[1], lo[2], lo[3], hi[0], hi[1], hi[2], hi[3]};
                o[dt] = __builtin_amdgcn_mfma_f32_32x32x16_bf16(vf, pf, o[dt], 0, 0, 0);
            }
        }
#pragma unroll
    for (int dt = 0; dt < 2; ++dt)
#pragma unroll
        for (int r = 0; r < 16; ++r) o[dt][r] *= inv;
}
__device__ __forceinline__ void store_o(bf16* orow, int h, const f32x16 (&o)[2]) {
#pragma unroll
    for (int dt = 0; dt < 2; ++dt)
#pragma unroll
        for (int pr = 0; pr < 2; ++pr) {
            const int ge = 2 * pr, go = 2 * pr + 1;
            const unsigned e0 = cvtpk(o[dt][4 * ge], o[dt][4 * ge + 1]), e1 = cvtpk(o[dt][4 * ge + 2], o[dt][4 * ge + 3]);
            const unsigned o0 = cvtpk(o[dt][4 * go], o[dt][4 * go + 1]), o1 = cvtpk(o[dt][4 * go + 2], o[dt][4 * go + 3]);
            const auto r0 = __builtin_amdgcn_permlane32_swap(e0, o0, false, false), r1 = __builtin_amdgcn_permlane32_swap(e1, o1, false, false);
            const v4u w = (v4u){r0[0], r1[0], r0[1], r1[1]};
            *(v4u*)(orow + 32 * dt + 8 * (2 * pr + h)) = w; }
}
__device__ __forceinline__ void knorm32(const v4u (&raw)[4], const LAS float* gk32, float (&kf)[32]) {
    float ss = 0.f;
#pragma unroll
    for (int i = 0; i < 4; ++i)
#pragma unroll
        for (int e = 0; e < 4; ++e) { kf[8 * i + 2 * e] = bf_lo(raw[i][e]); kf[8 * i + 2 * e + 1] = bf_hi(raw[i][e]); ss += kf[8 * i + 2 * e] * kf[8 * i + 2 * e] + kf[8 * i + 2 * e + 1] * kf[8 * i + 2 * e + 1]; }
    ss += __shfl_xor(ss, 1);
    const float rs = __builtin_amdgcn_rsqf(ss * (1.0f / HD) + EPS);
#pragma unroll
    for (int i = 0; i < 8; ++i) { const f32x4 g = *(const LAS f32x4*)(gk32 + 4 * i);
#pragma unroll
        for (int e = 0; e < 4; ++e) kf[4 * i + e] = kf[4 * i + e] * rs * g[e]; }
}
__device__ __forceinline__ void lds_put32(LAS unsigned char* dst, const float (&f)[32]) {
#pragma unroll
    for (int i = 0; i < 4; ++i) { v4u w; w.x = cvtpk(f[8 * i], f[8 * i + 1]); w.y = cvtpk(f[8 * i + 2], f[8 * i + 3]); w.z = cvtpk(f[8 * i + 4], f[8 * i + 5]); w.w = cvtpk(f[8 * i + 6], f[8 * i + 7]); *(LAS v4u*)(dst + 16 * i) = w; }
}
__device__ __forceinline__ void glb_put32(float* dst, const float (&f)[32]) {
#pragma unroll
    for (int i = 0; i < 8; ++i) *(f32x4*)(dst + 4 * i) = (f32x4){f[4 * i], f[4 * i + 1], f[4 * i + 2], f[4 * i + 3]};
}

struct P2Args { const bf16* Z; const bf16* U; bf16* MIX; const float *ck, *cv, *sc, *gq, *gk, *sinks, *wdw, *bdw, *gln, *bln; float* out; const bf16* zrow; };

__device__ __forceinline__ void kv_issue(const P2Args& A, int au, int tid, v4u (&kr)[4], v4u (&vr)[4]) {
    const int b = au >> 6, qb = (au >> 2) & 15, hk = au & 3, r = tid >> 1, half = tid & 1, t = 128 * (qb - 1) + r, tc = t < 0 ? 0 : t;
    const bf16* zr = A.Z + (size_t)(b * SEQ + tc) * ZW + hk * HD + half * 32;
#pragma unroll
    for (int i = 0; i < 4; ++i) { kr[i] = *(const v4u*)(zr + 1024 + 8 * i); vr[i] = *(const v4u*)(zr + 1280 + 8 * i); }
}
__device__ __forceinline__ void attn_prompt_all(const P2Args& A, LAS unsigned char* lds, const LAS float* gq, const LAS float* gk, int bx, int G, int tid, int lane, int wave) {
    LAS unsigned char* Kt = lds; LAS unsigned char* Vt = lds + 49152;
    constexpr int NU = NB * 16 * NKV;
    const int r32 = lane & 31, h = lane >> 5;
    v4u kr[4], vr[4];
    int au = bx;
    if (au < NU) kv_issue(A, au, tid, kr, vr);
#pragma unroll 1
    for (; au < NU; au += G) {
        const int b = au >> 6, qb = (au >> 2) & 15, hk = au & 3;
        v4u qcur[4];
        { const int wu = wave * 2, g = wu >> 2, q0 = (wu & 3) * 32, head = hk * 4 + g; const size_t row = (size_t)b * SEQ + 128 * qb + q0 + r32; q_issue(A.Z + row * ZW + head * HD, h, qcur); }
        {   const int r = tid >> 1, half = tid & 1, t = 128 * (qb - 1) + r;
            if (t < 0) {
#pragma unroll
                for (int i = 0; i < 4; ++i) { kr[i] = (v4u){0u, 0u, 0u, 0u}; vr[i] = (v4u){0u, 0u, 0u, 0u}; } }
            float kf[32]; knorm32(kr, gk + half * 32, kf);
            lds_put32(Kt + r * KV_RS + half * 64, kf);
#pragma unroll
            for (int i = 0; i < 4; ++i) *(LAS v4u*)(Vt + r * KV_RS + half * 64 + 16 * i) = vr[i];
            if (qb == 15 && r >= 128) {
                const size_t oo = ((size_t)(b * 128 + (r - 128)) * NKV + hk) * HD + half * 32;
                glb_put32(A.out + O_KP + oo, kf);
                float vf[32];
#pragma unroll
                for (int i = 0; i < 4; ++i)
#pragma unroll
                    for (int e = 0; e < 4; ++e) { vf[8 * i + 2 * e] = bf_lo(vr[i][e]); vf[8 * i + 2 * e + 1] = bf_hi(vr[i][e]); }
                glb_put32(A.out + O_VP + oo, vf);
            }
        }
        __syncthreads();
#pragma unroll 1
        for (int w2 = 0; w2 < 2; ++w2) {
            const int wu = wave * 2 + w2, g = wu >> 2, q0 = (wu & 3) * 32, head = hk * 4 + g; const size_t row = (size_t)b * SEQ + 128 * qb + q0 + r32;
            v4u qnext[4];
            if (w2 == 0) q_issue(A.Z + (row + 32) * ZW + (hk * 4 + ((wu + 1) >> 2)) * HD, h, qnext);
            else {
#pragma unroll
                for (int i = 0; i < 4; ++i) qnext[i] = qcur[i]; }
            bf16x8 qf[4]; q_finish(qcur, h, gq, qf);
            if (w2 == 0 && au + G < NU) kv_issue(A, au + G, tid, kr, vr);
            f32x16 o[2];
            attn_core(Kt, Vt, q0 >> 5, q0 + r32, qb == 0 ? 128 : 0, qf, A.sinks[head] * LOG2E, gq[128], lane, o);
            store_o(A.MIX + row * DM + head * HD, h, o);
#pragma unroll
            for (int i = 0; i < 4; ++i) qcur[i] = qnext[i];
        }
        __syncthreads();
    }
}
__device__ __forceinline__ void attn_sample_unit(const P2Args& A, LAS unsigned char* lds, const LAS float* gq, const LAS float* gk, int b, int hp, int tid, int lane, int wave) {
    LAS unsigned char* Kt = lds; LAS unsigned char* Vt = lds + 49152;
#pragma unroll 1
    for (int it = 0; it < 2; ++it) {
        const int task = tid + it * 512;
        if (task < 640) {
            const int hl = task / 320, rem = task % 320, r = rem >> 1, half = rem & 1, hk = 2 * hp + hl;
            LAS unsigned char* kd = Kt + hl * (160 * KV_RS) + r * KV_RS + half * 64; LAS unsigned char* vd = Vt + hl * (160 * KV_RS) + r * KV_RS + half * 64;
            float kf[32], vf[32];
            if (r < 128) {
                const size_t io = ((size_t)(b * 128 + r) * NKV + hk) * HD + half * 32;
#pragma unroll
                for (int i = 0; i < 8; ++i) { const f32x4 a = *(const f32x4*)(A.ck + io + 4 * i), c = *(const f32x4*)(A.cv + io + 4 * i);
                    kf[4 * i] = a[0]; kf[4 * i + 1] = a[1]; kf[4 * i + 2] = a[2]; kf[4 * i + 3] = a[3]; vf[4 * i] = c[0]; vf[4 * i + 1] = c[1]; vf[4 * i + 2] = c[2]; vf[4 * i + 3] = c[3]; }
                if (r >= 4) { const size_t oo = ((size_t)(b * 128 + r - 4) * NKV + hk) * HD + half * 32; glb_put32(A.out + O_KS + oo, kf); glb_put32(A.out + O_VS + oo, vf); }
            } else if (r < 132) {
                const bf16* zr = A.Z + (size_t)(MP + b * DS + (r - 128)) * ZW + hk * HD + half * 32;
                v4u kr[4], vr[4];
#pragma unroll
                for (int i = 0; i < 4; ++i) { kr[i] = *(const v4u*)(zr + 1024 + 8 * i); vr[i] = *(const v4u*)(zr + 1280 + 8 * i); }
                knorm32(kr, gk + half * 32, kf);
#pragma unroll
                for (int i = 0; i < 4; ++i)
#pragma unroll
                    for (int e = 0; e < 4; ++e) { vf[8 * i + 2 * e] = bf_lo(vr[i][e]); vf[8 * i + 2 * e + 1] = bf_hi(vr[i][e]); }
                const size_t oo = ((size_t)(b * 128 + r - 4) * NKV + hk) * HD + half * 32; glb_put32(A.out + O_KS + oo, kf); glb_put32(A.out + O_VS + oo, vf);
            } else {
#pragma unroll
                for (int i = 0; i < 32; ++i) { kf[i] = 0.f; vf[i] = 0.f; }
            }
            lds_put32(kd, kf); lds_put32(vd, vf);
        }
    }
    __syncthreads();
    if (wave < 2) {
        const int hk = 2 * hp + wave, r32 = lane & 31, h = lane >> 5, g = (r32 >> 2) & 3, i = r32 & 3, head = hk * 4 + g;
        const size_t row = (size_t)MP + b * DS + i;
        v4u qraw[4]; q_issue(A.Z + row * ZW + head * HD, h, qraw);
        bf16x8 qf[4]; q_finish(qraw, h, gq, qf);
        f32x16 o[2];
        attn_core(Kt + wave * (160 * KV_RS), Vt + wave * (160 * KV_RS), 0, i, 0, qf, A.sinks[head] * LOG2E, gq[128], lane, o);
        if (r32 < 16) store_o(A.MIX + row * DM + head * HD, h, o);
    }
    __syncthreads();
}

template <int TT>
__device__ __forceinline__ void conv_ln_store(f32x2 (&acc)[TT], f32x2 bdw, f32x2 gln, f32x2 bln, LAS float* red, LAS float* fin, bf16* mixrow0  , int tid) {
#pragma unroll
    for (int tt = 0; tt < TT; ++tt) { const f32x2 y = acc[tt] + bdw; acc[tt] = y; red[(2 * tt) * 512 + tid] = y.x + y.y; red[(2 * tt + 1) * 512 + tid] = y.x * y.x + y.y * y.y; }
    __syncthreads();
    {   constexpr int NV = 2 * TT, PER = 512 / NV;
        const int v = tid / PER, p = tid % PER; float s = 0.f;
#pragma unroll
        for (int k = 0; k < NV; ++k) s += red[v * 512 + k * PER + p];
#pragma unroll
        for (int o = 1; o < PER; o <<= 1) s += __shfl_xor(s, o);
        if constexpr (PER == 16) {
            const float q = __shfl_xor(s, 16);
            if ((tid & 31) == 0) { const float mean = s * (1.0f / CCH), var = q * (1.0f / CCH) - mean * mean; *(LAS f32x2*)(fin + 2 * (tid >> 5)) = (f32x2){mean, __builtin_amdgcn_rsqf(var + EPS)}; }
        } else { if (p == 0) fin[v] = s; } }
    __syncthreads();
#pragma unroll
    for (int tt = 0; tt < TT; ++tt) {
        f32x2 mr = *(const LAS f32x2*)(fin + 2 * tt);
        if constexpr (512 / (2 * TT) != 16) { const float mean = mr.x * (1.0f / CCH), var = mr.y * (1.0f / CCH) - mean * mean; mr = (f32x2){mean, __builtin_amdgcn_rsqf(var + EPS)}; }
        const f32x2 val = (acc[tt] - mr.x) * (gln * mr.y) + bln;
        const float o0 = val.x * __builtin_amdgcn_rcpf(1.0f + __expf(-val.x)), o1 = val.y * __builtin_amdgcn_rcpf(1.0f + __expf(-val.y));
        *(unsigned*)(mixrow0 + (size_t)tt * DM) = cvtpk(o0, o1);
    }
}
constexpr int CTT = 16;
__device__ __forceinline__ void conv_issue(const P2Args& A, int cu, int tid, unsigned (&raw)[CTT + 30]) {
    const int b = cu >> 7, t0 = (cu & 127) * CTT;
#pragma unroll
    for (int rr = 0; rr < CTT + 30; ++rr) { const int t = t0 - 30 + rr;
        const char* rowp = (t >= 0) ? (const char*)(A.U + (size_t)(b * SEQ + t) * CCH) : (const char*)A.zrow;
        raw[rr] = *(const unsigned*)(rowp + (unsigned)(4 * tid)); }
}
__device__ __forceinline__ void conv_prompt_all(const P2Args& A, LAS unsigned char* lds, const f32x2 (&w)[CW], f32x2 bdw, f32x2 gln, f32x2 bln, int first, int G, int NU, int tid) {
    LAS float* red = (LAS float*)lds; LAS float* fin = (LAS float*)(lds + 65536);
    const int c = 2 * tid;
    unsigned raw[CTT + 30];
    int cu = first;
    if (cu < NU) conv_issue(A, cu, tid, raw);
#pragma unroll 1
    for (; cu < NU; cu += G) {
        const int b = cu >> 7, t0 = (cu & 127) * CTT;
        f32x2 acc[CTT];
#pragma unroll
        for (int tt = 0; tt < CTT; ++tt) acc[tt] = (f32x2){0.f, 0.f};
#pragma unroll
        for (int rr = 0; rr < CTT + 30; ++rr) {
            const f32x2 u2 = (f32x2){bf_lo(raw[rr]), bf_hi(raw[rr])};
#pragma unroll
            for (int tt = 0; tt < CTT; ++tt) { const int j = rr - tt; if (j >= 0 && j < CW) acc[tt] += w[j] * u2; }
        }
        if (t0 + CTT > SEQ - 30) {
#pragma unroll
            for (int rr = 30; rr < CTT + 30; ++rr) { const int t = t0 - 30 + rr; if (t >= SEQ - 30) *(f32x2*)(A.out + O_CP + ((size_t)b * 30 + t - (SEQ - 30)) * CCH + c) = (f32x2){bf_lo(raw[rr]), bf_hi(raw[rr])}; }
        }
        if (cu + G < NU) conv_issue(A, cu + G, tid, raw);
        conv_ln_store<CTT>(acc, bdw, gln, bln, red, fin, A.MIX + (size_t)(b * SEQ + t0) * DM + 1024 + c, tid);
    }
}
__device__ __forceinline__ void conv_sample_unit(const P2Args& A, LAS unsigned char* lds, int b, const f32x2 (&w)[CW], f32x2 bdw, f32x2 gln, f32x2 bln, int tid) {
    LAS float* red = (LAS float*)lds; LAS float* fin = (LAS float*)(lds + 65536);
    const int c = 2 * tid;
    f32x2 ue[30 + DS];
#pragma unroll
    for (int rr = 0; rr < 30; ++rr) ue[rr] = *(const f32x2*)(A.sc + ((size_t)b * 30 + rr) * CCH + c);
#pragma unroll
    for (int rr = 0; rr < DS; ++rr) { const unsigned raw = *(const unsigned*)(A.U + (size_t)(MP + b * DS + rr) * CCH + c); ue[30 + rr] = (f32x2){bf_lo(raw), bf_hi(raw)}; }
    f32x2 acc[DS];
#pragma unroll
    for (int tt = 0; tt < DS; ++tt) acc[tt] = (f32x2){0.f, 0.f};
#pragma unroll
    for (int rr = 0; rr < DS + 30; ++rr)
#pragma unroll
        for (int tt = 0; tt < DS; ++tt) { const int j = rr - tt; if (j >= 0 && j < CW) acc[tt] += w[j] * ue[rr]; }
#pragma unroll
    for (int rr = DS; rr < 30 + DS; ++rr) *(f32x2*)(A.out + O_CS + ((size_t)b * 30 + rr - DS) * CCH + c) = ue[rr];
    conv_ln_store<DS>(acc, bdw, gln, bln, red, fin, A.MIX + (size_t)(MP + b * DS) * DM + 1024 + c, tid);
}

__device__ __forceinline__ void run_p2(const P2Args& A, LAS unsigned char* lds, int bx, int G, int tid, int lane, int wave) {
    LAS float* gq = (LAS float*)(lds + 98304); LAS float* gk = gq + 64;
    if (tid < 64) { const float a = A.gq[tid], b = A.gk[tid]; gq[tid] = a; gk[tid] = b;
        float ma = fabsf(a), mb = fabsf(b);
#pragma unroll
        for (int o = 1; o < 64; o <<= 1) { ma = fmaxf(ma, __shfl_xor(ma, o)); mb = fmaxf(mb, __shfl_xor(mb, o)); }
        if (tid == 0) gq[128] = fmaxf(0.f, QSCALE * 64.0f * ma * mb - 64.0f); }
    __syncthreads();
    attn_prompt_all(A, lds, gq, gk, bx, G, tid, lane, wave);
#if PROBE == 4
    attn_prompt_all(A, lds, gq, gk, bx, G, tid, lane, wave);
#endif
    for (int su = bx; su < DB * 2; su += G) attn_sample_unit(A, lds, gq, gk, su >> 1, su & 1, tid, lane, wave);
#if PROBE == 6
    for (int su = bx; su < DB * 2; su += G) attn_sample_unit(A, lds, gq, gk, su >> 1, su & 1, tid, lane, wave);
#endif
    f32x2 w[CW];
#pragma unroll
    for (int j = 0; j < CW; ++j) w[j] = *(const f32x2*)(A.wdw + j * CCH + 2 * tid);
    const f32x2 bdw = *(const f32x2*)(A.bdw + 2 * tid), gln = *(const f32x2*)(A.gln + 2 * tid), bln = *(const f32x2*)(A.bln + 2 * tid);
    conv_prompt_all(A, lds, w, bdw, gln, bln, bx, G, MP / CTT, tid);
#if PROBE == 5
    conv_prompt_all(A, lds, w, bdw, gln, bln, bx, G, MP / CTT, tid);
#endif
    for (int cu = bx; cu < DB; cu += G) conv_sample_unit(A, lds, cu, w, bdw, gln, bln, tid);
#if PROBE == 6
    for (int cu = bx; cu < DB; cu += G) conv_sample_unit(A, lds, cu, w, bdw, gln, bln, tid);
#endif
}

template <int MODE> struct SEpi;
struct SgPtrs { bf16* Z; bf16* U; const float* rstd1; const float* xs; float* out; bf16* XB; float* ssqs; bf16* H; const float* r2; };
__device__ __forceinline__ void sg_store_bf16(bf16* p, float x) { *p = (bf16)f2bf(x); }
template <int MODE>
__device__ __forceinline__ void sg_epilogue(const SgPtrs& P, const float (&v)[2][4], int rs0  , int nblk  , int r) {
#pragma unroll
    for (int e = 0; e < 4; ++e) {
        const int rs = rs0 + e; const size_t row = (size_t)MP + rs;
        if (MODE == 0) { const float s = P.rstd1[row];
#pragma unroll
            for (int cb = 0; cb < 2; ++cb) sg_store_bf16(P.Z + row * ZW + 64 * nblk + 32 * cb + r, v[cb][e] * s); }
        if (MODE == 1) { const float s = P.rstd1[row]; const float a = v[0][e] * s, g = v[1][e] * s; sg_store_bf16(P.U + row * CCH + 32 * nblk + r, a * __builtin_amdgcn_rcpf(1.0f + __expf(-g))); }
        if (MODE == 2) {
#pragma unroll
            for (int cb = 0; cb < 2; ++cb) { const int col = 64 * nblk + 32 * cb + r; const float x1 = P.xs[(size_t)rs * DM + col] + v[cb][e];
                P.out[row * DM + col] = x1; sg_store_bf16(P.XB + row * DM + col, x1);
                float q = x1 * x1;
#pragma unroll
                for (int o = 1; o < 32; o <<= 1) q += __shfl_xor(q, o);
                if (r == 0) P.ssqs[(size_t)rs * 64 + 2 * nblk + cb] = q; } }
        if (MODE == 3) {
#pragma unroll
            for (int cb = 0; cb < 2; ++cb) { const float a = fmaxf(v[cb][e], 0.f); sg_store_bf16(P.H + row * FF + 64 * nblk + 32 * cb + r, a * a); } }
        if (MODE == 4) { const float s = P.r2[row];
#pragma unroll
            for (int cb = 0; cb < 2; ++cb) { float* o = P.out + row * DM + 64 * nblk + 32 * cb + r; *o = *o + s * v[cb][e]; } }
    }
}
#define SG_MMA(a0, a1, b0, b1) do { _Pragma("unroll") for (int j_ = 0; j_ < 4; ++j_) { \
        acc[0][0] = __builtin_amdgcn_mfma_f32_32x32x16_bf16(a0[j_], b0[j_], acc[0][0], 0, 0, 0); \
        acc[0][1] = __builtin_amdgcn_mfma_f32_32x32x16_bf16(a0[j_], b1[j_], acc[0][1], 0, 0, 0); \
        acc[1][0] = __builtin_amdgcn_mfma_f32_32x32x16_bf16(a1[j_], b0[j_], acc[1][0], 0, 0, 0); \
        acc[1][1] = __builtin_amdgcn_mfma_f32_32x32x16_bf16(a1[j_], b1[j_], acc[1][1], 0, 0, 0); } } while (0)
template <int MODE>
__device__ __forceinline__ void sgemm_tile(LAS unsigned char* lds, const SgPtrs& P, const bf16* A0  , const bf16* Bb0, const bf16* Bb1, int K, int mi, int nblk, int lane_, int wave) {
    int lane = lane_; asm volatile("" : "+v"(lane));
    const int r = lane & 31, h = lane >> 5, kw = K >> 3, ns = kw >> 6, lr = lane >> 3, lc = lane & 7;
    const unsigned goff = (unsigned)(lr * K + wave * kw) * 2u + (unsigned)lc * 16u, gp = (unsigned)(8 * K) * 2u;
    LAS unsigned char* wb = lds + wave * 16384;
    const int wofs0 = lr * 128 + ((lc ^ lr) * 16), wofs1 = lr * 128 + ((lc ^ lr ^ 1) * 16);
    const int rm = (r & 7) ^ ((r >> 3) & 1);
    __syncthreads();
    f32x16 acc[2][2];
#pragma unroll
    for (int i = 0; i < 2; ++i)
#pragma unroll
        for (int j = 0; j < 2; ++j) acc[i][j] = (f32x16){0.f, 0.f, 0.f, 0.f, 0.f, 0.f, 0.f, 0.f, 0.f, 0.f, 0.f, 0.f, 0.f, 0.f, 0.f, 0.f};
    v4u g[4][4];
#define SG_ISSUE(kb) do { _Pragma("unroll") for (int p_ = 0; p_ < 4; ++p_) { \
        g[0][p_] = *(const v4u*)((const char*)A0 + (goff + p_ * gp + (kb))); g[1][p_] = *(const v4u*)((const char*)A0 + (goff + (p_ + 4) * gp + (kb))); \
        g[2][p_] = *(const v4u*)((const char*)Bb0 + (goff + p_ * gp + (kb))); g[3][p_] = *(const v4u*)((const char*)Bb1 + (goff + p_ * gp + (kb))); } } while (0)
#define SG_WRITE() do { _Pragma("unroll") for (int b_ = 0; b_ < 4; ++b_) _Pragma("unroll") for (int p_ = 0; p_ < 4; ++p_) \
        *(LAS v4u*)(wb + b_ * 4096 + p_ * 1024 + ((p_ & 1) ? wofs1 : wofs0)) = g[b_][p_]; } while (0)
    SG_ISSUE(0u);
    SG_WRITE();
#pragma unroll 1
    for (int s = 0; s < ns; ++s) {
        const bool more = (s + 1 < ns);
        if (more) SG_ISSUE(128u * (unsigned)(s + 1));
        __builtin_amdgcn_sched_barrier(0);
        bf16x8 a0[4], a1[4], b0[4], b1[4];
#pragma unroll
        for (int j = 0; j < 4; ++j) { const int co = r * 128 + (((2 * j + h) ^ rm) * 16);
            a0[j] = *(const LAS bf16x8*)(wb + co); a1[j] = *(const LAS bf16x8*)(wb + 4096 + co); b0[j] = *(const LAS bf16x8*)(wb + 8192 + co); b1[j] = *(const LAS bf16x8*)(wb + 12288 + co); }
        SG_MMA(a0, a1, b0, b1);
        __builtin_amdgcn_sched_barrier(0);
        if (more) SG_WRITE();
    }
#undef SG_ISSUE
#undef SG_WRITE
    LAS float* red = (LAS float*)lds;
    __syncthreads();
#pragma unroll
    for (int rb = 0; rb < 2; ++rb)
#pragma unroll
        for (int cb = 0; cb < 2; ++cb)
#pragma unroll
            for (int g2 = 0; g2 < 16; ++g2) red[(wave * 64 + rb * 32 + cb * 16 + g2) * 64 + lane] = acc[rb][cb][g2];
    __syncthreads();
    const int rb = wave >> 2, q = wave & 3;
    float v[2][4];
#pragma unroll
    for (int cb = 0; cb < 2; ++cb)
#pragma unroll
        for (int e2 = 0; e2 < 4; ++e2) { float sm = 0.f;
#pragma unroll
            for (int ww = 0; ww < 8; ++ww) sm += red[(ww * 64 + rb * 32 + cb * 16 + 4 * q + e2) * 64 + lane];
            v[cb][e2] = sm; }
    sg_epilogue<MODE>(P, v, 64 * mi + 32 * rb + 8 * q + 4 * h, nblk, r);
}
#undef SG_MMA

struct Args { const float* in[18]; float* out; unsigned char* ws; };
__global__ void __launch_bounds__(NWAVES * 64, 2) fwd_kernel(Args args) {
    extern __shared__ __attribute__((aligned(16))) unsigned char lds_raw[];
    LAS unsigned char* lds = (LAS unsigned char*)lds_raw;
    volatile LAS unsigned* MISC = (volatile LAS unsigned*)(lds + MISC_OFF);
    const int tid = threadIdx.x, lane = tid & 63, wave = __builtin_amdgcn_readfirstlane(tid >> 6);
    const int G = gridDim.x, bx = blockIdx.x;
    unsigned char* ws = args.ws;
    unsigned* ctl = (unsigned*)(ws + WS_CTL);
    const float* xp = args.in[0]; const float* xs = args.in[1];
    bf16* Wi = (bf16*)(ws + WS_WIN); bf16* Wo = (bf16*)(ws + WS_WOUT); bf16* Wu = (bf16*)(ws + WS_WUP); bf16* Wd = (bf16*)(ws + WS_WDN);
    float* rstd1 = (float*)(ws + WS_RSTD1); float* r2 = (float*)(ws + WS_R2); float* ssq = (float*)(ws + WS_SSQ); float* ssqs = (float*)(ws + WS_SSQS);
    bf16* XB = (bf16*)(ws + WS_XB); bf16* Z = (bf16*)(ws + WS_Z); bf16* U = (bf16*)(ws + WS_U); bf16* MIX = (bf16*)(ws + WS_MIX); bf16* H = (bf16*)(ws + WS_H);
    float* out = args.out;
    const SgPtrs SP{Z, U, rstd1, xs, out, XB, ssqs, H, r2};
    const int SG_XCD = bx & 7, SG_MI = (bx >> 3) >> 2, SG_NS = (bx >> 3) & 3;
    for (int u = tid; u < (LDS_BYTES - RING_BYTES) / 4; u += NWAVES * 64) ((LAS unsigned*)(lds + RING_BYTES))[u] = 0u;
    __syncthreads();
    XcdBarrier bar = xcd_barrier_post(ctl + CW_BAR, MISC + 8);
    const P0Mats Mx{args.in[6], args.in[5], args.in[14], args.in[16], args.in[15], args.in[17], Wi, Wo, Wu, Wd};
#define CONVERT_WEIGHTS(lo, hi) do { __syncthreads(); p0_weights(Mx, (LAS float*)(lds + wave * 16384), bx * NWAVES + wave, G * NWAVES, lane, (lo), (hi)); } while (0)

    for (int rep_ = 0; rep_ < (PROBE == 1 ? 2 : 1); ++rep_) {
        LAS float* scr = (LAS float*)(lds + wave * 16384);
        const int gw = bx * NWAVES + wave, NGW = G * NWAVES;
        p0_weights(Mx, scr, gw, NGW, lane, 0, P0_I_IN);
        p0_xrows(xp, xs, XB, rstd1, gw, NGW, lane);
    }
    xcd_barrier(bar);

    {
#define SGR_IN(lo, hi) for (int rd = (lo); rd < (hi); ++rd) { const int mi = SG_MI, ni = (rd * 8 + SG_XCD) * 4 + SG_NS; \
            if (ni < 24) sgemm_tile<0>(lds, SP, XB + (size_t)(MP + 64 * mi) * DM, Wi + (size_t)(64 * ni) * DM, Wi + (size_t)(64 * ni + 32) * DM, DM, mi, ni, lane, wave); \
            else if (ni < 56) { const int ci = ni - 24, ch = 32 * ci; const bf16* b0 = Wi + (size_t)(ZW + 256 * (ch >> 7) + (ch & 127)) * DM; \
                sgemm_tile<1>(lds, SP, XB + (size_t)(MP + 64 * mi) * DM, b0, b0 + (size_t)128 * DM, DM, mi, ci, lane, wave); } }
        const int nf = (SG_NS * 2) / 3;
        SGR_IN(0, nf);
        __syncthreads();
        pg8::Gemm g{XB, Wi, MP, INW, DM}; pg8::StaticOrder S; S.init(MP, INW, G, bx);
        pg8::EpiIn E{Z, U, rstd1};
        pg8::gemm_phase<pg8::EpiIn, pg8::StaticOrder, true, true>(lds, g, S, E);
        SGR_IN(nf, 2);
#undef SGR_IN
    }
    xcd_barrier(bar);

    {
        P2Args A{Z, U, MIX, args.in[2], args.in[3], args.in[4], args.in[7], args.in[8], args.in[9], args.in[10], args.in[11], args.in[12], args.in[13], out, (const bf16*)(ws + WS_ZROW)};
        run_p2(A, lds, bx, G, tid, lane, wave);
#if PROBE == 2
        run_p2(A, lds, bx, G, tid, lane, wave);
#endif
        CONVERT_WEIGHTS(P0_I_IN, P0_I_IN + P0_I_OUT);
    }
    xcd_barrier(bar);

    for (int rep_ = 0; rep_ < (PROBE == 3 ? 2 : 1); ++rep_) {
#define SGR_OUT(lo, hi) for (int rd = (lo); rd < (hi); ++rd) { const int mi = SG_MI, ni = SG_XCD * 4 + SG_NS; sgemm_tile<2>(lds, SP, MIX + (size_t)(MP + 64 * mi) * DM, Wo + (size_t)(64 * ni) * DM, Wo + (size_t)(64 * ni + 32) * DM, DM, mi, ni, lane, wave); }
        const int nf = SG_NS & 1;
        SGR_OUT(0, nf);
        __syncthreads();
        pg8::Gemm g{MIX, Wo, MP, DM, DM}; pg8::StaticOrder S; S.init(MP, DM, G, bx, 4);
        pg8::EpiOut E{xp, xs, out, XB, ssq};
        pg8::gemm_phase<pg8::EpiOut, pg8::StaticOrder, true, true>(lds, g, S, E);
        SGR_OUT(nf, 1);
#undef SGR_OUT
    }
    CONVERT_WEIGHTS(P0_I_IN + P0_I_OUT, P0_I_IN + P0_I_OUT + P0_I_UP);
    xcd_barrier(bar);

    {
        for (int row = bx * (NWAVES * 64) + tid; row < M; row += G * NWAVES * 64) {
            float s = 0.f;
            if (row < MP) { const f32x4* p = (const f32x4*)(ssq + (size_t)row * 32);
#pragma unroll
                for (int i = 0; i < 8; ++i) { const f32x4 v = p[i]; s += (v.x + v.y) + (v.z + v.w); } }
            else { const f32x4* p = (const f32x4*)(ssqs + (size_t)(row - MP) * 64);
#pragma unroll
                for (int i = 0; i < 16; ++i) { const f32x4 v = p[i]; s += (v.x + v.y) + (v.z + v.w); } }
            r2[row] = 1.0f / (s * (1.0f / DM) + EPS);
        }
#define SGR_UP(lo, hi) for (int rd = (lo); rd < (hi); ++rd) { const int mi = SG_MI, ni = (rd * 8 + SG_XCD) * 4 + SG_NS; sgemm_tile<3>(lds, SP, XB + (size_t)(MP + 64 * mi) * DM, Wu + (size_t)(64 * ni) * DM, Wu + (size_t)(64 * ni + 32) * DM, DM, mi, ni, lane, wave); }
        const int nf = SG_NS;
        SGR_UP(0, nf);
        __syncthreads();
        pg8::Gemm g{XB, Wu, MP, FF, DM}; pg8::StaticOrder S; S.init(MP, FF, G, bx);
        pg8::EpiUp E{H};
        pg8::gemm_phase<pg8::EpiUp, pg8::StaticOrder, true, true>(lds, g, S, E);
        SGR_UP(nf, 4);
#undef SGR_UP
    }
    CONVERT_WEIGHTS(P0_I_IN + P0_I_OUT + P0_I_UP, P0_NITEMS);
    xcd_barrier(bar);

    {
#define SGR_DN(lo, hi) for (int rd = (lo); rd < (hi); ++rd) { const int mi = SG_MI, ni = SG_XCD * 4 + SG_NS; sgemm_tile<4>(lds, SP, H + (size_t)(MP + 64 * mi) * FF, Wd + (size_t)(64 * ni) * FF, Wd + (size_t)(64 * ni + 32) * FF, FF, mi, ni, lane, wave); }
        const int nf = SG_NS & 1;
        SGR_DN(0, nf);
        __syncthreads();
        pg8::Gemm g{H, Wd, MP, DM, FF}; pg8::StaticOrder S; S.init(MP, DM, G, bx, 4);
        pg8::EpiDown E{out, r2, XB};
        pg8::gemm_phase<pg8::EpiDown, pg8::StaticOrder, true, true>(lds, g, S, E);
        SGR_DN(nf, 1);
#undef SGR_DN
    }
}

extern "C" void kernel_launch(void* const* d_in, const int* in_sizes, int n_in, void* d_out, int out_size, void* d_ws, size_t ws_size, hipStream_t stream) {
    static int grid = 0;
    if (grid == 0) {
        if (n_in != 18 || (size_t)out_size != O_END || ws_size < WS_END) { fprintf(stderr, "kernel_launch: unexpected shapes (n_in %d, out %d, ws %zu); nothing launched\n", n_in, out_size, ws_size); grid = -1; return; }
        int dev = 0, cus = 0, per_cu = 0;
        if (hipGetDevice(&dev) != hipSuccess || hipDeviceGetAttribute(&cus, hipDeviceAttributeMultiprocessorCount, dev) != hipSuccess) { grid = -1; return; }
        if (hipFuncSetAttribute((const void*)fwd_kernel, hipFuncAttributeMaxDynamicSharedMemorySize, LDS_BYTES) != hipSuccess) { fprintf(stderr, "kernel_launch: hipFuncSetAttribute failed\n"); grid = -1; return; }
        if (hipOccupancyMaxActiveBlocksPerMultiprocessor(&per_cu, (const void*)fwd_kernel, NWAVES * 64, LDS_BYTES) != hipSuccess || per_cu < 1) { fprintf(stderr, "kernel_launch: occupancy query reports %d\n", per_cu); }
        (void)hipGetLastError();
        if (cus < 256) { fprintf(stderr, "kernel_launch: built for a 256-CU device (got %d CUs); nothing launched\n", cus); grid = -1; return; }
        grid = 256;
    }
    if (grid < 0) return;
    if (hipMemsetAsync((char*)d_ws + WS_CTL, 0, CTL_ZERO_BYTES, stream) != hipSuccess) return;
    Args a{};
    for (int i = 0; i < 18; ++i) a.in[i] = (const float*)d_in[i];
    a.out = (float*)d_out; a.ws = (unsigned char*)d_ws;
    hipLaunchKernelGGL(fwd_kernel, dim3(grid), dim3(NWAVES * 64), LDS_BYTES, stream, a);
}
```

```cpp
#include <hip/hip_runtime.h>
#include <cstdio>
#include <cstdint>
#ifndef RES_BF16
#define RES_BF16 1
#endif
#ifndef PROBE
#define PROBE 0
#endif
namespace pg8 {
#define PG8_LAS __attribute__((address_space(3)))
typedef unsigned short bf16_t;
typedef short bf16x8 __attribute__((ext_vector_type(8)));
typedef float f32x4 __attribute__((ext_vector_type(4)));
typedef unsigned u32x4 __attribute__((ext_vector_type(4)));
constexpr int BM = 256, BK = 64, HALF = 128, HTB = HALF * BK * 2  , STAGE_BYTES = 8 * HTB, NXCD = 8, WGM = 8;

__host__ __device__ __forceinline__ int lds_byte(int r, int c) { const int st = (r >> 4) * 2 + (c >> 5), rr = r & 15, cc = c & 31, ob = rr * 64 + cc * 2; return st * 1024 + (ob ^ (((ob >> 9) & 1) << 5)); }
__host__ __device__ __forceinline__ void stage_rc(int b, int& R, int& C) { const int st = b / 1024, sb = b % 1024, swz = sb ^ (((sb >> 9) & 1) << 5); R = (st >> 1) * 16 + swz / 64; C = (st & 1) * 32 + (swz % 64) / 2; }
__host__ __device__ __forceinline__ int perm32(int rho) { const int n = rho >> 4, i = rho & 15; return 8 * (i >> 2) + 4 * n + (i & 3); }

struct Unit { int pm, pn; };
struct Gemm { const bf16_t* A; const bf16_t* Bt; int M, N, K; };

struct StaticOrder {
    int nM, nN, nwg, G, c, wgm, rev;
    __host__ __device__ void init(int M, int N, int G_, int c_, int wgm_ = WGM, int rev_ = 0) { nM = M / BM; nN = N / BM; nwg = nM * nN; G = G_; c = c_; wgm = wgm_; rev = rev_; }
    __host__ __device__ bool next(int i, Unit& u) const {
        if ((long)i * G + c >= nwg) return false;
        const int nr = (nwg - c + G - 1) / G; const long L = (long)(rev ? nr - 1 - i : i) * G + c;
        int wgid = (int)L; { const int q = nwg / NXCD, r = nwg % NXCD, xcd = wgid % NXCD, off = wgid / NXCD; wgid = (xcd < r ? xcd * (q + 1) : r * (q + 1) + (xcd - r) * q) + off; }
        const int nig = wgm * nN, gid = wgid / nig, fm = gid * wgm, gsz = (nM - fm) < wgm ? (nM - fm) : wgm;
        u.pm = fm + ((wgid % nig) % gsz); u.pn = (wgid % nig) / gsz; return true;
    }
    __device__ __forceinline__ void a_ready(const Unit&) const {}
    __device__ __forceinline__ void done(const Unit&) const {}
};

__device__ __forceinline__ unsigned cvt_pk_bf16(float lo, float hi) { unsigned r; asm volatile("v_cvt_pk_bf16_f32 %0, %1, %2" : "=v"(r) : "v"(lo), "v"(hi)); return r; }
typedef float f32x2 __attribute__((ext_vector_type(2)));
struct EpiIn {
    static constexpr bool PERM = true, AFTER_DRAIN = false;
    bf16_t* Z; bf16_t* U; const float* rstd;
    __device__ __forceinline__ void operator()(const f32x4 (&acc)[2][2][4][2], const Unit& u, int wr, int wc, int fr, int fq) const {
        const int row0 = u.pm * BM + wr * 64 + fr;
        if (u.pn < 6) {
            const int col0 = u.pn * BM + wc * 32 + 8 * fq;
#pragma unroll
            for (int ai = 0; ai < 2; ++ai)
#pragma unroll
                for (int m = 0; m < 4; ++m) { const int row = row0 + ai * HALF + m * 16; const float rs = rstd[row]; bf16_t* rowp = Z + (size_t)row * 1536 + col0;
#pragma unroll
                    for (int bj = 0; bj < 2; ++bj) { const f32x4 v0 = acc[ai][bj][m][0] * rs, v1 = acc[ai][bj][m][1] * rs;
                        u32x4 w; w.x = cvt_pk_bf16(v0[0], v0[1]); w.y = cvt_pk_bf16(v0[2], v0[3]); w.z = cvt_pk_bf16(v1[0], v1[1]); w.w = cvt_pk_bf16(v1[2], v1[3]);
                        *(u32x4*)(rowp + bj * HALF) = w; } }
        } else {
            const int c0 = (u.pn - 6) * HALF + wc * 32 + 8 * fq;
#pragma unroll
            for (int ai = 0; ai < 2; ++ai)
#pragma unroll
                for (int m = 0; m < 4; ++m) { const int row = row0 + ai * HALF + m * 16; const float rs = rstd[row];
                    float o[8];
#pragma unroll
                    for (int n = 0; n < 2; ++n)
#pragma unroll
                        for (int e = 0; e < 4; ++e) { const float a = acc[ai][0][m][n][e] * rs, g = acc[ai][1][m][n][e] * rs; o[n * 4 + e] = a * __builtin_amdgcn_rcpf(1.0f + __expf(-g)); }
                    u32x4 w; w.x = cvt_pk_bf16(o[0], o[1]); w.y = cvt_pk_bf16(o[2], o[3]); w.z = cvt_pk_bf16(o[4], o[5]); w.w = cvt_pk_bf16(o[6], o[7]);
                    *(u32x4*)(U + (size_t)row * 1024 + c0) = w; }
        }
    }
};
struct EpiOut {
#if RES_BF16
    static constexpr bool PERM = true, AFTER_DRAIN = false;
    const float* xp; const float* xs; float* out; bf16_t* XB; float* ssq;
    __device__ __forceinline__ void operator()(const f32x4 (&acc)[2][2][4][2], const Unit& u, int wr, int wc, int fr, int fq) const {
        const int row0 = u.pm * BM + wr * 64 + fr, col0 = u.pn * BM + wc * 32 + 8 * fq;
#pragma unroll
        for (int ai = 0; ai < 2; ++ai) {
            u32x4 xr[4][2];
#pragma unroll
            for (int m = 0; m < 4; ++m) { const size_t ro = (size_t)(row0 + ai * HALF + m * 16) * 2048 + col0;
#pragma unroll
                for (int bj = 0; bj < 2; ++bj) xr[m][bj] = *(const u32x4*)(XB + ro + bj * HALF); }
            __builtin_amdgcn_sched_barrier(0);
#pragma unroll
            for (int m = 0; m < 4; ++m) { const int row = row0 + ai * HALF + m * 16; const size_t ro = (size_t)row * 2048 + col0; float q = 0.f;
#pragma unroll
                for (int bj = 0; bj < 2; ++bj) { const u32x4 xw = xr[m][bj];
                    const f32x4 x0 = (f32x4){__builtin_bit_cast(float, xw.x << 16), __builtin_bit_cast(float, xw.x & 0xffff0000u), __builtin_bit_cast(float, xw.y << 16), __builtin_bit_cast(float, xw.y & 0xffff0000u)};
                    const f32x4 x1 = (f32x4){__builtin_bit_cast(float, xw.z << 16), __builtin_bit_cast(float, xw.z & 0xffff0000u), __builtin_bit_cast(float, xw.w << 16), __builtin_bit_cast(float, xw.w & 0xffff0000u)};
                    const f32x4 v0 = acc[ai][bj][m][0] + x0, v1 = acc[ai][bj][m][1] + x1;
                    u32x4 w; w.x = cvt_pk_bf16(v0[0], v0[1]); w.y = cvt_pk_bf16(v0[2], v0[3]); w.z = cvt_pk_bf16(v1[0], v1[1]); w.w = cvt_pk_bf16(v1[2], v1[3]);
                    *(u32x4*)(XB + ro + bj * HALF) = w;
                    q += (v0[0] * v0[0] + v0[1] * v0[1]) + (v0[2] * v0[2] + v0[3] * v0[3]) + (v1[0] * v1[0] + v1[1] * v1[1]) + (v1[2] * v1[2] + v1[3] * v1[3]); }
                q += __shfl_xor(q, 16); q += __shfl_xor(q, 32);
                if (fq == 0) ssq[(size_t)row * 32 + u.pn * 4 + wc] = q; }
            __builtin_amdgcn_sched_barrier(0);
        }
    }
#else
    static constexpr bool PERM = false, AFTER_DRAIN = false;
    const float* xp; const float* xs; float* out; bf16_t* XB; float* ssq;
    __device__ __forceinline__ void operator()(const f32x4 (&acc)[2][2][4][2], const Unit& u, int wr, int wc, int fr, int fq) const {
        typedef unsigned u32x2 __attribute__((ext_vector_type(2)));
        const int row0 = u.pm * BM + wr * 64 + fr, col0 = u.pn * BM + wc * 32 + 4 * fq;
        const float* xb = (u.pm < 128) ? xp : (xs - (size_t)32768 * 2048);
#pragma unroll
        for (int ai = 0; ai < 2; ++ai) {
            f32x4 xr[4][2][2];
#pragma unroll
            for (int m = 0; m < 4; ++m) { const size_t ro = (size_t)(row0 + ai * HALF + m * 16) * 2048 + col0;
#pragma unroll
                for (int bj = 0; bj < 2; ++bj) { xr[m][bj][0] = *(const f32x4*)(xb + ro + bj * HALF); xr[m][bj][1] = *(const f32x4*)(xb + ro + bj * HALF + 16); } }
            __builtin_amdgcn_sched_barrier(0);
#pragma unroll
            for (int m = 0; m < 4; ++m) { const int row = row0 + ai * HALF + m * 16; const size_t ro = (size_t)row * 2048 + col0; float q = 0.f;
#pragma unroll
                for (int bj = 0; bj < 2; ++bj)
#pragma unroll
                    for (int n = 0; n < 2; ++n) { const f32x4 v = acc[ai][bj][m][n] + xr[m][bj][n];
                        *(f32x4*)(out + ro + bj * HALF + n * 16) = v;
                        u32x2 w; w.x = cvt_pk_bf16(v[0], v[1]); w.y = cvt_pk_bf16(v[2], v[3]);
                        *(u32x2*)(XB + ro + bj * HALF + n * 16) = w;
                        q += (v[0] * v[0] + v[1] * v[1]) + (v[2] * v[2] + v[3] * v[3]); }
                q += __shfl_xor(q, 16); q += __shfl_xor(q, 32);
                if (fq == 0) ssq[(size_t)row * 32 + u.pn * 4 + wc] = q; }
            __builtin_amdgcn_sched_barrier(0);
        }
    }
#endif
};
struct EpiUp {
    static constexpr bool PERM = true, AFTER_DRAIN = false;
    bf16_t* H;
    __device__ __forceinline__ void operator()(const f32x4 (&acc)[2][2][4][2], const Unit& u, int wr, int wc, int fr, int fq) const {
        const int row0 = u.pm * BM + wr * 64 + fr, col0 = u.pn * BM + wc * 32 + 8 * fq;
#pragma unroll
        for (int ai = 0; ai < 2; ++ai)
#pragma unroll
            for (int m = 0; m < 4; ++m) { bf16_t* rowp = H + (size_t)(row0 + ai * HALF + m * 16) * 8192 + col0;
#pragma unroll
                for (int bj = 0; bj < 2; ++bj) { f32x4 v0 = acc[ai][bj][m][0], v1 = acc[ai][bj][m][1];
#pragma unroll
                    for (int e = 0; e < 4; ++e) { const float a = fmaxf(v0[e], 0.f), b = fmaxf(v1[e], 0.f); v0[e] = a * a; v1[e] = b * b; }
                    u32x4 w; w.x = cvt_pk_bf16(v0[0], v0[1]); w.y = cvt_pk_bf16(v0[2], v0[3]); w.z = cvt_pk_bf16(v1[0], v1[1]); w.w = cvt_pk_bf16(v1[2], v1[3]);
                    *(u32x4*)(rowp + bj * HALF) = w; } }
    }
};
struct EpiDown {
    static constexpr bool PERM = false, AFTER_DRAIN = false;
    float* out; const float* r2; const bf16_t* XB;
    __device__ __forceinline__ void operator()(const f32x4 (&acc)[2][2][4][2], const Unit& u, int wr, int wc, int fr, int fq) const {
        typedef unsigned u32x2 __attribute__((ext_vector_type(2)));
        const int row0 = u.pm * BM + wr * 64 + fr, col0 = u.pn * BM + wc * 32 + 4 * fq;
#pragma unroll
        for (int ai = 0; ai < 2; ++ai) {
#if RES_BF16
            u32x2 xr[4][2][2]; float sc[4];
#pragma unroll
            for (int m = 0; m < 4; ++m) { const int row = row0 + ai * HALF + m * 16; const bf16_t* rowp = XB + (size_t)row * 2048 + col0; sc[m] = r2[row];
#pragma unroll
                for (int bj = 0; bj < 2; ++bj) { xr[m][bj][0] = *(const u32x2*)(rowp + bj * HALF); xr[m][bj][1] = *(const u32x2*)(rowp + bj * HALF + 16); } }
            __builtin_amdgcn_sched_barrier(0);
#pragma unroll
            for (int m = 0; m < 4; ++m) { float* rowp = out + (size_t)(row0 + ai * HALF + m * 16) * 2048 + col0;
#pragma unroll
                for (int bj = 0; bj < 2; ++bj)
#pragma unroll
                    for (int n = 0; n < 2; ++n) { const u32x2 w = xr[m][bj][n];
                        const f32x4 x = (f32x4){__builtin_bit_cast(float, w.x << 16), __builtin_bit_cast(float, w.x & 0xffff0000u), __builtin_bit_cast(float, w.y << 16), __builtin_bit_cast(float, w.y & 0xffff0000u)};
                        *(f32x4*)(rowp + bj * HALF + n * 16) = x + acc[ai][bj][m][n] * sc[m]; } }
            __builtin_amdgcn_sched_barrier(0);
#else
            f32x4 xr[4][2][2]; float sc[4];
#pragma unroll
            for (int m = 0; m < 4; ++m) { const int row = row0 + ai * HALF + m * 16; const float* rowp = out + (size_t)row * 2048 + col0; sc[m] = r2[row];
#pragma unroll
                for (int bj = 0; bj < 2; ++bj) { xr[m][bj][0] = *(const f32x4*)(rowp + bj * HALF); xr[m][bj][1] = *(const f32x4*)(rowp + bj * HALF + 16); } }
            __builtin_amdgcn_sched_barrier(0);
#pragma unroll
            for (int m = 0; m < 4; ++m) { float* rowp = out + (size_t)(row0 + ai * HALF + m * 16) * 2048 + col0;
#pragma unroll
                for (int bj = 0; bj < 2; ++bj) { *(f32x4*)(rowp + bj * HALF) = xr[m][bj][0] + acc[ai][bj][m][0] * sc[m]; *(f32x4*)(rowp + bj * HALF + 16) = xr[m][bj][1] + acc[ai][bj][m][1] * sc[m]; } }
            __builtin_amdgcn_sched_barrier(0);
#endif
        }
    }
};

template <class Epi, class Sched, bool ALIGN_EPI = false, bool SP2 = false>
__device__ __forceinline__ void gemm_phase(PG8_LAS unsigned char* lds, const Gemm g, const Sched& S, const Epi& E) {
    int tid_ = threadIdx.x; asm volatile("" : "+v"(tid_));
    const int tid = tid_, wid = __builtin_amdgcn_readfirstlane(tid >> 6), lane = tid & 63, wr = wid >> 2, wc = wid & 3, fr = lane & 15, fq = lane >> 4;
    const int K = g.K, nt = K / BK;
    unsigned voffA[2], voffB[2];
#pragma unroll
    for (int i = 0; i < 2; ++i) { int R, C; stage_rc(tid * 16 + i * 8192, R, C); const int Rb = Epi::PERM ? ((R & ~31) + perm32(R & 31)) : R;
        voffA[i] = (unsigned)(R * K + C) * 2u; voffB[i] = (unsigned)(Rb * K + C) * 2u; }
    const size_t kstep = (size_t)(BK * 2);
    const size_t hstep = (size_t)HALF * K * 2;
    const size_t tstep = 2 * hstep;
    const unsigned ldsw = (unsigned)wid * 1024u;
    const int aoff = lds_byte(wr * 64 + fr, fq * 8), boff = lds_byte(wc * 32 + fr, fq * 8);
#define PG8_SA(b, h) (((b) * 2 + (h)) * HTB)
#define PG8_SB(b, h) ((4 + (b) * 2 + (h)) * HTB)
#define PG8_STAGE(bufoff, gbase, voff) do { _Pragma("unroll") for (int _i = 0; _i < 2; ++_i) \
        __builtin_amdgcn_global_load_lds((const unsigned*)((const char*)(gbase) + (voff)[_i]), (PG8_LAS unsigned*)(lds + (bufoff) + ldsw + _i * 8192), 16, 0, 0); } while (0)
#define PG8_LDA(dst, b, h) do { _Pragma("unroll") for (int m = 0; m < 4; ++m) _Pragma("unroll") for (int k = 0; k < 2; ++k) dst[m][k] = *(const PG8_LAS bf16x8*)(lds + PG8_SA(b, h) + aoff + m * 2048 + k * 1024); } while (0)
#define PG8_LDB(dst, b, h) do { _Pragma("unroll") for (int n = 0; n < 2; ++n) _Pragma("unroll") for (int k = 0; k < 2; ++k) dst[n][k] = *(const PG8_LAS bf16x8*)(lds + PG8_SB(b, h) + boff + n * 2048 + k * 1024); } while (0)
#define PG8_MMA(ai, bj, At, Bt) do { __builtin_amdgcn_s_setprio(1); _Pragma("unroll") for (int m = 0; m < 4; ++m) _Pragma("unroll") for (int n = 0; n < 2; ++n) _Pragma("unroll") for (int k = 0; k < 2; ++k) \
        acc[ai][bj][m][n] = __builtin_amdgcn_mfma_f32_16x16x32_bf16(Bt[n][k], At[m][k], acc[ai][bj][m][n], 0, 0, 0); __builtin_amdgcn_s_setprio(0); } while (0)
#define PG8_WAIT_V(n) asm volatile("s_waitcnt vmcnt(" #n ")" ::: "memory")
#define PG8_WAIT_L(n) asm volatile("s_waitcnt lgkmcnt(" #n ")" ::: "memory")
#define PG8_BAR __builtin_amdgcn_s_barrier()
#define PG8_SCHED __builtin_amdgcn_sched_barrier(0)
    Unit cur, nxt; int ui = 0;
    if (!S.next(0, cur)) return;
    f32x4 acc[2][2][4][2];
#pragma unroll
    for (int a = 0; a < 2; ++a)
#pragma unroll
        for (int b = 0; b < 2; ++b)
#pragma unroll
            for (int m = 0; m < 4; ++m)
#pragma unroll
                for (int n = 0; n < 2; ++n) acc[a][b][m][n] = (f32x4){0.f, 0.f, 0.f, 0.f};
    bf16x8 At[4][2], B0[2][2], B1[2][2];
    const char* cA = (const char*)g.A + (size_t)cur.pm * tstep; const char* cB = (const char*)g.Bt + (size_t)cur.pn * tstep;
    S.a_ready(cur);
    if constexpr (SP2) {
        PG8_STAGE(PG8_SB(0, 0), cB, voffB); PG8_STAGE(PG8_SB(0, 1), cB + hstep, voffB); PG8_STAGE(PG8_SA(0, 0), cA, voffA); PG8_STAGE(PG8_SA(0, 1), cA + hstep, voffA);
        if (wr == 1) PG8_BAR;
        PG8_WAIT_V(2); PG8_BAR;
        PG8_STAGE(PG8_SB(1, 0), cB + kstep, voffB); PG8_STAGE(PG8_SA(1, 0), cA + kstep, voffA); PG8_STAGE(PG8_SB(1, 1), cB + hstep + kstep, voffB);
        PG8_WAIT_V(6); PG8_BAR;
    } else {
        PG8_STAGE(PG8_SB(0, 0), cB, voffB); PG8_STAGE(PG8_SA(0, 0), cA, voffA); PG8_STAGE(PG8_SB(0, 1), cB + hstep, voffB); PG8_STAGE(PG8_SA(0, 1), cA + hstep, voffA);
        if (wr == 1) PG8_BAR;
        PG8_WAIT_V(4); PG8_BAR;
        PG8_STAGE(PG8_SB(1, 0), cB + kstep, voffB); PG8_STAGE(PG8_SA(1, 0), cA + kstep, voffA); PG8_STAGE(PG8_SB(1, 1), cB + hstep + kstep, voffB);
        PG8_WAIT_V(6); PG8_BAR;
    }
    for (;;) {
        const bool has_next = S.next(ui + 1, nxt);
        const char* nA = has_next ? (const char*)g.A + (size_t)nxt.pm * tstep : cA; const char* nB = has_next ? (const char*)g.Bt + (size_t)nxt.pn * tstep : cB;
        for (int t = 0; t < nt; t += 2) {
            const bool last = (t == nt - 2);
            const char* a1 = cA + (size_t)(t + 1) * kstep;
            const char* a2 = last ? nA : cA + (size_t)(t + 2) * kstep; const char* b2 = last ? nB : cB + (size_t)(t + 2) * kstep;
            const char* a3 = a2 + kstep; const char* b3 = b2 + kstep;
            if (last && has_next) S.a_ready(nxt);
            if constexpr (SP2) {
            PG8_LDB(B0, 0, 0); PG8_LDB(B1, 0, 1); PG8_SCHED; PG8_LDA(At, 0, 0); PG8_STAGE(PG8_SA(1, 1), a1 + hstep, voffA);
            PG8_WAIT_V(8); PG8_WAIT_L(0); PG8_BAR; PG8_MMA(0, 0, At, B0); PG8_MMA(0, 1, At, B1); PG8_BAR; PG8_SCHED;
            PG8_LDA(At, 0, 1); PG8_STAGE(PG8_SB(0, 0), b2, voffB); PG8_STAGE(PG8_SB(0, 1), b2 + hstep, voffB); PG8_STAGE(PG8_SA(0, 0), a2, voffA);
            PG8_WAIT_V(8); PG8_WAIT_L(0); PG8_BAR; PG8_MMA(1, 0, At, B0); PG8_MMA(1, 1, At, B1); PG8_BAR; PG8_SCHED;
            PG8_LDB(B0, 1, 0); PG8_LDB(B1, 1, 1); PG8_SCHED; PG8_LDA(At, 1, 0); PG8_STAGE(PG8_SA(0, 1), a2 + hstep, voffA);
            PG8_WAIT_V(8); PG8_WAIT_L(0); PG8_BAR; PG8_MMA(0, 0, At, B0); PG8_MMA(0, 1, At, B1); PG8_BAR; PG8_SCHED;
            PG8_LDA(At, 1, 1); PG8_STAGE(PG8_SB(1, 0), b3, voffB); PG8_STAGE(PG8_SB(1, 1), b3 + hstep, voffB); PG8_STAGE(PG8_SA(1, 0), a3, voffA);
            PG8_WAIT_V(8); PG8_WAIT_L(0); PG8_BAR; PG8_MMA(1, 0, At, B0); PG8_MMA(1, 1, At, B1); PG8_BAR; PG8_SCHED;
            } else {
            PG8_LDB(B0, 0, 0); PG8_SCHED; PG8_LDA(At, 0, 0); PG8_STAGE(PG8_SA(1, 1), a1 + hstep, voffA);
            PG8_WAIT_L(8); PG8_BAR; PG8_WAIT_L(0); PG8_MMA(0, 0, At, B0); PG8_BAR; PG8_SCHED;
            PG8_LDB(B1, 0, 1); PG8_STAGE(PG8_SB(0, 0), b2, voffB);
            PG8_BAR; PG8_WAIT_L(0); PG8_MMA(0, 1, At, B1); PG8_BAR;
            PG8_LDA(At, 0, 1); PG8_STAGE(PG8_SA(0, 0), a2, voffA);
            PG8_BAR; PG8_WAIT_L(0); PG8_MMA(1, 0, At, B0); PG8_BAR; PG8_SCHED;
            PG8_STAGE(PG8_SB(0, 1), b2 + hstep, voffB);
            PG8_WAIT_V(6); PG8_BAR; PG8_MMA(1, 1, At, B1); PG8_BAR;
            PG8_LDB(B0, 1, 0); PG8_SCHED; PG8_LDA(At, 1, 0); PG8_STAGE(PG8_SA(0, 1), a2 + hstep, voffA);
            PG8_WAIT_L(8); PG8_BAR; PG8_WAIT_L(0); PG8_MMA(0, 0, At, B0); PG8_BAR; PG8_SCHED;
            PG8_LDB(B1, 1, 1); PG8_STAGE(PG8_SB(1, 0), b3, voffB);
            PG8_BAR; PG8_WAIT_L(0); PG8_MMA(0, 1, At, B1); PG8_BAR;
            PG8_LDA(At, 1, 1); PG8_STAGE(PG8_SA(1, 0), a3, voffA);
            PG8_BAR; PG8_WAIT_L(0); PG8_MMA(1, 0, At, B0); PG8_BAR; PG8_SCHED;
            PG8_STAGE(PG8_SB(1, 1), b3 + hstep, voffB);
            PG8_WAIT_V(6); PG8_BAR; PG8_MMA(1, 1, At, B1); PG8_BAR;
            }
        }
        if constexpr (ALIGN_EPI) { if (wr == 0) PG8_BAR; }
        if constexpr (!Epi::AFTER_DRAIN) { E(acc, cur, wr, wc, fr, fq); S.done(cur); }
        if (!has_next) break;
#pragma unroll
        for (int a = 0; a < 2; ++a)
#pragma unroll
            for (int b = 0; b < 2; ++b)
#pragma unroll
                for (int m = 0; m < 4; ++m)
#pragma unroll
                    for (int n = 0; n < 2; ++n) acc[a][b][m][n] = (f32x4){0.f, 0.f, 0.f, 0.f};
        cur = nxt; cA = nA; cB = nB; ++ui;
        if constexpr (ALIGN_EPI) { if (wr == 1) PG8_BAR; }
    }
    PG8_WAIT_V(0);
    if constexpr (!ALIGN_EPI) { if (wr == 0) PG8_BAR; }
    PG8_BAR;
    if constexpr (Epi::AFTER_DRAIN) { E.fused(acc, cur, wr, wc, fr, fq, lds, wid, lane); S.done(cur); }
#undef PG8_SA
#undef PG8_SB
#undef PG8_STAGE
#undef PG8_LDA
#undef PG8_LDB
#undef PG8_MMA
#undef PG8_WAIT_V
#undef PG8_WAIT_L
#undef PG8_BAR
#undef PG8_SCHED
}
}

constexpr int NWAVES = 8;
constexpr int DM = 2048, NB = 16, SEQ = 2048, DB = 128, DS = 4, HD = 64, NH = 16, NKV = 4, CCH = 1024, CW = 31, FF = 8192;
constexpr int MP = NB * SEQ, MS = DB * DS, M = MP + MS;
constexpr int INW = 3584, ZW = 1536;
constexpr float EPS = 1e-6f;
constexpr float QSCALE = 0.125f * 1.4426950408889634f;
constexpr float LOG2E = 1.4426950408889634f;
constexpr size_t O_Y = 0, O_KP = (size_t)M * DM, O_VP = O_KP + (size_t)NB * 128 * 256, O_CP = O_VP + (size_t)NB * 128 * 256,
                 O_KS = O_CP + (size_t)NB * 30 * CCH, O_VS = O_KS + (size_t)DB * 128 * 256, O_CS = O_VS + (size_t)DB * 128 * 256, O_END = O_CS + (size_t)DB * 30 * CCH;
constexpr size_t MiB = 1u << 20;
constexpr size_t WS_CTL = 0, CTL_ZERO_BYTES = 64 * 1024, WS_ZROW = 48 * 1024;
constexpr size_t WS_WIN = 1 * MiB, WS_WOUT = 15 * MiB, WS_WUP = 23 * MiB, WS_WDN = 55 * MiB;
constexpr size_t WS_RSTD1 = 87 * MiB, WS_R2 = 88 * MiB, WS_SSQS = 88 * MiB + 512 * 1024, WS_SSQ = 89 * MiB;
constexpr size_t WS_XB = 94 * MiB;
constexpr size_t WS_Z = 224 * MiB, WS_U = 322 * MiB, WS_MIX = 387 * MiB;
constexpr size_t WS_H = 224 * MiB, WS_END = 744 * MiB;
static_assert(WS_Z + (size_t)M * ZW * 2 <= WS_U && WS_U + (size_t)M * CCH * 2 <= WS_MIX && WS_MIX + (size_t)M * DM * 2 <= WS_END && WS_H + (size_t)M * FF * 2 <= WS_END, "d_ws map");
static_assert(WS_XB + (size_t)M * DM * 2 <= WS_Z && WS_SSQ + (size_t)M * 32 * 4 <= WS_XB && WS_WIN + (size_t)INW * DM * 2 <= WS_WOUT, "d_ws map");
constexpr int CW_BAR = 4096;
constexpr int RING_BYTES = 131072, MISC_OFF = RING_BYTES + 320, LDS_BYTES = 147456;
#define GAS __attribute__((address_space(1)))
#define LAS __attribute__((address_space(3)))
typedef unsigned short bf16;
typedef unsigned v4u __attribute__((ext_vector_type(4)));
typedef float f32x4 __attribute__((ext_vector_type(4)));
typedef short bf16x8 __attribute__((ext_vector_type(8)));
typedef GAS unsigned gu32;
typedef GAS unsigned long long gu64;
#define RLX_AGENT __ATOMIC_RELAXED, __HIP_MEMORY_SCOPE_AGENT
#define LDS_WAIT() asm volatile("s_waitcnt lgkmcnt(0)" ::: "memory")
#define VM_WAIT() asm volatile("s_waitcnt vmcnt(0)" ::: "memory")
__device__ __forceinline__ unsigned long long rt() { return __builtin_amdgcn_s_memrealtime(); }
__device__ __forceinline__ unsigned f2bf(float f) { unsigned u = __builtin_bit_cast(unsigned, f); return (u + 0x7fffu + ((u >> 16) & 1u)) >> 16; }
__device__ __forceinline__ unsigned pk2(float lo, float hi) { return f2bf(lo) | (f2bf(hi) << 16); }

#define XB_TMO      128
#define XB_XCNT(j)  (256  + 64 * (j))
#define XB_XSUB(j)  (1280 + 64 * (j))
#define XB_XGEN(j)  (2304 + 64 * (j))
#define XB_TOP      3328
#define XB_TOPGEN   3392
#define XCD_BAR_WORDS 3456
#define XB_SPIN_CAP (1u << 18)

__device__ __forceinline__ unsigned xb_ld(unsigned* p)              { return __hip_atomic_load(p, __ATOMIC_RELAXED, __HIP_MEMORY_SCOPE_AGENT); }
__device__ __forceinline__ unsigned xb_add(unsigned* p, unsigned v) { return __hip_atomic_fetch_add(p, v, __ATOMIC_RELAXED, __HIP_MEMORY_SCOPE_AGENT); }
__device__ __forceinline__ unsigned xb_xcc_id() { return (unsigned)__builtin_amdgcn_s_getreg((3 << 11) | 20) & 0xFu; }
#define XB_SPIN(cond, bar) do { unsigned _sp = 0; while (cond) { __builtin_amdgcn_s_sleep(1); \
    if ((++_sp & 255u) == 0u) { if (xb_ld(&(bar)[XB_TMO])) break; if (_sp > XB_SPIN_CAP) { atomicAdd(&(bar)[XB_TMO], 1u); break; } } } } while (0)

struct XcdBarrier {
    unsigned* bar; unsigned x;
    volatile LAS unsigned* st;
};

__device__ __forceinline__ XcdBarrier xcd_barrier_post(unsigned* bar, volatile LAS unsigned* st) {
    XcdBarrier b; b.bar = bar; b.x = xb_xcc_id(); b.st = st;
    if (threadIdx.x == 0) (void)xb_add(&bar[XB_XCNT(b.x)], 1u);
    return b;
}
__device__ __forceinline__ void xcd_barrier_complete(unsigned* bar, unsigned x, unsigned& nloc, unsigned& nx) {
    const unsigned G = gridDim.x * gridDim.y * gridDim.z;
    unsigned sum, cnt, mine, sp = 0u;
    for (;;) {
        sum = 0u; cnt = 0u; mine = 0u;
#pragma unroll
        for (unsigned j = 0; j < 16; ++j) { const unsigned c = xb_ld(&bar[XB_XCNT(j)]); sum += c; cnt += (c > 0u) ? 1u : 0u; mine = (j == x) ? c : mine; }
        if (sum == G) break;
        __builtin_amdgcn_s_sleep(1);
        if ((++sp & 255u) == 0u) { if (xb_ld(&bar[XB_TMO])) break; if (sp > XB_SPIN_CAP) { atomicAdd(&bar[XB_TMO], 1u); break; } }
    }
    nloc = mine > 0u ? mine : 1u; nx = cnt > 0u ? cnt : 1u;
}

__device__ __forceinline__ void xcd_barrier(const XcdBarrier& b) {
    asm volatile("s_waitcnt vmcnt(0)" ::: "memory");
    __syncthreads();
    if (threadIdx.x == 0) {
        unsigned* bar = b.bar;
        __builtin_amdgcn_s_waitcnt(0);
        unsigned nloc = b.st[0], nx = b.st[1];
        if (nloc == 0u) { xcd_barrier_complete(bar, b.x, nloc, nx); b.st[0] = nloc; b.st[1] = nx; }
        const unsigned old = xb_add(&bar[XB_XSUB(b.x)], 1u);
        const unsigned gen = old / nloc;
        if (old + 1u == (gen + 1u) * nloc) {
            __builtin_amdgcn_fence(__ATOMIC_RELEASE, "agent");
            asm volatile("s_waitcnt vmcnt(0)" ::: "memory");
            const unsigned og = xb_add(&bar[XB_TOP], 1u);
            const unsigned tg = og / nx;
            if (og + 1u == (tg + 1u) * nx) xb_add(&bar[XB_TOPGEN], 1u);
            else XB_SPIN(xb_ld(&bar[XB_TOPGEN]) == tg, bar);
            __builtin_amdgcn_fence(__ATOMIC_ACQUIRE, "agent");
            xb_add(&bar[XB_XGEN(b.x)], 1u);
            asm volatile("s_waitcnt vmcnt(0)" ::: "memory");
        } else {
            XB_SPIN(xb_ld(&bar[XB_XGEN(b.x)]) == gen, bar);
            __builtin_amdgcn_fence(__ATOMIC_ACQUIRE, "agent");
            asm volatile("s_waitcnt vmcnt(0)" ::: "memory");
        }
    }
    __syncthreads();
}

typedef float f32x2 __attribute__((ext_vector_type(2)));
typedef float f32x16 __attribute__((ext_vector_type(16)));
typedef short s16x4 __attribute__((ext_vector_type(4)));
__device__ __forceinline__ unsigned cvtpk(float lo, float hi) { unsigned r; asm volatile("v_cvt_pk_bf16_f32 %0, %1, %2" : "=v"(r) : "v"(lo), "v"(hi)); return r; }
__device__ __forceinline__ float bf_lo(unsigned u) { return __builtin_bit_cast(float, u << 16); }
__device__ __forceinline__ float bf_hi(unsigned u) { return __builtin_bit_cast(float, u & 0xffff0000u); }
__device__ __forceinline__ void fmac1(float& acc, float a, float b) { asm("v_fmac_f32 %0, %1, %2" : "+v"(acc) : "v"(a), "v"(b)); }
__device__ __forceinline__ float wave_sum(float v) {
#pragma unroll
    for (int o = 1; o < 64; o <<= 1) v += __shfl_xor(v, o);
    return v;
}

struct P0Item { const float* W; const float* gain; bf16* WT; int K, N, rowmap, k0, n0; };
struct P0Mats { const float *w_in, *g_in, *w_out, *w_up, *g_up, *w_dn; bf16 *Wi, *Wo, *Wu, *Wd; };
constexpr int P0_I_IN = (DM / 64) * (INW / 32), P0_I_OUT = (DM / 64) * (DM / 32), P0_I_UP = (DM / 64) * (FF / 32), P0_I_DN = (FF / 64) * (DM / 32), P0_NITEMS = P0_I_IN + P0_I_OUT + P0_I_UP + P0_I_DN;
__device__ __forceinline__ P0Item p0_item(const P0Mats& Mx, int it) {
    P0Item I; int r = it;
    if (r < P0_I_IN) { I.W = Mx.w_in; I.gain = Mx.g_in; I.WT = Mx.Wi; I.K = DM; I.N = INW; I.rowmap = 1; }
    else if ((r -= P0_I_IN) < P0_I_OUT) { I.W = Mx.w_out; I.gain = nullptr; I.WT = Mx.Wo; I.K = DM; I.N = DM; I.rowmap = 0; }
    else if ((r -= P0_I_OUT) < P0_I_UP) { I.W = Mx.w_up; I.gain = Mx.g_up; I.WT = Mx.Wu; I.K = DM; I.N = FF; I.rowmap = 0; }
    else { r -= P0_I_UP; I.W = Mx.w_dn; I.gain = nullptr; I.WT = Mx.Wd; I.K = FF; I.N = DM; I.rowmap = 0; }
    const int nblk = I.N / 32; I.k0 = 64 * (r / nblk); I.n0 = 32 * (r % nblk); return I;
}
__device__ __forceinline__ void p0_item_issue(const P0Item& I, int lane, f32x4 (&v)[8], float (&g)[8]) {
    const int kr = lane >> 3, nc = lane & 7;
#pragma unroll
    for (int j = 0; j < 8; ++j) { v[j] = *(const f32x4*)(I.W + (size_t)(I.k0 + 8 * j + kr) * I.N + I.n0 + 4 * nc); g[j] = I.gain ? I.gain[I.k0 + 8 * j + kr] : 1.0f; }
}
__device__ __forceinline__ void p0_weights(const P0Mats& Mx, LAS float* scr, int gw, int NGW, int lane_, int lo, int hi) {
    int lane = lane_; asm volatile("" : "+v"(lane));
    f32x4 v[8]; float g[8];
    int it = lo + gw;
    P0Item I = p0_item(Mx, it < hi ? it : lo);
    if (it < hi) p0_item_issue(I, lane, v, g);
#pragma unroll 1
    for (; it < hi; it += NGW) {
        {   const int kr = lane >> 3, nc = lane & 7;
#pragma unroll
            for (int j = 0; j < 8; ++j) { LAS float* d = scr + (8 * j + kr) * 33 + 4 * nc; d[0] = v[j].x * g[j]; d[1] = v[j].y * g[j]; d[2] = v[j].z * g[j]; d[3] = v[j].w * g[j]; } }
        const P0Item C = I;
        if (it + NGW < hi) { I = p0_item(Mx, it + NGW); p0_item_issue(I, lane, v, g); }
        __builtin_amdgcn_sched_barrier(0);
        LDS_WAIT(); asm volatile("" ::: "memory");
        int nd0 = C.n0;
        if (C.rowmap == 1 && C.n0 >= ZW) { int c = C.n0 - ZW; if (c < CCH) nd0 = ZW + 256 * (c >> 7) + (c & 127); else { c -= CCH; nd0 = ZW + 256 * (c >> 7) + 128 + (c & 127); } }
        const int c = lane & 7;
#pragma unroll
        for (int j = 0; j < 4; ++j) { const int n = (lane >> 3) + 8 * j; const LAS float* s = scr + (8 * c) * 33 + n;
            v4u o; o.x = pk2(s[0 * 33], s[1 * 33]); o.y = pk2(s[2 * 33], s[3 * 33]); o.z = pk2(s[4 * 33], s[5 * 33]); o.w = pk2(s[6 * 33], s[7 * 33]);
            *(GAS v4u*)(C.WT + (size_t)(nd0 + n) * C.K + C.k0 + 8 * c) = o; }
        LDS_WAIT(); asm volatile("" ::: "memory");
    }
}
__device__ __forceinline__ void p0_xrows(const float* xp, const float* xs, bf16* XB, float* rstd1, int gw, int NGW, int lane) {
    f32x4 v[8];
    int m = gw;
    if (m < M) { const GAS f32x4* xr = (const GAS f32x4*)((m < MP) ? xp + (size_t)m * DM : xs + (size_t)(m - MP) * DM) + lane;
#pragma unroll
        for (int j = 0; j < 8; ++j) v[j] = xr[64 * j]; }
#pragma unroll 1
    for (; m < M; m += NGW) {
        float s = 0.f; unsigned long long pk[8];
#pragma unroll
        for (int j = 0; j < 8; ++j) { s += (v[j].x * v[j].x + v[j].y * v[j].y) + (v[j].z * v[j].z + v[j].w * v[j].w); pk[j] = (unsigned long long)cvtpk(v[j].x, v[j].y) | ((unsigned long long)cvtpk(v[j].z, v[j].w) << 32); }
        const int mn = m + NGW;
        if (mn < M) { const GAS f32x4* xr = (const GAS f32x4*)((mn < MP) ? xp + (size_t)mn * DM : xs + (size_t)(mn - MP) * DM) + lane;
#pragma unroll
            for (int j = 0; j < 8; ++j) v[j] = xr[64 * j]; }
        __builtin_amdgcn_sched_barrier(0);
        s = wave_sum(s);
        if (lane == 0) rstd1[m] = 1.0f / sqrtf(s * (1.0f / DM) + EPS);
        GAS unsigned long long* o8 = (GAS unsigned long long*)(XB + (size_t)m * DM) + lane;
#pragma unroll
        for (int j = 0; j < 8; ++j) o8[64 * j] = pk[j];
    }
}

constexpr int KV_RS = 144;
__device__ __forceinline__ int crow(int r, int hi) { return (r & 3) + 8 * (r >> 2) + 4 * hi; }
__device__ __forceinline__ s16x4 vtr(const LAS unsigned char* p) { return __builtin_bit_cast(s16x4, __builtin_amdgcn_ds_read_tr16_b64_v4i16((LAS s16x4*)p)); }

__device__ __forceinline__ void q_issue(const bf16* qrow, int h, v4u (&raw)[4]) {
#pragma unroll
    for (int d0 = 0; d0 < 4; ++d0) raw[d0] = *(const v4u*)(qrow + 16 * d0 + 8 * h);
}
__device__ __forceinline__ void q_finish(const v4u (&raw)[4], int h, const LAS float* gq, bf16x8 (&qf)[4]) {
    float v[4][8]; float ss = 0.f;
#pragma unroll
    for (int d0 = 0; d0 < 4; ++d0)
#pragma unroll
        for (int e = 0; e < 4; ++e) { v[d0][2 * e] = bf_lo(raw[d0][e]); v[d0][2 * e + 1] = bf_hi(raw[d0][e]); ss += v[d0][2 * e] * v[d0][2 * e] + v[d0][2 * e + 1] * v[d0][2 * e + 1]; }
    ss += __shfl_xor(ss, 32);
    const float rs = __builtin_amdgcn_rsqf(ss * (1.0f / HD) + EPS) * QSCALE;
#pragma unroll
    for (int d0 = 0; d0 < 4; ++d0) { const f32x4 g0 = *(const LAS f32x4*)(gq + 16 * d0 + 8 * h), g1 = *(const LAS f32x4*)(gq + 16 * d0 + 8 * h + 4);
        v4u w; w.x = cvtpk(v[d0][0] * rs * g0[0], v[d0][1] * rs * g0[1]); w.y = cvtpk(v[d0][2] * rs * g0[2], v[d0][3] * rs * g0[3]);
        w.z = cvtpk(v[d0][4] * rs * g1[0], v[d0][5] * rs * g1[1]); w.w = cvtpk(v[d0][6] * rs * g1[2], v[d0][7] * rs * g1[3]);
        qf[d0] = __builtin_bit_cast(bf16x8, w); }
}
__device__ __forceinline__ void attn_core(const LAS unsigned char* Kt, const LAS unsigned char* Vt, int tt0, int qrel, int kvmin, const bf16x8 (&qf)[4], float sink2, float cshift, int lane, f32x16 (&o)[2]) {
    const int r32 = lane & 31, h = lane >> 5;
    f32x16 s[5];
#pragma unroll
    for (int i = 0; i < 5; ++i) {
        const LAS unsigned char* kp = Kt + (32 * (tt0 + i) + r32) * KV_RS + h * 16;
        const float nc = -cshift; f32x16 a = {nc, nc, nc, nc, nc, nc, nc, nc, nc, nc, nc, nc, nc, nc, nc, nc};
#pragma unroll
        for (int d0 = 0; d0 < 4; ++d0) { const bf16x8 kf = *(const LAS bf16x8*)(kp + 32 * d0); a = __builtin_amdgcn_mfma_f32_32x32x16_bf16(kf, qf[d0], a, 0, 0, 0); }
        s[i] = a;
    }
    const int qloc = qrel - 32 * tt0, ndead = (kvmin >> 5) - tt0;
    float ls = 0.f;
#pragma unroll
    for (int i = 0; i < 5; ++i)
#pragma unroll
        for (int r = 0; r < 16; ++r) { const int cr = (r & 3) + 8 * (r >> 2); bool ok = (i >= ndead);
            if (i == 0) ok = ok && (cr + 4 * h > qloc);
            if (i == 4) ok = ok && (cr + 4 * h <= qloc);
            const float p = ok ? __builtin_amdgcn_exp2f(s[i][r]) : 0.f; s[i][r] = p; ls += p; }
    ls += __shfl_xor(ls, 32);
    const float inv = __builtin_amdgcn_rcpf(ls + __builtin_amdgcn_exp2f(sink2 - cshift));
    o[0] = (f32x16){0.f, 0.f, 0.f, 0.f, 0.f, 0.f, 0.f, 0.f, 0.f, 0.f, 0.f, 0.f, 0.f, 0.f, 0.f, 0.f}; o[1] = o[0];
    const LAS unsigned char* vb = Vt + (4 * h + ((lane & 15) >> 2)) * KV_RS + ((lane >> 4) & 1) * 32 + (lane & 3) * 8;
#pragma unroll
    for (int i = 0; i < 5; ++i)
#pragma unroll
        for (int st = 0; st < 2; ++st) {
            v4u pw; pw.x = cvtpk(s[i][8 * st + 0], s[i][8 * st + 1]); pw.y = cvtpk(s[i][8 * st + 2], s[i][8 * st + 3]); pw.z = cvtpk(s[i][8 * st + 4], s[i][8 * st + 5]); pw.w = cvtpk(s[i][8 * st + 6], s[i][8 * st + 7]);
            const bf16x8 pf = __builtin_bit_cast(bf16x8, pw);
#pragma unroll
            for (int dt = 0; dt < 2; ++dt) {
                const LAS unsigned char* vp = vb + (32 * (tt0 + i) + 16 * st) * KV_RS + dt * 64;
                const s16x4 lo = vtr(vp), hi = vtr(vp + 8 * KV_RS);
                const bf16x8 vf = (bf16x8){lo[0], lo[1], lo[2], lo[3], hi[0], hi[1], hi[2], hi[3]};
                o[dt] = __builtin_amdgcn_mfma_f32_32x32x16_bf16(vf, pf, o[dt], 0, 0, 0);
            }
        }
#pragma unroll
    for (int dt = 0; dt < 2; ++dt)
#pragma unroll
        for (int r = 0; r < 16; ++r) o[dt][r] *= inv;
}
__device__ __forceinline__ void store_o(bf16* orow, int h, const f32x16 (&o)[2]) {
#pragma unroll
    for (int dt = 0; dt < 2; ++dt)
#pragma unroll
        for (int pr = 0; pr < 2; ++pr) {
            const int ge = 2 * pr, go = 2 * pr + 1;
            const unsigned e0 = cvtpk(o[dt][4 * ge], o[dt][4 * ge + 1]), e1 = cvtpk(o[dt][4 * ge + 2], o[dt][4 * ge + 3]);
            const unsigned o0 = cvtpk(o[dt][4 * go], o[dt][4 * go + 1]), o1 = cvtpk(o[dt][4 * go + 2], o[dt][4 * go + 3]);
            const auto r0 = __builtin_amdgcn_permlane32_swap(e0, o0, false, false), r1 = __builtin_amdgcn_permlane32_swap(e1, o1, false, false);
            const v4u w = (v4u){r0[0], r1[0], r0[1], r1[1]};
            *(v4u*)(orow + 32 * dt + 8 * (2 * pr + h)) = w; }
}
__device__ __forceinline__ void knorm32(const v4u (&raw)[4], const LAS float* gk32, float (&kf)[32]) {
    float ss = 0.f;
#pragma unroll
    for (int i = 0; i < 4; ++i)
#pragma unroll
        for (int e = 0; e < 4; ++e) { kf[8 * i + 2 * e] = bf_lo(raw[i][e]); kf[8 * i + 2 * e + 1] = bf_hi(raw[i][e]); ss += kf[8 * i + 2 * e] * kf[8 * i + 2 * e] + kf[8 * i + 2 * e + 1] * kf[8 * i + 2 * e + 1]; }
    ss += __shfl_xor(ss, 1);
    const float rs = __builtin_amdgcn_rsqf(ss * (1.0f / HD) + EPS);
#pragma unroll
    for (int i = 0; i < 8; ++i) { const f32x4 g = *(const LAS f32x4*)(gk32 + 4 * i);
#pragma unroll
        for (int e = 0; e < 4; ++e) kf[4 * i + e] = kf[4 * i + e] * rs * g[e]; }
}
__device__ __forceinline__ void lds_put32(LAS unsigned char* dst, const float (&f)[32]) {
#pragma unroll
    for (int i = 0; i < 4; ++i) { v4u w; w.x = cvtpk(f[8 * i], f[8 * i + 1]); w.y = cvtpk(f[8 * i + 2], f[8 * i + 3]); w.z = cvtpk(f[8 * i + 4], f[8 * i + 5]); w.w = cvtpk(f[8 * i + 6], f[8 * i + 7]); *(LAS v4u*)(dst + 16 * i) = w; }
}
__device__ __forceinline__ void glb_put32(float* dst, const float (&f)[32]) {
#pragma unroll
    for (int i = 0; i < 8; ++i) *(f32x4*)(dst + 4 * i) = (f32x4){f[4 * i], f[4 * i + 1], f[4 * i + 2], f[4 * i + 3]};
}

struct P2Args { const bf16* Z; const bf16* U; bf16* MIX; const float *ck, *cv, *sc, *gq, *gk, *sinks, *wdw, *bdw, *gln, *bln; float* out; const bf16* zrow; };

__device__ __forceinline__ void kv_issue(const P2Args& A, int au, int tid, v4u (&kr)[4], v4u (&vr)[4]) {
    const int b = au >> 6, qb = (au >> 2) & 15, hk = au & 3, r = tid >> 1, half = tid & 1, t = 128 * (qb - 1) + r, tc = t < 0 ? 0 : t;
    const bf16* zr = A.Z + (size_t)(b * SEQ + tc) * ZW + hk * HD + half * 32;
#pragma unroll
    for (int i = 0; i < 4; ++i) { kr[i] = *(const v4u*)(zr + 1024 + 8 * i); vr[i] = *(const v4u*)(zr + 1280 + 8 * i); }
}
__device__ __forceinline__ void attn_prompt_all(const P2Args& A, LAS unsigned char* lds, const LAS float* gq, const LAS float* gk, int bx, int G, int tid, int lane, int wave) {
    LAS unsigned char* Kt = lds; LAS unsigned char* Vt = lds + 49152;
    constexpr int NU = NB * 16 * NKV;
    const int r32 = lane & 31, h = lane >> 5;
    v4u kr[4], vr[4];
    int au = bx;
    if (au < NU) kv_issue(A, au, tid, kr, vr);
#pragma unroll 1
    for (; au < NU; au += G) {
        const int b = au >> 6, qb = (au >> 2) & 15, hk = au & 3;
        v4u qcur[4];
        { const int wu = wave * 2, g = wu >> 2, q0 = (wu & 3) * 32, head = hk * 4 + g; const size_t row = (size_t)b * SEQ + 128 * qb + q0 + r32; q_issue(A.Z + row * ZW + head * HD, h, qcur); }
        {   const int r = tid >> 1, half = tid & 1, t = 128 * (qb - 1) + r;
            if (t < 0) {
#pragma unroll
                for (int i = 0; i < 4; ++i) { kr[i] = (v4u){0u, 0u, 0u, 0u}; vr[i] = (v4u){0u, 0u, 0u, 0u}; } }
            float kf[32]; knorm32(kr, gk + half * 32, kf);
            lds_put32(Kt + r * KV_RS + half * 64, kf);
#pragma unroll
            for (int i = 0; i < 4; ++i) *(LAS v4u*)(Vt + r * KV_RS + half * 64 + 16 * i) = vr[i];
            if (qb == 15 && r >= 128) {
                const size_t oo = ((size_t)(b * 128 + (r - 128)) * NKV + hk) * HD + half * 32;
                glb_put32(A.out + O_KP + oo, kf);
                float vf[32];
#pragma unroll
                for (int i = 0; i < 4; ++i)
#pragma unroll
                    for (int e = 0; e < 4; ++e) { vf[8 * i + 2 * e] = bf_lo(vr[i][e]); vf[8 * i + 2 * e + 1] = bf_hi(vr[i][e]); }
                glb_put32(A.out + O_VP + oo, vf);
            }
        }
        __syncthreads();
#pragma unroll 1
        for (int w2 = 0; w2 < 2; ++w2) {
            const int wu = wave * 2 + w2, g = wu >> 2, q0 = (wu & 3) * 32, head = hk * 4 + g; const size_t row = (size_t)b * SEQ + 128 * qb + q0 + r32;
            v4u qnext[4];
            if (w2 == 0) q_issue(A.Z + (row + 32) * ZW + (hk * 4 + ((wu + 1) >> 2)) * HD, h, qnext);
            else {
#pragma unroll
                for (int i = 0; i < 4; ++i) qnext[i] = qcur[i]; }
            bf16x8 qf[4]; q_finish(qcur, h, gq, qf);
            if (w2 == 0 && au + G < NU) kv_issue(A, au + G, tid, kr, vr);
            f32x16 o[2];
            attn_core(Kt, Vt, q0 >> 5, q0 + r32, qb == 0 ? 128 : 0, qf, A.sinks[head] * LOG2E, gq[128], lane, o);
            store_o(A.MIX + row * DM + head * HD, h, o);
#pragma unroll
            for (int i = 0; i < 4; ++i) qcur[i] = qnext[i];
        }
        __syncthreads();
    }
}
__device__ __forceinline__ void attn_sample_unit(const P2Args& A, LAS unsigned char* lds, const LAS float* gq, const LAS float* gk, int b, int hp, int tid, int lane, int wave) {
    LAS unsigned char* Kt = lds; LAS unsigned char* Vt = lds + 49152;
#pragma unroll 1
    for (int it = 0; it < 2; ++it) {
        const int task = tid + it * 512;
        if (task < 640) {
            const int hl = task / 320, rem = task % 320, r = rem >> 1, half = rem & 1, hk = 2 * hp + hl;
            LAS unsigned char* kd = Kt + hl * (160 * KV_RS) + r * KV_RS + half * 64; LAS unsigned char* vd = Vt + hl * (160 * KV_RS) + r * KV_RS + half * 64;
            float kf[32], vf[32];
            if (r < 128) {
                const size_t io = ((size_t)(b * 128 + r) * NKV + hk) * HD + half * 32;
#pragma unroll
                for (int i = 0; i < 8; ++i) { const f32x4 a = *(const f32x4*)(A.ck + io + 4 * i), c = *(const f32x4*)(A.cv + io + 4 * i);
                    kf[4 * i] = a[0]; kf[4 * i + 1] = a[1]; kf[4 * i + 2] = a[2]; kf[4 * i + 3] = a[3]; vf[4 * i] = c[0]; vf[4 * i + 1] = c[1]; vf[4 * i + 2] = c[2]; vf[4 * i + 3] = c[3]; }
                if (r >= 4) { const size_t oo = ((size_t)(b * 128 + r - 4) * NKV + hk) * HD + half * 32; glb_put32(A.out + O_KS + oo, kf); glb_put32(A.out + O_VS + oo, vf); }
            } else if (r < 132) {
                const bf16* zr = A.Z + (size_t)(MP + b * DS + (r - 128)) * ZW + hk * HD + half * 32;
                v4u kr[4], vr[4];
#pragma unroll
                for (int i = 0; i < 4; ++i) { kr[i] = *(const v4u*)(zr + 1024 + 8 * i); vr[i] = *(const v4u*)(zr + 1280 + 8 * i); }
                knorm32(kr, gk + half * 32, kf);
#pragma unroll
                for (int i = 0; i < 4; ++i)
#pragma unroll
                    for (int e = 0; e < 4; ++e) { vf[8 * i + 2 * e] = bf_lo(vr[i][e]); vf[8 * i + 2 * e + 1] = bf_hi(vr[i][e]); }
                const size_t oo = ((size_t)(b * 128 + r - 4) * NKV + hk) * HD + half * 32; glb_put32(A.out + O_KS + oo, kf); glb_put32(A.out + O_VS + oo, vf);
            } else {
#pragma unroll
                for (int i = 0; i < 32; ++i) { kf[i] = 0.f; vf[i] = 0.f; }
            }
            lds_put32(kd, kf); lds_put32(vd, vf);
        }
    }
    __syncthreads();
    if (wave < 2) {
        const int hk = 2 * hp + wave, r32 = lane & 31, h = lane >> 5, g = (r32 >> 2) & 3, i = r32 & 3, head = hk * 4 + g;
        const size_t row = (size_t)MP + b * DS + i;
        v4u qraw[4]; q_issue(A.Z + row * ZW + head * HD, h, qraw);
        bf16x8 qf[4]; q_finish(qraw, h, gq, qf);
        f32x16 o[2];
        attn_core(Kt + wave * (160 * KV_RS), Vt + wave * (160 * KV_RS), 0, i, 0, qf, A.sinks[head] * LOG2E, gq[128], lane, o);
        if (r32 < 16) store_o(A.MIX + row * DM + head * HD, h, o);
    }
    __syncthreads();
}

template <int TT>
__device__ __forceinline__ void conv_ln_store(f32x2 (&acc)[TT], f32x2 bdw, f32x2 gln, f32x2 bln, LAS float* red, LAS float* fin, bf16* mixrow0  , int tid) {
#pragma unroll
    for (int tt = 0; tt < TT; ++tt) { const f32x2 y = acc[tt] + bdw; acc[tt] = y; red[(2 * tt) * 512 + tid] = y.x + y.y; red[(2 * tt + 1) * 512 + tid] = y.x * y.x + y.y * y.y; }
    __syncthreads();
    {   constexpr int NV = 2 * TT, PER = 512 / NV;
        const int v = tid / PER, p = tid % PER; float s = 0.f;
#pragma unroll
        for (int k = 0; k < NV; ++k) s += red[v * 512 + k * PER + p];
#pragma unroll
        for (int o = 1; o < PER; o <<= 1) s += __shfl_xor(s, o);
        if constexpr (PER == 16) {
            const float q = __shfl_xor(s, 16);
            if ((tid & 31) == 0) { const float mean = s * (1.0f / CCH), var = q * (1.0f / CCH) - mean * mean; *(LAS f32x2*)(fin + 2 * (tid >> 5)) = (f32x2){mean, __builtin_amdgcn_rsqf(var + EPS)}; }
        } else { if (p == 0) fin[v] = s; } }
    __syncthreads();
#pragma unroll
    for (int tt = 0; tt < TT; ++tt) {
        f32x2 mr = *(const LAS f32x2*)(fin + 2 * tt);
        if constexpr (512 / (2 * TT) != 16) { const float mean = mr.x * (1.0f / CCH), var = mr.y * (1.0f / CCH) - mean * mean; mr = (f32x2){mean, __builtin_amdgcn_rsqf(var + EPS)}; }
        const f32x2 val = (acc[tt] - mr.x) * (gln * mr.y) + bln;
        const float o0 = val.x * __builtin_amdgcn_rcpf(1.0f + __expf(-val.x)), o1 = val.y * __builtin_amdgcn_rcpf(1.0f + __expf(-val.y));
        *(unsigned*)(mixrow0 + (size_t)tt * DM) = cvtpk(o0, o1);
    }
}
constexpr int CTT = 16;
__device__ __forceinline__ void conv_issue(const P2Args& A, int cu, int tid, unsigned (&raw)[CTT + 30]) {
    const int b = cu >> 7, t0 = (cu & 127) * CTT;
#pragma unroll
    for (int rr = 0; rr < CTT + 30; ++rr) { const int t = t0 - 30 + rr;
        const char* rowp = (t >= 0) ? (const char*)(A.U + (size_t)(b * SEQ + t) * CCH) : (const char*)A.zrow;
        raw[rr] = *(const unsigned*)(rowp + (unsigned)(4 * tid)); }
}
__device__ __forceinline__ void conv_prompt_all(const P2Args& A, LAS unsigned char* lds, const f32x2 (&w)[CW], f32x2 bdw, f32x2 gln, f32x2 bln, int first, int G, int NU, int tid) {
    LAS float* red = (LAS float*)lds; LAS float* fin = (LAS float*)(lds + 65536);
    const int c = 2 * tid;
    unsigned raw[CTT + 30];
    int cu = first;
    if (cu < NU) conv_issue(A, cu, tid, raw);
#pragma unroll 1
    for (; cu < NU; cu += G) {
        const int b = cu >> 7, t0 = (cu & 127) * CTT;
        f32x2 acc[CTT];
#pragma unroll
        for (int tt = 0; tt < CTT; ++tt) acc[tt] = (f32x2){0.f, 0.f};
#pragma unroll
        for (int rr = 0; rr < CTT + 30; ++rr) {
            const f32x2 u2 = (f32x2){bf_lo(raw[rr]), bf_hi(raw[rr])};
#pragma unroll
            for (int tt = 0; tt < CTT; ++tt) { const int j = rr - tt; if (j >= 0 && j < CW) acc[tt] += w[j] * u2; }
        }
        if (t0 + CTT > SEQ - 30) {
#pragma unroll
            for (int rr = 30; rr < CTT + 30; ++rr) { const int t = t0 - 30 + rr; if (t >= SEQ - 30) *(f32x2*)(A.out + O_CP + ((size_t)b * 30 + t - (SEQ - 30)) * CCH + c) = (f32x2){bf_lo(raw[rr]), bf_hi(raw[rr])}; }
        }
        if (cu + G < NU) conv_issue(A, cu + G, tid, raw);
        conv_ln_store<CTT>(acc, bdw, gln, bln, red, fin, A.MIX + (size_t)(b * SEQ + t0) * DM + 1024 + c, tid);
    }
}
__device__ __forceinline__ void conv_sample_unit(const P2Args& A, LAS unsigned char* lds, int b, const f32x2 (&w)[CW], f32x2 bdw, f32x2 gln, f32x2 bln, int tid) {
    LAS float* red = (LAS float*)lds; LAS float* fin = (LAS float*)(lds + 65536);
    const int c = 2 * tid;
    f32x2 ue[30 + DS];
#pragma unroll
    for (int rr = 0; rr < 30; ++rr) ue[rr] = *(const f32x2*)(A.sc + ((size_t)b * 30 + rr) * CCH + c);
#pragma unroll
    for (int rr = 0; rr < DS; ++rr) { const unsigned raw = *(const unsigned*)(A.U + (size_t)(MP + b * DS + rr) * CCH + c); ue[30 + rr] = (f32x2){bf_lo(raw), bf_hi(raw)}; }
    f32x2 acc[DS];
#pragma unroll
    for (int tt = 0; tt < DS; ++tt) acc[tt] = (f32x2){0.f, 0.f};
#pragma unroll
    for (int rr = 0; rr < DS + 30; ++rr)
#pragma unroll
        for (int tt = 0; tt < DS; ++tt) { const int j = rr - tt; if (j >= 0 && j < CW) acc[tt] += w[j] * ue[rr]; }
#pragma unroll
    for (int rr = DS; rr < 30 + DS; ++rr) *(f32x2*)(A.out + O_CS + ((size_t)b * 30 + rr - DS) * CCH + c) = ue[rr];
    conv_ln_store<DS>(acc, bdw, gln, bln, red, fin, A.MIX + (size_t)(MP + b * DS) * DM + 1024 + c, tid);
}

__device__ __forceinline__ void run_p2(const P2Args& A, LAS unsigned char* lds, int bx, int G, int tid, int lane, int wave) {
    LAS float* gq = (LAS float*)(lds + 98304); LAS float* gk = gq + 64;
    if (tid < 64) { const float a = A.gq[tid], b = A.gk[tid]; gq[tid] = a; gk[tid] = b;
        float ma = fabsf(a), mb = fabsf(b);
#pragma unroll
        for (int o = 1; o < 64; o <<= 1) { ma = fmaxf(ma, __shfl_xor(ma, o)); mb = fmaxf(mb, __shfl_xor(mb, o)); }
        if (tid == 0) gq[128] = fmaxf(0.f, QSCALE * 64.0f * ma * mb - 64.0f); }
    __syncthreads();
    attn_prompt_all(A, lds, gq, gk, bx, G, tid, lane, wave);
#if PROBE == 4
    attn_prompt_all(A, lds, gq, gk, bx, G, tid, lane, wave);
#endif
    for (int su = bx; su < DB * 2; su += G) attn_sample_unit(A, lds, gq, gk, su >> 1, su & 1, tid, lane, wave);
#if PROBE == 6
    for (int su = bx; su < DB * 2; su += G) attn_sample_unit(A, lds, gq, gk, su >> 1, su & 1, tid, lane, wave);
#endif
    f32x2 w[CW];
#pragma unroll
    for (int j = 0; j < CW; ++j) w[j] = *(const f32x2*)(A.wdw + j * CCH + 2 * tid);
    const f32x2 bdw = *(const f32x2*)(A.bdw + 2 * tid), gln = *(const f32x2*)(A.gln + 2 * tid), bln = *(const f32x2*)(A.bln + 2 * tid);
    conv_prompt_all(A, lds, w, bdw, gln, bln, bx, G, MP / CTT, tid);
#if PROBE == 5
    conv_prompt_all(A, lds, w, bdw, gln, bln, bx, G, MP / CTT, tid);
#endif
    for (int cu = bx; cu < DB; cu += G) conv_sample_unit(A, lds, cu, w, bdw, gln, bln, tid);
#if PROBE == 6
    for (int cu = bx; cu < DB; cu += G) conv_sample_unit(A, lds, cu, w, bdw, gln, bln, tid);
#endif
}

template <int MODE> struct SEpi;
struct SgPtrs { bf16* Z; bf16* U; const float* rstd1; const float* xs; float* out; bf16* XB; float* ssqs; bf16* H; const float* r2; };
__device__ __forceinline__ void sg_store_bf16(bf16* p, float x) { *p = (bf16)f2bf(x); }
template <int MODE>
__device__ __forceinline__ void sg_epilogue(const SgPtrs& P, const float (&v)[2][4], int rs0  , int nblk  , int r) {
#pragma unroll
    for (int e = 0; e < 4; ++e) {
        const int rs = rs0 + e; const size_t row = (size_t)MP + rs;
        if (MODE == 0) { const float s = P.rstd1[row];
#pragma unroll
            for (int cb = 0; cb < 2; ++cb) sg_store_bf16(P.Z + row * ZW + 64 * nblk + 32 * cb + r, v[cb][e] * s); }
        if (MODE == 1) { const float s = P.rstd1[row]; const float a = v[0][e] * s, g = v[1][e] * s; sg_store_bf16(P.U + row * CCH + 32 * nblk + r, a * __builtin_amdgcn_rcpf(1.0f + __expf(-g))); }
        if (MODE == 2) {
#pragma unroll
            for (int cb = 0; cb < 2; ++cb) { const int col = 64 * nblk + 32 * cb + r; const float x1 = P.xs[(size_t)rs * DM + col] + v[cb][e];
                P.out[row * DM + col] = x1; sg_store_bf16(P.XB + row * DM + col, x1);
                float q = x1 * x1;
#pragma unroll
                for (int o = 1; o < 32; o <<= 1) q += __shfl_xor(q, o);
                if (r == 0) P.ssqs[(size_t)rs * 64 + 2 * nblk + cb] = q; } }
        if (MODE == 3) {
#pragma unroll
            for (int cb = 0; cb < 2; ++cb) { const float a = fmaxf(v[cb][e], 0.f); sg_store_bf16(P.H + row * FF + 64 * nblk + 32 * cb + r, a * a); } }
        if (MODE == 4) { const float s = P.r2[row];
#pragma unroll
            for (int cb = 0; cb < 2; ++cb) { float* o = P.out + row * DM + 64 * nblk + 32 * cb + r; *o = *o + s * v[cb][e]; } }
    }
}
#define SG_MMA(a0, a1, b0, b1) do { _Pragma("unroll") for (int j_ = 0; j_ < 4; ++j_) { \
        acc[0][0] = __builtin_amdgcn_mfma_f32_32x32x16_bf16(a0[j_], b0[j_], acc[0][0], 0, 0, 0); \
        acc[0][1] = __builtin_amdgcn_mfma_f32_32x32x16_bf16(a0[j_], b1[j_], acc[0][1], 0, 0, 0); \
        acc[1][0] = __builtin_amdgcn_mfma_f32_32x32x16_bf16(a1[j_], b0[j_], acc[1][0], 0, 0, 0); \
        acc[1][1] = __builtin_amdgcn_mfma_f32_32x32x16_bf16(a1[j_], b1[j_], acc[1][1], 0, 0, 0); } } while (0)
template <int MODE>
__device__ __forceinline__ void sgemm_tile(LAS unsigned char* lds, const SgPtrs& P, const bf16* A0  , const bf16* Bb0, const bf16* Bb1, int K, int mi, int nblk, int lane_, int wave) {
    int lane = lane_; asm volatile("" : "+v"(lane));
    const int r = lane & 31, h = lane >> 5, kw = K >> 3, ns = kw >> 6, lr = lane >> 3, lc = lane & 7;
    const unsigned goff = (unsigned)(lr * K + wave * kw) * 2u + (unsigned)lc * 16u, gp = (unsigned)(8 * K) * 2u;
    LAS unsigned char* wb = lds + wave * 16384;
    const int wofs0 = lr * 128 + ((lc ^ lr) * 16), wofs1 = lr * 128 + ((lc ^ lr ^ 1) * 16);
    const int rm = (r & 7) ^ ((r >> 3) & 1);
    __syncthreads();
    f32x16 acc[2][2];
#pragma unroll
    for (int i = 0; i < 2; ++i)
#pragma unroll
        for (int j = 0; j < 2; ++j) acc[i][j] = (f32x16){0.f, 0.f, 0.f, 0.f, 0.f, 0.f, 0.f, 0.f, 0.f, 0.f, 0.f, 0.f, 0.f, 0.f, 0.f, 0.f};
    v4u g[4][4];
#define SG_ISSUE(kb) do { _Pragma("unroll") for (int p_ = 0; p_ < 4; ++p_) { \
        g[0][p_] = *(const v4u*)((const char*)A0 + (goff + p_ * gp + (kb))); g[1][p_] = *(const v4u*)((const char*)A0 + (goff + (p_ + 4) * gp + (kb))); \
        g[2][p_] = *(const v4u*)((const char*)Bb0 + (goff + p_ * gp + (kb))); g[3][p_] = *(const v4u*)((const char*)Bb1 + (goff + p_ * gp + (kb))); } } while (0)
#define SG_WRITE() do { _Pragma("unroll") for (int b_ = 0; b_ < 4; ++b_) _Pragma("unroll") for (int p_ = 0; p_ < 4; ++p_) \
        *(LAS v4u*)(wb + b_ * 4096 + p_ * 1024 + ((p_ & 1) ? wofs1 : wofs0)) = g[b_][p_]; } while (0)
    SG_ISSUE(0u);
    SG_WRITE();
#pragma unroll 1
    for (int s = 0; s < ns; ++s) {
        const bool more = (s + 1 < ns);
        if (more) SG_ISSUE(128u * (unsigned)(s + 1));
        __builtin_amdgcn_sched_barrier(0);
        bf16x8 a0[4], a1[4], b0[4], b1[4];
#pragma unroll
        for (int j = 0; j < 4; ++j) { const int co = r * 128 + (((2 * j + h) ^ rm) * 16);
            a0[j] = *(const LAS bf16x8*)(wb + co); a1[j] = *(const LAS bf16x8*)(wb + 4096 + co); b0[j] = *(const LAS bf16x8*)(wb + 8192 + co); b1[j] = *(const LAS bf16x8*)(wb + 12288 + co); }
        SG_MMA(a0, a1, b0, b1);
        __builtin_amdgcn_sched_barrier(0);
        if (more) SG_WRITE();
    }
#undef SG_ISSUE
#undef SG_WRITE
    LAS float* red = (LAS float*)lds;
    __syncthreads();
#pragma unroll
    for (int rb = 0; rb < 2; ++rb)
#pragma unroll
        for (int cb = 0; cb < 2; ++cb)
#pragma unroll
            for (int g2 = 0; g2 < 16; ++g2) red[(wave * 64 + rb * 32 + cb * 16 + g2) * 64 + lane] = acc[rb][cb][g2];
    __syncthreads();
    const int rb = wave >> 2, q = wave & 3;
    float v[2][4];
#pragma unroll
    for (int cb = 0; cb < 2; ++cb)
#pragma unroll
        for (int e2 = 0; e2 < 4; ++e2) { float sm = 0.f;
#pragma unroll
            for (int ww = 0; ww < 8; ++ww) sm += red[(ww * 64 + rb * 32 + cb * 16 + 4 * q + e2) * 64 + lane];
            v[cb][e2] = sm; }
    sg_epilogue<MODE>(P, v, 64 * mi + 32 * rb + 8 * q + 4 * h, nblk, r);
}
#undef SG_MMA

struct Args { const float* in[18]; float* out; unsigned char* ws; };
__global__ void __launch_bounds__(NWAVES * 64, 2) fwd_kernel(Args args) {
    extern __shared__ __attribute__((aligned(16))) unsigned char lds_raw[];
    LAS unsigned char* lds = (LAS unsigned char*)lds_raw;
    volatile LAS unsigned* MISC = (volatile LAS unsigned*)(lds + MISC_OFF);
    const int tid = threadIdx.x, lane = tid & 63, wave = __builtin_amdgcn_readfirstlane(tid >> 6);
    const int G = gridDim.x, bx = blockIdx.x;
    unsigned char* ws = args.ws;
    unsigned* ctl = (unsigned*)(ws + WS_CTL);
    const float* xp = args.in[0]; const float* xs = args.in[1];
    bf16* Wi = (bf16*)(ws + WS_WIN); bf16* Wo = (bf16*)(ws + WS_WOUT); bf16* Wu = (bf16*)(ws + WS_WUP); bf16* Wd = (bf16*)(ws + WS_WDN);
    float* rstd1 = (float*)(ws + WS_RSTD1); float* r2 = (float*)(ws + WS_R2); float* ssq = (float*)(ws + WS_SSQ); float* ssqs = (float*)(ws + WS_SSQS);
    bf16* XB = (bf16*)(ws + WS_XB); bf16* Z = (bf16*)(ws + WS_Z); bf16* U = (bf16*)(ws + WS_U); bf16* MIX = (bf16*)(ws + WS_MIX); bf16* H = (bf16*)(ws + WS_H);
    float* out = args.out;
    const SgPtrs SP{Z, U, rstd1, xs, out, XB, ssqs, H, r2};
    const int SG_XCD = bx & 7, SG_MI = (bx >> 3) >> 2, SG_NS = (bx >> 3) & 3;
    for (int u = tid; u < (LDS_BYTES - RING_BYTES) / 4; u += NWAVES * 64) ((LAS unsigned*)(lds + RING_BYTES))[u] = 0u;
    __syncthreads();
    XcdBarrier bar = xcd_barrier_post(ctl + CW_BAR, MISC + 8);
    const P0Mats Mx{args.in[6], args.in[5], args.in[14], args.in[16], args.in[15], args.in[17], Wi, Wo, Wu, Wd};
#define CONVERT_WEIGHTS(lo, hi) do { __syncthreads(); p0_weights(Mx, (LAS float*)(lds + wave * 16384), bx * NWAVES + wave, G * NWAVES, lane, (lo), (hi)); } while (0)

    for (int rep_ = 0; rep_ < (PROBE == 1 ? 2 : 1); ++rep_) {
        LAS float* scr = (LAS float*)(lds + wave * 16384);
        const int gw = bx * NWAVES + wave, NGW = G * NWAVES;
        p0_weights(Mx, scr, gw, NGW, lane, 0, P0_I_IN);
        p0_xrows(xp, xs, XB, rstd1, gw, NGW, lane);
    }
    xcd_barrier(bar);

    {
#define SGR_IN(lo, hi) for (int rd = (lo); rd < (hi); ++rd) { const int mi = SG_MI, ni = (rd * 8 + SG_XCD) * 4 + SG_NS; \
            if (ni < 24) sgemm_tile<0>(lds, SP, XB + (size_t)(MP + 64 * mi) * DM, Wi + (size_t)(64 * ni) * DM, Wi + (size_t)(64 * ni + 32) * DM, DM, mi, ni, lane, wave); \
            else if (ni < 56) { const int ci = ni - 24, ch = 32 * ci; const bf16* b0 = Wi + (size_t)(ZW + 256 * (ch >> 7) + (ch & 127)) * DM; \
                sgemm_tile<1>(lds, SP, XB + (size_t)(MP + 64 * mi) * DM, b0, b0 + (size_t)128 * DM, DM, mi, ci, lane, wave); } }
        const int nf = (SG_NS * 2) / 3;
        SGR_IN(0, nf);
        __syncthreads();
        pg8::Gemm g{XB, Wi, MP, INW, DM}; pg8::StaticOrder S; S.init(MP, INW, G, bx);
        pg8::EpiIn E{Z, U, rstd1};
        pg8::gemm_phase<pg8::EpiIn, pg8::StaticOrder, true, true>(lds, g, S, E);
        SGR_IN(nf, 2);
#undef SGR_IN
    }
    xcd_barrier(bar);

    {
        P2Args A{Z, U, MIX, args.in[2], args.in[3], args.in[4], args.in[7], args.in[8], args.in[9], args.in[10], args.in[11], args.in[12], args.in[13], out, (const bf16*)(ws + WS_ZROW)};
        run_p2(A, lds, bx, G, tid, lane, wave);
#if PROBE == 2
        run_p2(A, lds, bx, G, tid, lane, wave);
#endif
        CONVERT_WEIGHTS(P0_I_IN, P0_I_IN + P0_I_OUT);
    }
    xcd_barrier(bar);

    for (int rep_ = 0; rep_ < (PROBE == 3 ? 2 : 1); ++rep_) {
#define SGR_OUT(lo, hi) for (int rd = (lo); rd < (hi); ++rd) { const int mi = SG_MI, ni = SG_XCD * 4 + SG_NS; sgemm_tile<2>(lds, SP, MIX + (size_t)(MP + 64 * mi) * DM, Wo + (size_t)(64 * ni) * DM, Wo + (size_t)(64 * ni + 32) * DM, DM, mi, ni, lane, wave); }
        const int nf = SG_NS & 1;
        SGR_OUT(0, nf);
        __syncthreads();
        pg8::Gemm g{MIX, Wo, MP, DM, DM}; pg8::StaticOrder S; S.init(MP, DM, G, bx, 4);
        pg8::EpiOut E{xp, xs, out, XB, ssq};
        pg8::gemm_phase<pg8::EpiOut, pg8::StaticOrder, true, true>(lds, g, S, E);
        SGR_OUT(nf, 1);
#undef SGR_OUT
    }
    CONVERT_WEIGHTS(P0_I_IN + P0_I_OUT, P0_I_IN + P0_I_OUT + P0_I_UP);
    xcd_barrier(bar);

    {
        for (int row = bx * (NWAVES * 64) + tid; row < M; row += G * NWAVES * 64) {
            float s = 0.f;
            if (row < MP) { const f32x4* p = (const f32x4*)(ssq + (size_t)row * 32);
#pragma unroll
                for (int i = 0; i < 8; ++i) { const f32x4 v = p[i]; s += (v.x + v.y) + (v.z + v.w); } }
            else { const f32x4* p = (const f32x4*)(ssqs + (size_t)(row - MP) * 64);
#pragma unroll
                for (int i = 0; i < 16; ++i) { const f32x4 v = p[i]; s += (v.x + v.y) + (v.z + v.w); } }
            r2[row] = 1.0f / (s * (1.0f / DM) + EPS);
        }
#define SGR_UP(lo, hi) for (int rd = (lo); rd < (hi); ++rd) { const int mi = SG_MI, ni = (rd * 8 + SG_XCD) * 4 + SG_NS; sgemm_tile<3>(lds, SP, XB + (size_t)(MP + 64 * mi) * DM, Wu + (size_t)(64 * ni) * DM, Wu + (size_t)(64 * ni + 32) * DM, DM, mi, ni, lane, wave); }
        const int nf = SG_NS;
        SGR_UP(0, nf);
        __syncthreads();
        pg8::Gemm g{XB, Wu, MP, FF, DM}; pg8::StaticOrder S; S.init(MP, FF, G, bx);
        pg8::EpiUp E{H};
        pg8::gemm_phase<pg8::EpiUp, pg8::StaticOrder, true, true>(lds, g, S, E);
        SGR_UP(nf, 4);
#undef SGR_UP
    }
    CONVERT_WEIGHTS(P0_I_IN + P0_I_OUT + P0_I_UP, P0_NITEMS);
    xcd_barrier(bar);

    {
#define SGR_DN(lo, hi) for (int rd = (lo); rd < (hi); ++rd) { const int mi = SG_MI, ni = SG_XCD * 4 + SG_NS; sgemm_tile<4>(lds, SP, H + (size_t)(MP + 64 * mi) * FF, Wd + (size_t)(64 * ni) * FF, Wd + (size_t)(64 * ni + 32) * FF, FF, mi, ni, lane, wave); }
        const int nf = SG_NS & 1;
        SGR_DN(0, nf);
        __syncthreads();
        pg8::Gemm g{H, Wd, MP, DM, FF}; pg8::StaticOrder S; S.init(MP, DM, G, bx, 4, 1);
        pg8::EpiDown E{out, r2, XB};
        pg8::gemm_phase<pg8::EpiDown, pg8::StaticOrder, true, true>(lds, g, S, E);
        SGR_DN(nf, 1);
#undef SGR_DN
    }
}

extern "C" void kernel_launch(void* const* d_in, const int* in_sizes, int n_in, void* d_out, int out_size, void* d_ws, size_t ws_size, hipStream_t stream) {
    static int grid = 0;
    if (grid == 0) {
        if (n_in != 18 || (size_t)out_size != O_END || ws_size < WS_END) { fprintf(stderr, "kernel_launch: unexpected shapes (n_in %d, out %d, ws %zu); nothing launched\n", n_in, out_size, ws_size); grid = -1; return; }
        int dev = 0, cus = 0, per_cu = 0;
        if (hipGetDevice(&dev) != hipSuccess || hipDeviceGetAttribute(&cus, hipDeviceAttributeMultiprocessorCount, dev) != hipSuccess) { grid = -1; return; }
        if (hipFuncSetAttribute((const void*)fwd_kernel, hipFuncAttributeMaxDynamicSharedMemorySize, LDS_BYTES) != hipSuccess) { fprintf(stderr, "kernel_launch: hipFuncSetAttribute failed\n"); grid = -1; return; }
        if (hipOccupancyMaxActiveBlocksPerMultiprocessor(&per_cu, (const void*)fwd_kernel, NWAVES * 64, LDS_BYTES) != hipSuccess || per_cu < 1) { fprintf(stderr, "kernel_launch: occupancy query reports %d\n", per_cu); }
        (void)hipGetLastError();
        if (cus < 256) { fprintf(stderr, "kernel_launch: built for a 256-CU device (got %d CUs); nothing launched\n", cus); grid = -1; return; }
        grid = 256;
    }
    if (grid < 0) return;
    if (hipMemsetAsync((char*)d_ws + WS_CTL, 0, CTL_ZERO_BYTES, stream) != hipSuccess) return;
    Args a{};
    for (int i = 0; i < 18; ++i) a.in[i] = (const float*)d_in[i];
    a.out = (float*)d_out; a.ws = (unsigned char*)d_ws;
    hipLaunchKernelGGL(fwd_kernel, dim3(grid), dim3(NWAVES * 64), LDS_BYTES, stream, a);
}
```
